# Optimizing an MI355X kernel written in HIP

```python
import math
import jax
import jax.numpy as jnp
from jax import lax
import numpy as np

D_MODEL = 1024
BATCH = 8
SEQ = 2048
DEPTH = 1
DEC_BATCH = 128
DEC_SEQ = 4
PAST_LEN = 8192
PAGE_SIZE = 128

EPS = 1e-6
N_MEM = 256
SSD_HEADS = 8
SSD_HEAD_DIM = 64
SSD_WIDTH = SSD_HEADS * SSD_HEAD_DIM
SSD_GROUPS = 2
SSD_STATE = 128
SSD_CONV = 4
SSD_CHUNK = 128
SSD_CONV_DIM = SSD_WIDTH + 2 * SSD_GROUPS * SSD_STATE
ATT_HEADS = 8
ATT_KV_HEADS = 2
ATT_GROUP = ATT_HEADS // ATT_KV_HEADS
ATT_HEAD_DIM = 64
ATT_WIDTH = ATT_HEADS * ATT_HEAD_DIM
ATT_KV_WIDTH = ATT_KV_HEADS * ATT_HEAD_DIM
WINDOW = 128
ATT_SCALE = ATT_HEAD_DIM ** -0.5
MIX_WIDTH = SSD_WIDTH + ATT_WIDTH
X_HEADS = 4
X_HEAD_DIM = D_MODEL // X_HEADS
X_SCALE = X_HEAD_DIM ** -0.5
D_FF = -(-8 * D_MODEL // (3 * 256)) * 256
IN_SPLITS = (SSD_WIDTH, SSD_CONV_DIM, SSD_HEADS, ATT_WIDTH, ATT_KV_WIDTH, ATT_KV_WIDTH)
IN_DIM = sum(IN_SPLITS)
SPLIT_AT = tuple(int(s) for s in np.cumsum(IN_SPLITS)[:-1])

kernel_name = 'hymba_ssd_swa_sink_memxattn_step'


def rmsnorm(x, g):
    xf = x.astype(jnp.float32)
    y = xf * lax.rsqrt(jnp.mean(xf * xf, axis=-1, keepdims=True) + EPS)
    return (y * g.astype(jnp.float32)).astype(x.dtype)


def gated_group_rmsnorm(y, z, g):
    b, l, _ = y.shape
    u = (y * jax.nn.silu(z.astype(jnp.float32))).reshape(b, l, SSD_GROUPS, SSD_WIDTH // SSD_GROUPS)
    u = u * lax.rsqrt(jnp.mean(u * u, axis=-1, keepdims=True) + EPS)
    return u.reshape(b, l, SSD_WIDTH) * g.astype(jnp.float32)


def causal_conv(u, prev, w, bias):
    l = u.shape[1]
    up = jnp.concatenate([prev.astype(u.dtype), u], axis=1)
    out = bias
    for j in range(SSD_CONV):
        out = out + up[:, j:j + l] * w[j]
    return jax.nn.silu(out), up[:, l:]


def segsum(a):
    t = a.shape[-1]
    cs = jnp.cumsum(a, axis=-1)
    diff = cs[..., :, None] - cs[..., None, :]
    lower = jnp.tril(jnp.ones((t, t), dtype=bool))
    return jnp.where(lower, diff, -jnp.inf)


def ssd_scan(x, dt, a, bm, cm, h0):
    bsz, l = x.shape[0], x.shape[1]
    t = SSD_CHUNK if l % SSD_CHUNK == 0 else l
    nc = l // t
    r = SSD_HEADS // SSD_GROUPS
    xdt = (x * dt[..., None]).reshape(bsz, nc, t, SSD_GROUPS, r, SSD_HEAD_DIM)
    adt = (dt * a).reshape(bsz, nc, t, SSD_GROUPS, r).transpose(0, 3, 4, 1, 2)
    bc = bm.reshape(bsz, nc, t, SSD_GROUPS, SSD_STATE)
    cc = cm.reshape(bsz, nc, t, SSD_GROUPS, SSD_STATE)
    a_cum = jnp.cumsum(adt, axis=-1)
    decay_in = jnp.exp(segsum(adt))
    cb = jnp.einsum('bctgn,bcsgn->bgcts', cc, bc)
    y_diag = jnp.einsum('bgcts,bgrcts,bcsgrp->bctgrp', cb, decay_in, xdt)
    decay_to_end = jnp.exp(a_cum[..., -1:] - a_cum)
    chunk_states = jnp.einsum('bctgn,bgrct,bctgrp->bcgrpn', bc, decay_to_end, xdt)
    h0g = h0.reshape(bsz, 1, SSD_GROUPS, r, SSD_HEAD_DIM, SSD_STATE)
    states = jnp.concatenate([h0g, chunk_states], axis=1)
    chunk_tot = jnp.pad(a_cum[..., -1], ((0, 0), (0, 0), (0, 0), (1, 0)))
    decay_chunk = jnp.exp(segsum(chunk_tot))
    states = jnp.einsum('bgrzc,bcgrpn->bzgrpn', decay_chunk, states)
    y_off = jnp.einsum('bctgn,bcgrpn,bgrct->bctgrp', cc, states[:, :-1], jnp.exp(a_cum))
    y = (y_diag + y_off).reshape(bsz, l, SSD_HEADS, SSD_HEAD_DIM)
    return y, states[:, -1].reshape(bsz, SSD_HEADS, SSD_HEAD_DIM, SSD_STATE)


def ssd_mixer(z, xbc_raw, dt_raw, conv_prev, h0, conv_w, conv_b, dt_bias, a_log, d_skip, g_norm):
    dtype = z.dtype
    xbc, conv_new = causal_conv(xbc_raw, conv_prev, conv_w, conv_b)
    b, l, _ = xbc.shape
    xbc = xbc.astype(jnp.float32)
    gn = SSD_GROUPS * SSD_STATE
    xs = xbc[..., :SSD_WIDTH].reshape(b, l, SSD_HEADS, SSD_HEAD_DIM)
    bm = xbc[..., SSD_WIDTH:SSD_WIDTH + gn].reshape(b, l, SSD_GROUPS, SSD_STATE)
    cm = xbc[..., SSD_WIDTH + gn:].reshape(b, l, SSD_GROUPS, SSD_STATE)
    dt = jax.nn.softplus(dt_raw.astype(jnp.float32) + dt_bias.astype(jnp.float32))
    a = -jnp.exp(a_log.astype(jnp.float32))
    y, h_new = ssd_scan(xs, dt, a, bm, cm, h0.astype(jnp.float32))
    y = y + xs * d_skip.astype(jnp.float32)[:, None]
    y = gated_group_rmsnorm(y.reshape(b, l, SSD_WIDTH), z, g_norm)
    return y.astype(dtype), conv_new, h_new.astype(h0.dtype)


def sink_softmax(s, mask, sinks):
    sink = sinks.astype(jnp.float32).reshape(ATT_KV_HEADS, ATT_GROUP, 1, 1)
    s = jnp.where(mask, s, -jnp.inf)
    m = jnp.maximum(jnp.max(s, axis=-1, keepdims=True), sink)
    e = jnp.exp(s - m)
    return e / (jnp.sum(e, axis=-1, keepdims=True) + jnp.exp(sink - m))


def swa_prompt(q, k, v, sinks):
    bsz, l = q.shape[0], q.shape[1]
    nb = l // WINDOW
    qb = q.reshape(bsz, nb, WINDOW, ATT_KV_HEADS, ATT_GROUP, ATT_HEAD_DIM)
    kb = k.reshape(bsz, nb, WINDOW, ATT_KV_HEADS, ATT_HEAD_DIM)
    vb = v.reshape(bsz, nb, WINDOW, ATT_KV_HEADS, ATT_HEAD_DIM)
    pad = ((0, 0), (1, 0), (0, 0), (0, 0), (0, 0))
    kk = jnp.concatenate([jnp.pad(kb, pad)[:, :-1], kb], axis=2)
    vv = jnp.concatenate([jnp.pad(vb, pad)[:, :-1], vb], axis=2)
    s = jnp.einsum('bnqhrd,bnkhd->bnhrqk', qb, kk, preferred_element_type=jnp.float32) * ATT_SCALE
    qi = jnp.arange(WINDOW)[:, None] + WINDOW
    kj = jnp.arange(2 * WINDOW)[None, :]
    band = (kj <= qi) & (qi - kj < WINDOW)
    has_prev = (jnp.arange(nb) > 0)[:, None, None]
    mask = band[None] & (has_prev | (kj >= WINDOW)[None])
    pr = sink_softmax(s, mask[:, None, None], sinks)
    o = jnp.einsum('bnhrqk,bnkhd->bnqhrd', pr.astype(vv.dtype), vv)
    return o.reshape(bsz, l, ATT_WIDTH)


def swa_sample(q, k, v, buf_k, buf_v, sinks):
    bsz, l = q.shape[0], q.shape[1]
    wb = buf_k.shape[1]
    kk = jnp.concatenate([buf_k.astype(k.dtype), k], axis=1)
    vv = jnp.concatenate([buf_v.astype(v.dtype), v], axis=1)
    s = jnp.einsum('bqhrd,bkhd->bhrqk', q, kk, preferred_element_type=jnp.float32) * ATT_SCALE
    qpos = PAST_LEN + jnp.arange(l)[:, None]
    kpos = PAST_LEN - wb + jnp.arange(wb + l)[None, :]
    mask = (kpos <= qpos) & (qpos - kpos < WINDOW)
    pr = sink_softmax(s, mask, sinks)
    o = jnp.einsum('bhrqk,bkhd->bqhrd', pr.astype(vv.dtype), vv)
    return o.reshape(bsz, l, ATT_WIDTH), kk[:, -wb:], vv[:, -wb:]


def memory_kv(mem, g, w_k, w_v):
    b, m, _ = mem.shape
    mn = rmsnorm(mem, g)
    return ((mn @ w_k).reshape(b, m, X_HEADS, X_HEAD_DIM),
            (mn @ w_v).reshape(b, m, X_HEADS, X_HEAD_DIM))


def cross_attend(h, mem_k, mem_v, w_q, w_o):
    bsz, l, _ = h.shape
    q = (h @ w_q).reshape(bsz, l, X_HEADS, X_HEAD_DIM)
    s = jnp.einsum('blhd,bmhd->bhlm', q, mem_k.astype(q.dtype), preferred_element_type=jnp.float32) * X_SCALE
    pr = jax.nn.softmax(s, axis=-1)
    o = jnp.einsum('bhlm,bmhd->blhd', pr.astype(q.dtype), mem_v.astype(q.dtype))
    return o.reshape(bsz, l, D_MODEL) @ w_o


def decoder_layer(x, conv_prev, h0, win_k, win_v, mem_k, mem_v, p):
    bsz, l, _ = x.shape
    h = rmsnorm(x, p['g_mix_pre'])
    proj = h @ p['w_in']
    z, xbc_raw, dt_raw, q, k, v = jnp.split(proj, SPLIT_AT, axis=-1)
    y_ssd, conv_new, h_new = ssd_mixer(z, xbc_raw, dt_raw, conv_prev, h0, p['conv_w'], p['conv_b'],
                                       p['dt_bias'], p['a_log'], p['d_skip'], p['g_ssd_norm'])
    q = q.reshape(bsz, l, ATT_KV_HEADS, ATT_GROUP, ATT_HEAD_DIM)
    k = k.reshape(bsz, l, ATT_KV_HEADS, ATT_HEAD_DIM)
    v = v.reshape(bsz, l, ATT_KV_HEADS, ATT_HEAD_DIM)
    if win_k is None:
        y_att = swa_prompt(q, k, v, p['sinks'])
        new_k, new_v = k[:, -WINDOW:], v[:, -WINDOW:]
    else:
        y_att, new_k, new_v = swa_sample(q, k, v, win_k, win_v, p['sinks'])
    mix = jnp.concatenate([y_ssd, y_att.astype(x.dtype)], axis=-1) @ p['w_out']
    x = x + rmsnorm(mix, p['g_mix_post'])
    c = cross_attend(rmsnorm(x, p['g_x_pre']), mem_k, mem_v, p['w_xq'], p['w_xo'])
    x = x + rmsnorm(c, p['g_x_post'])
    hf = rmsnorm(x, p['g_ffn_pre'])
    f = (jax.nn.silu(hf @ p['w_gate']) * (hf @ p['w_up'])) @ p['w_down']
    x = x + rmsnorm(f, p['g_ffn_post'])
    return x, conv_new, h_new, new_k, new_v


def setup_inputs(seed: int = 0) -> dict:
    key = jax.random.key(seed)
    ks = iter(jax.random.split(key, 40))
    f32 = jnp.float32

    def nrm(shape, scale):
        return jax.random.normal(next(ks), shape, f32) * scale

    def gain(width):
        return 1.0 + nrm((DEPTH, width), 0.02)

    win_buf = min(WINDOW, PAST_LEN)
    x_prompt = nrm((BATCH, SEQ, D_MODEL), 1.0)
    x_sample = nrm((DEC_BATCH, DEC_SEQ, D_MODEL), 1.0)
    state_ssm = nrm((DEPTH, DEC_BATCH, SSD_HEADS, SSD_HEAD_DIM, SSD_STATE), 0.5)
    state_conv = nrm((DEPTH, DEC_BATCH, SSD_CONV - 1, SSD_CONV_DIM), 1.0)
    cache_win_k = nrm((DEPTH, DEC_BATCH, win_buf, ATT_KV_HEADS, ATT_HEAD_DIM), 1.0)
    cache_win_v = nrm((DEPTH, DEC_BATCH, win_buf, ATT_KV_HEADS, ATT_HEAD_DIM), 1.0)
    cache_mem_k = nrm((DEPTH, DEC_BATCH, N_MEM, X_HEADS, X_HEAD_DIM), 1.0)
    cache_mem_v = nrm((DEPTH, DEC_BATCH, N_MEM, X_HEADS, X_HEAD_DIM), 1.0)
    mem_prompt = nrm((BATCH, N_MEM, D_MODEL), 1.0)
    u = jax.random.uniform(next(ks), (DEPTH, SSD_HEADS), f32)
    dt0 = jnp.exp(u * (math.log(0.1) - math.log(0.001)) + math.log(0.001))
    dt_bias = dt0 + jnp.log(-jnp.expm1(-dt0))
    a_log = jnp.log(jax.random.uniform(next(ks), (DEPTH, SSD_HEADS), f32, 1.0, 16.0))
    return {
        'x_prompt': x_prompt, 'x_sample': x_sample,
        'state_ssm': state_ssm, 'state_conv': state_conv,
        'cache_win_k': cache_win_k, 'cache_win_v': cache_win_v,
        'cache_mem_k': cache_mem_k, 'cache_mem_v': cache_mem_v,
        'mem_prompt': mem_prompt,
        'g_mix_pre': gain(D_MODEL),
        'w_in': nrm((DEPTH, D_MODEL, IN_DIM), D_MODEL ** -0.5),
        'conv_w': nrm((DEPTH, SSD_CONV, SSD_CONV_DIM), SSD_CONV ** -0.5),
        'conv_b': nrm((DEPTH, SSD_CONV_DIM), 0.02),
        'dt_bias': dt_bias,
        'a_log': a_log,
        'd_skip': 1.0 + nrm((DEPTH, SSD_HEADS), 0.1),
        'g_ssd_norm': gain(SSD_WIDTH),
        'sinks': nrm((DEPTH, ATT_HEADS), 0.5),
        'w_out': nrm((DEPTH, MIX_WIDTH, D_MODEL), MIX_WIDTH ** -0.5),
        'g_mix_post': gain(D_MODEL),
        'g_x_pre': gain(D_MODEL),
        'w_xq': nrm((DEPTH, D_MODEL, D_MODEL), D_MODEL ** -0.5),
        'g_mem': gain(D_MODEL),
        'w_xk': nrm((DEPTH, D_MODEL, D_MODEL), D_MODEL ** -0.5),
        'w_xv': nrm((DEPTH, D_MODEL, D_MODEL), D_MODEL ** -0.5),
        'w_xo': nrm((DEPTH, D_MODEL, D_MODEL), D_MODEL ** -0.5),
        'g_x_post': gain(D_MODEL),
        'g_ffn_pre': gain(D_MODEL),
        'w_gate': nrm((DEPTH, D_MODEL, D_FF), D_MODEL ** -0.5),
        'w_up': nrm((DEPTH, D_MODEL, D_FF), D_MODEL ** -0.5),
        'w_down': nrm((DEPTH, D_FF, D_MODEL), D_FF ** -0.5),
        'g_ffn_post': gain(D_MODEL),
    }


def reference(x_prompt, x_sample, state_ssm, state_conv, cache_win_k, cache_win_v, cache_mem_k, cache_mem_v,
              mem_prompt, g_mix_pre, w_in, conv_w, conv_b, dt_bias, a_log, d_skip, g_ssd_norm, sinks, w_out,
              g_mix_post, g_x_pre, w_xq, g_mem, w_xk, w_xv, w_xo, g_x_post, g_ffn_pre, w_gate, w_up, w_down,
              g_ffn_post):
    yp, ys = x_prompt, x_sample
    bp = x_prompt.shape[0]
    p_ssm, p_conv, p_wk, p_wv, p_mk, p_mv = [], [], [], [], [], []
    s_ssm, s_conv, s_wk, s_wv = [], [], [], []
    for i in range(DEPTH):
        p = {'g_mix_pre': g_mix_pre[i], 'w_in': w_in[i], 'conv_w': conv_w[i], 'conv_b': conv_b[i],
             'dt_bias': dt_bias[i], 'a_log': a_log[i], 'd_skip': d_skip[i], 'g_ssd_norm': g_ssd_norm[i],
             'sinks': sinks[i], 'w_out': w_out[i], 'g_mix_post': g_mix_post[i], 'g_x_pre': g_x_pre[i],
             'w_xq': w_xq[i], 'w_xo': w_xo[i], 'g_x_post': g_x_post[i], 'g_ffn_pre': g_ffn_pre[i],
             'w_gate': w_gate[i], 'w_up': w_up[i], 'w_down': w_down[i], 'g_ffn_post': g_ffn_post[i]}
        mk, mv = memory_kv(mem_prompt, g_mem[i], w_xk[i], w_xv[i])
        conv0 = jnp.zeros((bp, SSD_CONV - 1, SSD_CONV_DIM), yp.dtype)
        h00 = jnp.zeros((bp, SSD_HEADS, SSD_HEAD_DIM, SSD_STATE), yp.dtype)
        yp, pc, ph, pk, pv = decoder_layer(yp, conv0, h00, None, None, mk, mv, p)
        p_ssm.append(ph); p_conv.append(pc); p_wk.append(pk); p_wv.append(pv); p_mk.append(mk); p_mv.append(mv)
        ys, sc, sh, sk, sv = decoder_layer(ys, state_conv[i], state_ssm[i], cache_win_k[i], cache_win_v[i],
                                           cache_mem_k[i], cache_mem_v[i], p)
        s_ssm.append(sh); s_conv.append(sc); s_wk.append(sk); s_wv.append(sv)
    return (yp, ys,
            jnp.stack(p_ssm), jnp.stack(p_conv), jnp.stack(p_wk), jnp.stack(p_wv), jnp.stack(p_mk), jnp.stack(p_mv),
            jnp.stack(s_ssm), jnp.stack(s_conv), jnp.stack(s_wk), jnp.stack(s_wv))
```

```cpp
#include <hip/hip_runtime.h>
#include <hip/hip_cooperative_groups.h>
#include <cstdio>
#include <cstdint>
namespace cg = cooperative_groups;
namespace pg8 {
#define PG8_LAS __attribute__((address_space(3)))
typedef unsigned short bf16_t;
typedef short bf16x8 __attribute__((ext_vector_type(8)));
typedef float f32x4 __attribute__((ext_vector_type(4)));
typedef unsigned u32x4 __attribute__((ext_vector_type(4)));
constexpr int BM = 256, BK = 64, HALF = 128, HTB = HALF * BK * 2  , STAGE_BYTES = 8 * HTB, NXCD = 8, WGM = 8;

__host__ __device__ __forceinline__ int lds_byte(int r, int c) { const int st = (r >> 4) * 2 + (c >> 5), rr = r & 15, cc = c & 31, ob = rr * 64 + cc * 2; return st * 1024 + (ob ^ (((ob >> 9) & 1) << 5)); }
__host__ __device__ __forceinline__ void stage_rc(int b, int& R, int& C) { const int st = b / 1024, sb = b % 1024, swz = sb ^ (((sb >> 9) & 1) << 5); R = (st >> 1) * 16 + swz / 64; C = (st & 1) * 32 + (swz % 64) / 2; }
__host__ __device__ __forceinline__ int perm32(int rho) { const int n = rho >> 4, i = rho & 15; return 8 * (i >> 2) + 4 * n + (i & 3); }

struct Unit { int pm, pn, kofs, nt, q; };
struct Gemm { const bf16_t* A; const bf16_t* Bt; int M, N, K; };

struct StaticOrder {
    int nM, nN, nwg, G, c;
    __host__ __device__ void init(int M, int N, int G_, int c_) { nM = M / BM; nN = N / BM; nwg = nM * nN; G = G_; c = c_; }
    __host__ __device__ bool next(int i, Unit& u) const {
        const long L = (long)i * G + c; if (L >= nwg) return false;
        int wgid = (int)L; { const int q = nwg / NXCD, r = nwg % NXCD, xcd = wgid % NXCD, off = wgid / NXCD; wgid = (xcd < r ? xcd * (q + 1) : r * (q + 1) + (xcd - r) * q) + off; }
        const int nig = WGM * nN, gid = wgid / nig, fm = gid * WGM, gsz = (nM - fm) < WGM ? (nM - fm) : WGM;
        u.pm = fm + ((wgid % nig) % gsz); u.pn = (wgid % nig) / gsz; return true;
    }
    __device__ __forceinline__ void a_ready(const Unit&) const {}
    __device__ __forceinline__ void done(const Unit&) const {}
};

__device__ __forceinline__ unsigned cvt_pk_bf16(float lo, float hi) { unsigned r; asm volatile("v_cvt_pk_bf16_f32 %0, %1, %2" : "=v"(r) : "v"(lo), "v"(hi)); return r; }
typedef float f32x2 __attribute__((ext_vector_type(2)));
template <class Epi, class Sched, bool ALIGN_EPI = false, bool SP2 = false>
__device__ __forceinline__ void gemm_phase(PG8_LAS unsigned char* lds, const Gemm g, const Sched& S, const Epi& E) {
    int tid_ = threadIdx.x; asm volatile("" : "+v"(tid_));
    const int tid = tid_, wid = __builtin_amdgcn_readfirstlane(tid >> 6), lane = tid & 63, wr = wid >> 2, wc = wid & 3, fr = lane & 15, fq = lane >> 4;
    const int K = g.K; int nt = K / BK;
    unsigned voffA[2], voffB[2];
#pragma unroll
    for (int i = 0; i < 2; ++i) { int R, C; stage_rc(tid * 16 + i * 8192, R, C); const int Rb = Epi::PERM ? ((R & ~31) + perm32(R & 31)) : R;
        voffA[i] = (unsigned)(R * K + C) * 2u; voffB[i] = (unsigned)(Rb * K + C) * 2u; }
    const size_t kstep = (size_t)(BK * 2);
    const size_t hstep = (size_t)HALF * K * 2;
    const size_t tstep = 2 * hstep;
    const unsigned ldsw = (unsigned)wid * 1024u;
    const int aoff = lds_byte(wr * 64 + fr, fq * 8), boff = lds_byte(wc * 32 + fr, fq * 8);
#define PG8_SA(b, h) (((b) * 2 + (h)) * HTB)
#define PG8_SB(b, h) ((4 + (b) * 2 + (h)) * HTB)
#define PG8_STAGE(bufoff, gbase, voff) do { _Pragma("unroll") for (int _i = 0; _i < 2; ++_i) \
        __builtin_amdgcn_global_load_lds((const unsigned*)((const char*)(gbase) + (voff)[_i]), (PG8_LAS unsigned*)(lds + (bufoff) + ldsw + _i * 8192), 16, 0, 0); } while (0)
#define PG8_LDA(dst, b, h) do { _Pragma("unroll") for (int m = 0; m < 4; ++m) _Pragma("unroll") for (int k = 0; k < 2; ++k) dst[m][k] = *(const PG8_LAS bf16x8*)(lds + PG8_SA(b, h) + aoff + m * 2048 + k * 1024); } while (0)
#define PG8_LDB(dst, b, h) do { _Pragma("unroll") for (int n = 0; n < 2; ++n) _Pragma("unroll") for (int k = 0; k < 2; ++k) dst[n][k] = *(const PG8_LAS bf16x8*)(lds + PG8_SB(b, h) + boff + n * 2048 + k * 1024); } while (0)
#define PG8_MMA(ai, bj, At, Bt) do { __builtin_amdgcn_s_setprio(1); _Pragma("unroll") for (int m = 0; m < 4; ++m) _Pragma("unroll") for (int n = 0; n < 2; ++n) _Pragma("unroll") for (int k = 0; k < 2; ++k) \
        acc[ai][bj][m][n] = __builtin_amdgcn_mfma_f32_16x16x32_bf16(Bt[n][k], At[m][k], acc[ai][bj][m][n], 0, 0, 0); __builtin_amdgcn_s_setprio(0); } while (0)
#define PG8_WAIT_V(n) asm volatile("s_waitcnt vmcnt(" #n ")" ::: "memory")
#define PG8_WAIT_L(n) asm volatile("s_waitcnt lgkmcnt(" #n ")" ::: "memory")
#define PG8_BAR __builtin_amdgcn_s_barrier()
#define PG8_SCHED __builtin_amdgcn_sched_barrier(0)
    Unit cur, nxt; int ui = 0;
    if (!S.next(0, cur)) return;
    f32x4 acc[2][2][4][2];
#pragma unroll
    for (int a = 0; a < 2; ++a)
#pragma unroll
        for (int b = 0; b < 2; ++b)
#pragma unroll
            for (int m = 0; m < 4; ++m)
#pragma unroll
                for (int n = 0; n < 2; ++n) acc[a][b][m][n] = (f32x4){0.f, 0.f, 0.f, 0.f};
    bf16x8 At[4][2], B0[2][2], B1[2][2];
    const char* cA = (const char*)g.A + (size_t)cur.pm * tstep + (size_t)cur.kofs * 2; const char* cB = (const char*)g.Bt + (size_t)cur.pn * tstep + (size_t)cur.kofs * 2;
    if (cur.nt) nt = cur.nt;
    S.a_ready(cur);
    if constexpr (SP2) {
        PG8_STAGE(PG8_SB(0, 0), cB, voffB); PG8_STAGE(PG8_SB(0, 1), cB + hstep, voffB); PG8_STAGE(PG8_SA(0, 0), cA, voffA); PG8_STAGE(PG8_SA(0, 1), cA + hstep, voffA);
        if (wr == 1) PG8_BAR;
        PG8_WAIT_V(2); PG8_BAR;
        PG8_STAGE(PG8_SB(1, 0), cB + kstep, voffB); PG8_STAGE(PG8_SA(1, 0), cA + kstep, voffA); PG8_STAGE(PG8_SB(1, 1), cB + hstep + kstep, voffB);
        PG8_WAIT_V(6); PG8_BAR;
    } else {
        PG8_STAGE(PG8_SB(0, 0), cB, voffB); PG8_STAGE(PG8_SA(0, 0), cA, voffA); PG8_STAGE(PG8_SB(0, 1), cB + hstep, voffB); PG8_STAGE(PG8_SA(0, 1), cA + hstep, voffA);
        if (wr == 1) PG8_BAR;
        PG8_WAIT_V(4); PG8_BAR;
        PG8_STAGE(PG8_SB(1, 0), cB + kstep, voffB); PG8_STAGE(PG8_SA(1, 0), cA + kstep, voffA); PG8_STAGE(PG8_SB(1, 1), cB + hstep + kstep, voffB);
        PG8_WAIT_V(6); PG8_BAR;
    }
    for (;;) {
        const bool has_next = S.next(ui + 1, nxt);
        const char* nA = has_next ? (const char*)g.A + (size_t)nxt.pm * tstep + (size_t)nxt.kofs * 2 : cA; const char* nB = has_next ? (const char*)g.Bt + (size_t)nxt.pn * tstep + (size_t)nxt.kofs * 2 : cB;
        for (int t = 0; t < nt; t += 2) {
            const bool last = (t == nt - 2);
            const char* a1 = cA + (size_t)(t + 1) * kstep;
            const char* a2 = last ? nA : cA + (size_t)(t + 2) * kstep; const char* b2 = last ? nB : cB + (size_t)(t + 2) * kstep;
            const char* a3 = a2 + kstep; const char* b3 = b2 + kstep;
            if (last && has_next) S.a_ready(nxt);
            if constexpr (SP2) {
            PG8_LDB(B0, 0, 0); PG8_LDB(B1, 0, 1); PG8_SCHED; PG8_LDA(At, 0, 0); PG8_STAGE(PG8_SA(1, 1), a1 + hstep, voffA);
            PG8_WAIT_V(8); PG8_WAIT_L(0); PG8_BAR; PG8_MMA(0, 0, At, B0); PG8_MMA(0, 1, At, B1); PG8_BAR; PG8_SCHED;
            PG8_LDA(At, 0, 1); PG8_STAGE(PG8_SB(0, 0), b2, voffB); PG8_STAGE(PG8_SB(0, 1), b2 + hstep, voffB); PG8_STAGE(PG8_SA(0, 0), a2, voffA);
            PG8_WAIT_V(8); PG8_WAIT_L(0); PG8_BAR; PG8_MMA(1, 0, At, B0); PG8_MMA(1, 1, At, B1); PG8_BAR; PG8_SCHED;
            PG8_LDB(B0, 1, 0); PG8_LDB(B1, 1, 1); PG8_SCHED; PG8_LDA(At, 1, 0); PG8_STAGE(PG8_SA(0, 1), a2 + hstep, voffA);
            PG8_WAIT_V(8); PG8_WAIT_L(0); PG8_BAR; PG8_MMA(0, 0, At, B0); PG8_MMA(0, 1, At, B1); PG8_BAR; PG8_SCHED;
            PG8_LDA(At, 1, 1); PG8_STAGE(PG8_SB(1, 0), b3, voffB); PG8_STAGE(PG8_SB(1, 1), b3 + hstep, voffB); PG8_STAGE(PG8_SA(1, 0), a3, voffA);
            PG8_WAIT_V(8); PG8_WAIT_L(0); PG8_BAR; PG8_MMA(1, 0, At, B0); PG8_MMA(1, 1, At, B1); PG8_BAR; PG8_SCHED;
            } else {
            PG8_LDB(B0, 0, 0); PG8_SCHED; PG8_LDA(At, 0, 0); PG8_STAGE(PG8_SA(1, 1), a1 + hstep, voffA);
            PG8_WAIT_L(8); PG8_BAR; PG8_WAIT_L(0); PG8_MMA(0, 0, At, B0); PG8_BAR; PG8_SCHED;
            PG8_LDB(B1, 0, 1); PG8_STAGE(PG8_SB(0, 0), b2, voffB);
            PG8_BAR; PG8_WAIT_L(0); PG8_MMA(0, 1, At, B1); PG8_BAR;
            PG8_LDA(At, 0, 1); PG8_STAGE(PG8_SA(0, 0), a2, voffA);
            PG8_BAR; PG8_WAIT_L(0); PG8_MMA(1, 0, At, B0); PG8_BAR; PG8_SCHED;
            PG8_STAGE(PG8_SB(0, 1), b2 + hstep, voffB);
            PG8_WAIT_V(6); PG8_BAR; PG8_MMA(1, 1, At, B1); PG8_BAR;
            PG8_LDB(B0, 1, 0); PG8_SCHED; PG8_LDA(At, 1, 0); PG8_STAGE(PG8_SA(0, 1), a2 + hstep, voffA);
            PG8_WAIT_L(8); PG8_BAR; PG8_WAIT_L(0); PG8_MMA(0, 0, At, B0); PG8_BAR; PG8_SCHED;
            PG8_LDB(B1, 1, 1); PG8_STAGE(PG8_SB(1, 0), b3, voffB);
            PG8_BAR; PG8_WAIT_L(0); PG8_MMA(0, 1, At, B1); PG8_BAR;
            PG8_LDA(At, 1, 1); PG8_STAGE(PG8_SA(1, 0), a3, voffA);
            PG8_BAR; PG8_WAIT_L(0); PG8_MMA(1, 0, At, B0); PG8_BAR; PG8_SCHED;
            PG8_STAGE(PG8_SB(1, 1), b3 + hstep, voffB);
            PG8_WAIT_V(6); PG8_BAR; PG8_MMA(1, 1, At, B1); PG8_BAR;
            }
        }
        if constexpr (ALIGN_EPI) { if (wr == 0) PG8_BAR; }
        if constexpr (!Epi::AFTER_DRAIN) { E(acc, cur, wr, wc, fr, fq); S.done(cur); }
        if (!has_next) break;
#pragma unroll
        for (int a = 0; a < 2; ++a)
#pragma unroll
            for (int b = 0; b < 2; ++b)
#pragma unroll
                for (int m = 0; m < 4; ++m)
#pragma unroll
                    for (int n = 0; n < 2; ++n) acc[a][b][m][n] = (f32x4){0.f, 0.f, 0.f, 0.f};
        cur = nxt; cA = nA; cB = nB; ++ui; nt = cur.nt ? cur.nt : K / BK;
        if constexpr (ALIGN_EPI) { if (wr == 1) PG8_BAR; }
    }
    PG8_WAIT_V(0);
    if constexpr (!ALIGN_EPI) { if (wr == 0) PG8_BAR; }
    PG8_BAR;
    if constexpr (Epi::AFTER_DRAIN) { E.fused(acc, cur, wr, wc, fr, fq, lds, wid, lane); S.done(cur); }
#undef PG8_SA
#undef PG8_SB
#undef PG8_STAGE
#undef PG8_LDA
#undef PG8_LDB
#undef PG8_MMA
#undef PG8_WAIT_V
#undef PG8_WAIT_L
#undef PG8_BAR
#undef PG8_SCHED
}
}
#define LAS __attribute__((address_space(3)))
typedef unsigned short bf16_t;
typedef float f32x4 __attribute__((ext_vector_type(4)));
typedef short bf16x8 __attribute__((ext_vector_type(8)));
typedef unsigned u32x4 __attribute__((ext_vector_type(4)));
typedef unsigned u32x2 __attribute__((ext_vector_type(2)));

constexpr int DM = 1024, TP = 16384, TS = 512, TT = TP + TS, SEQ = 2048, NB = 8, NSB = 128;
constexpr int NPROJ = 2304, INDIM = 2312, DFF = 2816;
constexpr float EPS = 1e-6f;
constexpr int RT_H0 = 0, RT_MN = 66, RT_WIN = 74, RT_WXKV = 83, RT_END = 91;
constexpr size_t WS_R = 1u << 20;
constexpr size_t WS_H0 = WS_R;
constexpr size_t WS_MN = WS_R + (size_t)RT_MN * 256 * 2048;
constexpr size_t WS_WIN = WS_R + (size_t)RT_WIN * 256 * 2048;
constexpr size_t WS_WXKV = WS_R + (size_t)RT_WXKV * 256 * 2048;
constexpr size_t WS_WOUT = WS_R + (size_t)RT_END * 256 * 2048;
constexpr size_t WS_WXQ = WS_WOUT + 2097152;
constexpr size_t WS_WXO = WS_WXQ + 2097152;
constexpr size_t WS_WGU = WS_WXO + 2097152;
constexpr size_t WS_WDN = WS_WGU + (size_t)2 * DFF * 1024 * 2;
constexpr size_t WS_DTRAW = WS_WDN + (size_t)1024 * DFF * 2;
constexpr size_t WS_SPLIT = WS_DTRAW + (size_t)TT * 8 * 4;
constexpr size_t WS_ATOT = WS_SPLIT + (size_t)16 * 512 * 1024 * 4;
constexpr size_t WS_MIXIN = WS_ATOT + 8192;
constexpr size_t WS_CB16 = WS_MIXIN + (size_t)TT * 1024 * 2;
constexpr size_t WS_Q2 = WS_CB16 + (size_t)TT * 1024 * 2;
constexpr size_t WS_OX = WS_Q2 + (size_t)TT * 1024 * 2;
constexpr size_t WS_PROJ = WS_OX + (size_t)TT * 1024 * 2;
constexpr size_t WS_KVT = WS_PROJ + (size_t)TT * NPROJ * 2;
constexpr size_t WS_MK = WS_KVT + (size_t)256 * TT * 2;
constexpr size_t WS_MVT = WS_MK + (size_t)2048 * 1024 * 2;
constexpr size_t WS_MV = WS_MVT + (size_t)2048 * 1024 * 2;
constexpr size_t WS_CS = WS_MV + (size_t)2048 * 1024 * 2;
constexpr size_t WS_X1 = WS_CS;
constexpr size_t WS_END1 = WS_X1 + (size_t)TT * 1024 * 2 > WS_CS + (size_t)8 * 16 * 8 * 8192 * 4 ? WS_X1 + (size_t)TT * 1024 * 2 : WS_CS + (size_t)8 * 16 * 8 * 8192 * 4;
constexpr size_t WS_ACT = WS_PROJ;
constexpr size_t WS_END2 = WS_ACT + (size_t)TT * DFF * 2;
constexpr size_t WS_END = WS_END1 > WS_END2 ? WS_END1 : WS_END2;
constexpr size_t O_Y = 0, O_PSSM = 17301504, O_PCONV = 17825792, O_PWK = 17850368, O_PWV = 17981440, O_PMK = 18112512, O_PMV = 20209664,
                 O_SSSM = 22306816, O_SCONV = 30695424, O_SWK = 31088640, O_SWV = 33185792;
constexpr int LDS_BYTES = 147456;

struct Params {
    const float* in[32]; float* out; unsigned char* ws; int ph_lo, ph_hi;
};
typedef const __attribute__((address_space(4))) Params* CP;

__device__ __forceinline__ float bf2f(bf16_t h) { return __uint_as_float(((unsigned)h) << 16); }
__device__ __forceinline__ unsigned pk2(float lo, float hi) { return pg8::cvt_pk_bf16(lo, hi); }
__device__ __forceinline__ bf16_t f2bf(float f) { return (bf16_t)(pk2(f, 0.f) & 0xffffu); }
__device__ __forceinline__ float wave_sum(float v) {
#pragma unroll
    for (int o = 1; o < 64; o <<= 1) v += __shfl_xor(v, o);
    return v;
}
__device__ __forceinline__ float wave_max(float v) {
#pragma unroll
    for (int o = 1; o < 64; o <<= 1) v = fmaxf(v, __shfl_xor(v, o));
    return v;
}
__device__ __forceinline__ float silu_f(float x) { return x / (1.f + __expf(-x)); }
__device__ __forceinline__ float softplus_f(float x) { return x > 20.f ? x : log1pf(__expf(x)); }
#define LDSW() asm volatile("s_waitcnt lgkmcnt(0)" ::: "memory")

template <int NT>
__device__ __forceinline__ void mma_lds(f32x4 (&acc)[NT], const LAS bf16_t* A, int lda, const LAS bf16_t* B, int ldb, int K, int lane) {
    const int fr = lane & 15, fq = lane >> 4;
    for (int k0 = 0; k0 < K; k0 += 32) {
        const bf16x8 a = *(const LAS bf16x8*)(A + fr * lda + k0 + 8 * fq);
#pragma unroll
        for (int n = 0; n < NT; ++n) {
            const bf16x8 b = *(const LAS bf16x8*)(B + (16 * n + fr) * ldb + k0 + 8 * fq);
            acc[n] = __builtin_amdgcn_mfma_f32_16x16x32_bf16(b, a, acc[n], 0, 0, 0);
        }
    }
}
template <int NT, int KS, int ks0, int nks>
__device__ __forceinline__ void mma_areg(f32x4 (&acc)[NT], const bf16x8 (&a)[KS], const LAS bf16_t* B, int ldb, int lane) {
    const int fr = lane & 15, fq = lane >> 4;
#pragma unroll
    for (int ks = 0; ks < nks; ++ks) {
#pragma unroll
        for (int n = 0; n < NT; ++n) {
            const bf16x8 b = *(const LAS bf16x8*)(B + (16 * n + fr) * ldb + ks * 32 + 8 * fq);
            acc[n] = __builtin_amdgcn_mfma_f32_16x16x32_bf16(b, a[ks0 + ks], acc[n], 0, 0, 0);
        }
        __builtin_amdgcn_sched_barrier(0);
    }
}

struct Order {
    int n, G, c, mode, nN;
    __device__ __forceinline__ bool next(int i, pg8::Unit& u) const {
        const long L0 = (long)i * G + c; if (L0 >= n) return false;
        u.kofs = 0; u.nt = 0; u.q = 0;
        if (mode == 2) { const int L = (int)L0; if (L < 256) { const int v = (L % 8) * 32 + L / 8; u.pm = v / 4; u.pn = v % 4; }
            else { const int l = L - 256, q = l & 3, hi = ((nN + 7) / 8) * 2, lo = (nN - 2 * hi) / 2; u.pm = 64 + (l >> 4); u.pn = (l >> 2) & 3; u.q = q; u.nt = q < 2 ? hi : lo; u.kofs = 64 * (q < 2 ? q * hi : 2 * hi + (q - 2) * lo); } return true; }
        if (mode == 3) { const int L = (int)L0; if (L < 256) { const int v = (L % 8) * 32 + L / 8; u.pm = v / 4; u.pn = v % 4; }
            else { const int l = L - 256, q = l & 1; u.pm = 64 + (l >> 3); u.pn = (l >> 1) & 3; u.q = q; u.nt = nN / 2; u.kofs = 64 * q * (nN / 2); } return true; }
        int L = (int)L0; { const int q = n / 8, r = n % 8, xcd = L % 8, off = L / 8; L = (xcd < r ? xcd * (q + 1) : r * (q + 1) + (xcd - r) * q) + off; }
        if (mode == 0) {
            if (L < 594) { u.pm = L / 9; u.pn = RT_WIN + L % 9; }
            else if (L < 658) { const int l = L - 594; u.pm = RT_MN + l / 8; u.pn = RT_WXKV + l % 8; }
            else if (L < 690) { const int l = L - 658; u.pm = RT_WXKV + 4 + l / 8; u.pn = RT_MN + l % 8; }
            else { u.pm = RT_WIN + 8; u.pn = L - 690; }
        } else { u.pm = L / nN; u.pn = L % nN; }
        return true;
    }
    __device__ __forceinline__ void a_ready(const pg8::Unit&) const {}
    __device__ __forceinline__ void done(const pg8::Unit&) const {}
};
struct EpiP1 {
    static constexpr bool PERM = false, AFTER_DRAIN = false;
    bf16_t* proj; bf16_t* mk; bf16_t* mv; bf16_t* mvt; bf16_t* kvt;
    __device__ __forceinline__ void operator()(const f32x4 (&acc)[2][2][4][2], const pg8::Unit& u, int wr, int wc, int fr, int fq) const {
        bf16_t* base; int ld;
        if (u.pm < RT_MN) { base = proj + (size_t)(u.pm * 256) * NPROJ + (u.pn - RT_WIN) * 256; ld = NPROJ; }
        else if (u.pm < RT_WIN) { const int ct = u.pn - RT_WXKV; base = (ct < 4 ? mk + ct * 256 : mv + (ct - 4) * 256) + (size_t)((u.pm - RT_MN) * 256) * 1024; ld = 1024; }
        else if (u.pm == RT_WIN + 8) { base = kvt + u.pn * 256; ld = TT; }
        else { base = mvt + (size_t)((u.pm - RT_WXKV - 4) * 256) * 2048 + (u.pn - RT_MN) * 256; ld = 2048; }
#pragma unroll
        for (int ai = 0; ai < 2; ++ai)
#pragma unroll
            for (int m = 0; m < 4; ++m) {
                bf16_t* rowp = base + (size_t)(128 * ai + 64 * wr + 16 * m + fr) * ld + 32 * wc + 4 * fq;
#pragma unroll
                for (int bj = 0; bj < 2; ++bj)
#pragma unroll
                    for (int n = 0; n < 2; ++n) { const f32x4 v = acc[ai][bj][m][n]; u32x2 w; w.x = pk2(v[0], v[1]); w.y = pk2(v[2], v[3]); *(u32x2*)(rowp + 128 * bj + 16 * n) = w; }
            }
    }
};
struct EpiBf {
    static constexpr bool PERM = false, AFTER_DRAIN = false;
    bf16_t* O; int ldc; float scale; float* part;
    __device__ __forceinline__ void operator()(const f32x4 (&acc)[2][2][4][2], const pg8::Unit& u, int wr, int wc, int fr, int fq) const {
        if (u.nt) {
#pragma unroll
            for (int ai = 0; ai < 2; ++ai)
#pragma unroll
                for (int m = 0; m < 4; ++m) { float* rowp = part + (size_t)u.q * 512 * 1024 + (size_t)((u.pm - 64) * 256 + 128 * ai + 64 * wr + 16 * m + fr) * 1024 + u.pn * 256 + 32 * wc + 4 * fq;
#pragma unroll
                    for (int bj = 0; bj < 2; ++bj)
#pragma unroll
                        for (int n = 0; n < 2; ++n) *(f32x4*)(rowp + 128 * bj + 16 * n) = acc[ai][bj][m][n]; }
            return;
        }
#pragma unroll
        for (int ai = 0; ai < 2; ++ai)
#pragma unroll
            for (int m = 0; m < 4; ++m) {
                bf16_t* rowp = O + (size_t)(u.pm * 256 + 128 * ai + 64 * wr + 16 * m + fr) * ldc + u.pn * 256 + 32 * wc + 4 * fq;
#pragma unroll
                for (int bj = 0; bj < 2; ++bj)
#pragma unroll
                    for (int n = 0; n < 2; ++n) { const f32x4 v = acc[ai][bj][m][n] * scale; u32x2 w; w.x = pk2(v[0], v[1]); w.y = pk2(v[2], v[3]); *(u32x2*)(rowp + 128 * bj + 16 * n) = w; }
            }
    }
};
struct EpiGU {
    static constexpr bool PERM = false, AFTER_DRAIN = false;
    bf16_t* O;
    __device__ __forceinline__ void operator()(const f32x4 (&acc)[2][2][4][2], const pg8::Unit& u, int wr, int wc, int fr, int fq) const {
#pragma unroll
        for (int ai = 0; ai < 2; ++ai)
#pragma unroll
            for (int m = 0; m < 4; ++m) {
                bf16_t* rowp = O + (size_t)(u.pm * 256 + 128 * ai + 64 * wr + 16 * m + fr) * DFF + u.pn * 128 + 16 * wc + 4 * fq;
#pragma unroll
                for (int bj = 0; bj < 2; ++bj) { const f32x4 g = acc[ai][bj][m][0], up = acc[ai][bj][m][1];
                    u32x2 w; w.x = pk2(silu_f(g[0]) * up[0], silu_f(g[1]) * up[1]); w.y = pk2(silu_f(g[2]) * up[2], silu_f(g[3]) * up[3]); *(u32x2*)(rowp + 64 * bj) = w; }
            }
    }
};

struct TrSrc { const float* lo; const float* hi; int ld; };
__device__ __forceinline__ void tr_item(const TrSrc s, int k0, bf16_t* dst, int K, LAS float* scr, int lane) {
    const float* p = (lane & 16) ? s.hi + (lane & 15) : s.lo + (lane & 15);
    float tv[32];
#pragma unroll
    for (int i = 0; i < 32; ++i) { const int kk = 2 * i + (lane >> 5); tv[i] = p[(size_t)(k0 + kk) * s.ld]; }
#pragma unroll
    for (int i = 0; i < 32; ++i) { const int kk = 2 * i + (lane >> 5); scr[kk * 33 + (lane & 31)] = tv[i]; }
    LDSW();
    const int c = lane & 7;
#pragma unroll
    for (int j = 0; j < 4; ++j) { const int n = (lane >> 3) + 8 * j; const LAS float* q = scr + (8 * c) * 33 + n;
        u32x4 o; o.x = pk2(q[0], q[33]); o.y = pk2(q[2 * 33], q[3 * 33]); o.z = pk2(q[4 * 33], q[5 * 33]); o.w = pk2(q[6 * 33], q[7 * 33]);
        *(u32x4*)(dst + (size_t)n * K + 8 * c) = o; }
    LDSW();
}
__device__ __forceinline__ void rms_apply(f32x4 (&v)[4], const float* g, int lane) {
    float ss = 0.f;
#pragma unroll
    for (int j = 0; j < 4; ++j) ss += (v[j][0] * v[j][0] + v[j][1] * v[j][1]) + (v[j][2] * v[j][2] + v[j][3] * v[j][3]);
    const float r = rsqrtf(wave_sum(ss) * (1.f / 1024.f) + EPS);
#pragma unroll
    for (int j = 0; j < 4; ++j) { const f32x4 gv = *(const f32x4*)(g + 4 * lane + 256 * j); v[j] = v[j] * r * gv; }
}
__device__ __forceinline__ void store_row_bf16(bf16_t* o, const f32x4 (&v)[4], int lane) {
#pragma unroll
    for (int j = 0; j < 4; ++j) { u32x2 w; w.x = pk2(v[j][0], v[j][1]); w.y = pk2(v[j][2], v[j][3]); *(u32x2*)(o + 4 * lane + 256 * j) = w; }
}
__device__ __forceinline__ void load_row_f32(f32x4 (&v)[4], const float* x, int lane) {
#pragma unroll
    for (int j = 0; j < 4; ++j) v[j] = *(const f32x4*)(x + 4 * lane + 256 * j);
}

__device__ __forceinline__ void tr_items(CP P, LAS unsigned char* lds, int part, int gw, int NGW, int wave, int lane) {
    unsigned char* ws = P->ws;
    LAS float* scr = (LAS float*)(lds + wave * 16384);
    constexpr int I_IN = 72 * 16, I_SQ = 512, I_GU = 176 * 16, I_DN = 32 * 44;
    const int nitems = part == 0 ? I_IN + 3 * I_SQ : 2 * I_SQ + I_GU + I_DN;
    for (int it = gw; it < nitems; it += NGW) {
        int r = it; TrSrc s; bf16_t* dst; int K = 1024, k0; int which = -1;
        if (part == 0) { if (r >= I_IN) { r -= I_IN; const int w3 = r / I_SQ; r %= I_SQ; which = w3 == 0 ? 0 : w3 + 2; } }
        else { if (r < 2 * I_SQ) { which = 1 + r / I_SQ; r %= I_SQ; } else r -= 2 * I_SQ; }
        if (part == 0 && which < 0) { const int nb = r / 16, kb = r % 16, n0 = nb * 32, sc = n0 + (n0 >= 1536 ? 8 : 0);
            s.lo = P->in[10] + sc; s.hi = s.lo + 16; s.ld = INDIM; k0 = kb * 64; dst = (bf16_t*)(ws + WS_WIN) + (size_t)n0 * 1024 + k0; }
        else if (which >= 0) { const int nb = r / 16, kb = r % 16;
            const float* W = which == 0 ? P->in[18] : which == 1 ? P->in[21] : which == 2 ? P->in[25] : which == 3 ? P->in[23] : P->in[24];
            bf16_t* D = which == 0 ? (bf16_t*)(ws + WS_WOUT) : which == 1 ? (bf16_t*)(ws + WS_WXQ) : which == 2 ? (bf16_t*)(ws + WS_WXO) : which == 3 ? (bf16_t*)(ws + WS_WXKV) : (bf16_t*)(ws + WS_WXKV) + (size_t)1024 * 1024;
            s.lo = W + nb * 32; s.hi = s.lo + 16; s.ld = 1024; k0 = kb * 64; dst = D + (size_t)nb * 32 * 1024 + k0; }
        else if (r < I_GU) { const int nb = r / 16, kb = r % 16;
            s.lo = P->in[28] + nb * 16; s.hi = P->in[29] + nb * 16; s.ld = DFF; k0 = kb * 64; dst = (bf16_t*)(ws + WS_WGU) + (size_t)nb * 32 * 1024 + k0; }
        else { r -= I_GU; const int nb = r / 44, kb = r % 44; K = DFF;
            s.lo = P->in[30] + nb * 32; s.hi = s.lo + 16; s.ld = 1024; k0 = kb * 64; dst = (bf16_t*)(ws + WS_WDN) + (size_t)nb * 32 * DFF + k0; }
        tr_item(s, k0, dst, K, scr, lane);
    }
}
__device__ __forceinline__ void phase_prologue(CP P, LAS unsigned char* lds, int gw, int NGW, int wave, int lane) {
    unsigned char* ws = P->ws;
    tr_items(P, lds, 0, gw, NGW, wave, lane);
    __syncthreads();
    LAS float* wT = (LAS float*)lds;
    { const int tid = wave * 64 + lane;
#pragma unroll
      for (int it = 0; it < 4; ++it) { const int idx = tid + 512 * it, c = idx >> 1, hf = idx & 1; const f32x4 w = *(const f32x4*)(P->in[10] + (size_t)c * INDIM + 1536 + 4 * hf);
          wT[(4 * hf + 0) * 1024 + c] = w[0]; wT[(4 * hf + 1) * 1024 + c] = w[1]; wT[(4 * hf + 2) * 1024 + c] = w[2]; wT[(4 * hf + 3) * 1024 + c] = w[3]; } }
    __syncthreads();
    {
        f32x4 nx[4];
        if (gw < TT) load_row_f32(nx, gw < TP ? P->in[0] + (size_t)gw * 1024 : P->in[1] + (size_t)(gw - TP) * 1024, lane);
        for (int m = gw; m < TT; m += NGW) {
            f32x4 v[4];
#pragma unroll
            for (int j = 0; j < 4; ++j) v[j] = nx[j];
            const int m2 = m + NGW;
            if (m2 < TT) load_row_f32(nx, m2 < TP ? P->in[0] + (size_t)m2 * 1024 : P->in[1] + (size_t)(m2 - TP) * 1024, lane);
            rms_apply(v, P->in[9], lane);
            store_row_bf16((bf16_t*)(ws + WS_H0) + (size_t)m * 1024, v, lane);
            float d[8];
#pragma unroll
            for (int e = 0; e < 8; ++e) { float a = 0.f;
#pragma unroll
                for (int j = 0; j < 4; ++j) { const f32x4 w = *(const LAS f32x4*)(wT + e * 1024 + 4 * lane + 256 * j); a += (v[j][0] * w[0] + v[j][1] * w[1]) + (v[j][2] * w[2] + v[j][3] * w[3]); }
                d[e] = wave_sum(a); }
            if (lane == 0) { float* o = (float*)(ws + WS_DTRAW) + (size_t)m * 8; *(f32x4*)o = (f32x4){d[0], d[1], d[2], d[3]}; *(f32x4*)(o + 4) = (f32x4){d[4], d[5], d[6], d[7]}; }
        }
    }
    __syncthreads();
    for (int m = gw; m < 2048; m += NGW) {
        f32x4 v[4]; load_row_f32(v, P->in[8] + (size_t)m * 1024, lane); rms_apply(v, P->in[22], lane);
        store_row_bf16((bf16_t*)(ws + WS_MN) + (size_t)m * 1024, v, lane);
    }
}

__device__ __forceinline__ void phase_resid(CP P, int stage, int gw, int NGW, int lane) {
    unsigned char* ws = P->ws; const bf16_t* C = (const bf16_t*)(ws + WS_CB16); bf16_t* XB = (bf16_t*)(ws + WS_X1);
    const float* g1 = stage == 0 ? P->in[19] : stage == 1 ? P->in[26] : P->in[31];
    const float* g2 = stage == 0 ? P->in[20] : P->in[27];
    for (int m = gw; m < TT; m += NGW) {
        f32x4 c[4], x[4];
        if (m >= TP) { const float* pp_ = (const float*)(ws + WS_SPLIT) + (size_t)(stage == 0 ? 0 : stage == 1 ? 8 : 12) * 512 * 1024 + (size_t)(m - TP) * 1024; f32x4 c1[4], c2[4], c3[4];
            load_row_f32(c, pp_, lane); load_row_f32(c1, pp_ + 512 * 1024, lane);
            if (stage == 2) { load_row_f32(c2, pp_ + 2 * 512 * 1024, lane); load_row_f32(c3, pp_ + 3 * 512 * 1024, lane); }
#pragma unroll
            for (int j = 0; j < 4; ++j) c[j] = stage == 2 ? (c[j] + c1[j]) + (c2[j] + c3[j]) : c[j] + c1[j]; }
        else {
#pragma unroll
        for (int j = 0; j < 4; ++j) { const u32x2 w = *(const u32x2*)(C + (size_t)m * 1024 + 4 * lane + 256 * j);
            c[j] = (f32x4){__uint_as_float(w.x << 16), __uint_as_float(w.x & 0xffff0000u), __uint_as_float(w.y << 16), __uint_as_float(w.y & 0xffff0000u)}; }
        }
        if (stage == 0) load_row_f32(x, m < TP ? P->in[0] + (size_t)m * 1024 : P->in[1] + (size_t)(m - TP) * 1024, lane);
        else {
#pragma unroll
            for (int j = 0; j < 4; ++j) { const u32x2 w = *(const u32x2*)(XB + (size_t)m * 1024 + 4 * lane + 256 * j);
                x[j] = (f32x4){__uint_as_float(w.x << 16), __uint_as_float(w.x & 0xffff0000u), __uint_as_float(w.y << 16), __uint_as_float(w.y & 0xffff0000u)}; }
        }
        rms_apply(c, g1, lane);
#pragma unroll
        for (int j = 0; j < 4; ++j) x[j] = x[j] + c[j];
        if (stage == 2) {
#pragma unroll
            for (int j = 0; j < 4; ++j) *(f32x4*)(P->out + (size_t)m * 1024 + 4 * lane + 256 * j) = x[j];
        } else {
#pragma unroll
            for (int j = 0; j < 4; ++j) { u32x2 w; w.x = pk2(x[j][0], x[j][1]); w.y = pk2(x[j][2], x[j][3]); *(u32x2*)(XB + (size_t)m * 1024 + 4 * lane + 256 * j) = w;
                x[j] = (f32x4){__uint_as_float(w.x << 16), __uint_as_float(w.x & 0xffff0000u), __uint_as_float(w.y << 16), __uint_as_float(w.y & 0xffff0000u)}; }
            rms_apply(x, g2, lane); store_row_bf16((bf16_t*)(ws + WS_H0) + (size_t)m * 1024, x, lane);
        }
    }
}

__device__ __forceinline__ void conv8(const bf16_t* col, int t0, bool zero_hist, const float (&w)[4], float bias, float (&out)[8], float (&raw)[11]) {
#pragma unroll
    for (int i = 0; i < 11; ++i) { const int r = t0 - 3 + i; raw[i] = (r < 0 && zero_hist) ? 0.f : bf2f(col[(long)r * NPROJ]); }
#pragma unroll
    for (int j = 0; j < 8; ++j) out[j] = silu_f(bias + w[0] * raw[j] + w[1] * raw[j + 1] + w[2] * raw[j + 2] + w[3] * raw[j + 3]);
}
__device__ __forceinline__ void conv8x2(const bf16_t* col, int t0, bool zero_hist, const float* cw, const float* cb, int ch, float (&o0)[8], float (&o1)[8]) {
    float r0[11], r1[11];
#pragma unroll
    for (int i = 0; i < 11; ++i) { const int r = t0 - 3 + i; unsigned w = 0u; if (!(r < 0 && zero_hist)) w = *(const unsigned*)(col + (long)r * NPROJ); r0[i] = __uint_as_float(w << 16); r1[i] = __uint_as_float(w & 0xffff0000u); }
    const float b0 = cb[ch], b1 = cb[ch + 1];
    float w0[4], w1[4];
#pragma unroll
    for (int j = 0; j < 4; ++j) { w0[j] = cw[j * 1024 + ch]; w1[j] = cw[j * 1024 + ch + 1]; }
#pragma unroll
    for (int j = 0; j < 8; ++j) { o0[j] = silu_f(b0 + w0[0] * r0[j] + w0[1] * r0[j + 1] + w0[2] * r0[j + 2] + w0[3] * r0[j + 3]);
                                  o1[j] = silu_f(b1 + w1[0] * r1[j] + w1[1] * r1[j + 1] + w1[2] * r1[j + 2] + w1[3] * r1[j + 3]); }
}
__device__ __forceinline__ void dt_acum(CP P, int row0, int g, LAS float* dtv, LAS float* acum, int wave, int lane) {
    if (wave < 4) {
        const int h = g * 4 + wave; const float* dr = (const float*)(P->ws + WS_DTRAW);
        const float bias = P->in[13][h], a = -__expf(P->in[14][h]);
        const float d0 = softplus_f(dr[(size_t)(row0 + 2 * lane) * 8 + h] + bias), d1 = softplus_f(dr[(size_t)(row0 + 2 * lane + 1) * 8 + h] + bias);
        const float a0 = a * d0, a1 = a * d1; float s = a0 + a1;
#pragma unroll
        for (int o = 1; o < 64; o <<= 1) { const float t = __shfl_up(s, o); if (lane >= o) s += t; }
        dtv[(2 * lane) * 4 + wave] = d0; dtv[(2 * lane + 1) * 4 + wave] = d1;
        acum[(2 * lane) * 4 + wave] = s - a1; acum[(2 * lane + 1) * 4 + wave] = s;
    }
}

constexpr int PT = 136;
__device__ __forceinline__ void ssd_pass_a(CP P, LAS unsigned char* lds, int unit, int tid, int wave, int lane) {
    const int b = unit >> 5, c = (unit >> 1) & 15, g = unit & 1, row0 = b * SEQ + c * 128;
    LAS bf16_t* BT = (LAS bf16_t*)lds;
    LAS bf16_t* XW = (LAS bf16_t*)(lds + 128 * PT * 2);
    LAS float* dtv = (LAS float*)(lds + 384 * PT * 2); LAS float* acum = dtv + 512;
    const bf16_t* proj = (const bf16_t*)(P->ws + WS_PROJ);
    dt_acum(P, row0, g, dtv, acum, wave, lane);
    __syncthreads();
#pragma unroll 3
    for (int kk_ = 0; kk_ < 6; ++kk_) {
        const int it = tid + 512 * kk_;
        const int pr = it % 192, tb = it / 192, t0 = tb * 8, chl = 2 * pr;
        const int ch = chl < 256 ? g * 256 + chl : 512 + g * 128 + (chl - 256);
        float o0[8], o1[8]; conv8x2(proj + (size_t)row0 * NPROJ + 512 + ch, t0, c == 0, P->in[11], P->in[12], ch, o0, o1);
        if (chl < 256) { const int hh = chl >> 6; const float aend = acum[127 * 4 + hh];
#pragma unroll
            for (int j = 0; j < 8; ++j) { const float wg = dtv[(t0 + j) * 4 + hh] * __expf(aend - acum[(t0 + j) * 4 + hh]); o0[j] *= wg; o1[j] *= wg; } }
        u32x4 pk0, pk1; pk0.x = pk2(o0[0], o0[1]); pk0.y = pk2(o0[2], o0[3]); pk0.z = pk2(o0[4], o0[5]); pk0.w = pk2(o0[6], o0[7]);
        pk1.x = pk2(o1[0], o1[1]); pk1.y = pk2(o1[2], o1[3]); pk1.z = pk2(o1[4], o1[5]); pk1.w = pk2(o1[6], o1[7]);
        LAS bf16_t* d = chl < 256 ? XW + chl * PT + t0 : BT + (chl - 256) * PT + t0;
        *(LAS u32x4*)d = pk0; *(LAS u32x4*)(d + PT) = pk1;
    }
    __syncthreads();
    float* cs = (float*)(P->ws + WS_CS) + (size_t)((b * 16 + c) * 8 + g * 4) * 8192;
#pragma unroll
    for (int mt = 0; mt < 2; ++mt) {
        f32x4 acc[8];
#pragma unroll
        for (int n = 0; n < 8; ++n) acc[n] = (f32x4){0.f, 0.f, 0.f, 0.f};
        const int r0 = 32 * wave + 16 * mt;
        mma_lds<8>(acc, XW + r0 * PT, PT, BT, PT, 128, lane);
        const int fr = lane & 15, fq = lane >> 4;
#pragma unroll
        for (int n = 0; n < 8; ++n) *(f32x4*)(cs + (size_t)(r0 + fr) * 128 + 16 * n + 4 * fq) = acc[n];
    }
    if (tid < 4) ((float*)(P->ws + WS_ATOT))[(b * 16 + c) * 8 + g * 4 + tid] = acum[127 * 4 + tid];
    __syncthreads();
}

__device__ __forceinline__ void ssd_state_scan(CP P, int bid, int G, int tid) {
    for (int base_ = bid * 512; base_ < 8 * 8 * 2048; base_ += G * 512) {
        const int i = base_ + tid, bh = i >> 11, e4 = i & 2047, b = bh >> 3, h = bh & 7;
        float* cs = (float*)(P->ws + WS_CS) + (size_t)(b * 16 * 8 + h) * 8192 + 4 * e4;
        const float* at = (const float*)(P->ws + WS_ATOT) + b * 16 * 8 + h;
        f32x4 v[16]; float dec[16];
#pragma unroll
        for (int c = 0; c < 16; ++c) { v[c] = *(const f32x4*)(cs + (size_t)c * 8 * 8192); dec[c] = __expf(at[c * 8]); }
        f32x4 st = (f32x4){0.f, 0.f, 0.f, 0.f};
#pragma unroll
        for (int c = 0; c < 16; ++c) { *(f32x4*)(cs + (size_t)c * 8 * 8192) = st; st = st * dec[c] + v[c]; }
        *(f32x4*)(P->out + O_PSSM + (size_t)(b * 8 + h) * 8192 + 4 * e4) = st;
    }
}

__device__ __forceinline__ void ssd_pass_b(CP P, LAS unsigned char* lds, int unit, int tid, int wave, int lane) {
    const int b = unit >> 5, c = (unit >> 1) & 15, g = unit & 1, row0 = b * SEQ + c * 128;
    const int fr = lane & 15, fq = lane >> 4;
    LAS bf16_t* Cs = (LAS bf16_t*)lds;
    LAS bf16_t* Bs = (LAS bf16_t*)(lds + 128 * PT * 2);
    LAS bf16_t* XT = (LAS bf16_t*)(lds + 256 * PT * 2);
    LAS bf16_t* SI = (LAS bf16_t*)(lds + 320 * PT * 2);
    LAS float* dtv = (LAS float*)(lds + 384 * PT * 2); LAS float* acum = dtv + 512;
    const bf16_t* proj = (const bf16_t*)(P->ws + WS_PROJ);
    dt_acum(P, row0, g, dtv, acum, wave, lane);
#pragma unroll 4
    for (int kk_ = 0; kk_ < 4; ++kk_) {
        const int it = tid + 512 * kk_;
        const int chl = 2 * (it & 127), tb = it >> 7, t0 = tb * 8;
        const int ch = chl < 128 ? 512 + g * 128 + chl : 768 + g * 128 + (chl - 128);
        float o0[8], o1[8]; conv8x2(proj + (size_t)row0 * NPROJ + 512 + ch, t0, c == 0, P->in[11], P->in[12], ch, o0, o1);
        LAS bf16_t* d = chl < 128 ? Bs + chl : Cs + (chl - 128);
#pragma unroll
        for (int j = 0; j < 8; ++j) *(LAS unsigned*)(d + (t0 + j) * PT) = pk2(o0[j], o1[j]);
    }
    if (c == 15) {
        const int ch = tid < 256 ? g * 256 + tid : (tid < 384 ? 512 + g * 128 + (tid - 256) : 768 + g * 128 + (tid - 384));
#pragma unroll
        for (int i = 0; i < 3; ++i) P->out[O_PCONV + (size_t)(b * 3 + i) * 1024 + ch] = bf2f(proj[(size_t)(row0 + 125 + i) * NPROJ + 512 + ch]);
    }
    __syncthreads();
    f32x4 cb[8];
#pragma unroll
    for (int n = 0; n < 8; ++n) cb[n] = (f32x4){0.f, 0.f, 0.f, 0.f};
    mma_lds<8>(cb, Cs + 16 * wave * PT, PT, Bs, PT, 128, lane);
    __syncthreads();
    LAS bf16_t* Ls = Bs;
    const int t = 16 * wave + fr;
    float ss = 0.f;
    const bf16_t* zr = proj + (size_t)(row0 + t) * NPROJ + g * 256;
    bf16_t* orow = (bf16_t*)(P->ws + WS_MIXIN) + (size_t)(row0 + t) * 1024 + g * 256;
#pragma unroll 1
    for (int hh = 0; hh < 4; ++hh) {
        const int h = g * 4 + hh;
        u32x2 zw4[4];
#pragma unroll
        for (int n = 0; n < 4; ++n) zw4[n] = *(const u32x2*)(zr + hh * 64 + 16 * n + 4 * fq);
        {
            const int p = 2 * (tid & 31), tb = tid >> 5, t0 = tb * 8, ch = h * 64 + p;
            float o0[8], o1[8]; conv8x2(proj + (size_t)row0 * NPROJ + 512 + ch, t0, c == 0, P->in[11], P->in[12], ch, o0, o1);
            u32x4 pk0, pk1; pk0.x = pk2(o0[0], o0[1]); pk0.y = pk2(o0[2], o0[3]); pk0.z = pk2(o0[4], o0[5]); pk0.w = pk2(o0[6], o0[7]);
            pk1.x = pk2(o1[0], o1[1]); pk1.y = pk2(o1[2], o1[3]); pk1.z = pk2(o1[4], o1[5]); pk1.w = pk2(o1[6], o1[7]);
            *(LAS u32x4*)(XT + p * PT + t0) = pk0; *(LAS u32x4*)(XT + (p + 1) * PT + t0) = pk1;
        }
        {
            const int p = tid >> 3, n0 = (tid & 7) * 16;
            const float* src = (const float*)(P->ws + WS_CS) + (size_t)((b * 16 + c) * 8 + h) * 8192 + p * 128 + n0;
#pragma unroll
            for (int q = 0; q < 4; ++q) { const f32x4 sv = *(const f32x4*)(src + 4 * q); u32x2 w2; w2.x = pk2(sv[0], sv[1]); w2.y = pk2(sv[2], sv[3]); *(LAS u32x2*)(SI + p * PT + n0 + 4 * q) = w2; }
        }
        {
            const float at_ = acum[t * 4 + hh];
#pragma unroll
            for (int n = 0; n < 8; ++n) {
                float l[4];
#pragma unroll
                for (int e = 0; e < 4; ++e) { const int s_ = 16 * n + 4 * fq + e; l[e] = (s_ <= t) ? cb[n][e] * __expf(at_ - acum[s_ * 4 + hh]) * dtv[s_ * 4 + hh] : 0.f; }
                u32x2 w2; w2.x = pk2(l[0], l[1]); w2.y = pk2(l[2], l[3]); *(LAS u32x2*)(Ls + t * PT + 16 * n + 4 * fq) = w2;
            }
        }
        __syncthreads();
        {
            f32x4 yd[4], yo[4];
#pragma unroll
            for (int n = 0; n < 4; ++n) { yd[n] = (f32x4){0.f, 0.f, 0.f, 0.f}; yo[n] = (f32x4){0.f, 0.f, 0.f, 0.f}; }
            mma_lds<4>(yd, Ls + 16 * wave * PT, PT, XT, PT, 128, lane);
            mma_lds<4>(yo, Cs + 16 * wave * PT, PT, SI, PT, 128, lane);
            const float ea = __expf(acum[t * 4 + hh]), dsk = P->in[15][h];
#pragma unroll
            for (int n = 0; n < 4; ++n) {
                const u32x2 zw = zw4[n];
                const float z[4] = {__uint_as_float(zw.x << 16), __uint_as_float(zw.x & 0xffff0000u), __uint_as_float(zw.y << 16), __uint_as_float(zw.y & 0xffff0000u)};
                float u[4];
#pragma unroll
                for (int e = 0; e < 4; ++e) { u[e] = (yd[n][e] + ea * yo[n][e] + dsk * bf2f(XT[(16 * n + 4 * fq + e) * PT + t])) * silu_f(z[e]); ss += u[e] * u[e]; }
                u32x2 w2; w2.x = pk2(u[0], u[1]); w2.y = pk2(u[2], u[3]); *(u32x2*)(orow + hh * 64 + 16 * n + 4 * fq) = w2;
            }
        }
        __syncthreads();
    }
    {
        ss += __shfl_xor(ss, 16); ss += __shfl_xor(ss, 32);
        const float r = rsqrtf(ss * (1.f / 256.f) + EPS);
#pragma unroll
        for (int hh = 0; hh < 4; ++hh)
#pragma unroll
            for (int n = 0; n < 4; ++n) { const int col = hh * 64 + 16 * n + 4 * fq; const f32x4 gv = *(const f32x4*)(P->in[16] + g * 256 + col);
                const u32x2 uw = *(const u32x2*)(orow + col);
                const float u0 = __uint_as_float(uw.x << 16) * r * gv[0], u1 = __uint_as_float(uw.x & 0xffff0000u) * r * gv[1], u2 = __uint_as_float(uw.y << 16) * r * gv[2], u3 = __uint_as_float(uw.y & 0xffff0000u) * r * gv[3];
                u32x2 w2; w2.x = pk2(u0, u1); w2.y = pk2(u2, u3); *(u32x2*)(orow + col) = w2; }
    }
    __syncthreads();
}

constexpr int PK = 72, PV = 264;
__device__ __forceinline__ void swa_prompt(CP P, LAS unsigned char* lds, int unit, int tid, int wave, int lane) {
    const int b = unit >> 5, nb = (unit >> 1) & 15, kvh = unit & 1, row0 = b * SEQ + nb * 128;
    const int fr = lane & 15, fq = lane >> 4;
    LAS bf16_t* Ks = (LAS bf16_t*)lds;
    LAS bf16_t* VT = (LAS bf16_t*)(lds + 256 * PK * 2);
    const bf16_t* proj = (const bf16_t*)(P->ws + WS_PROJ); const bf16_t* kvt = (const bf16_t*)(P->ws + WS_KVT);
#pragma unroll
    for (int kk_ = 0; kk_ < 4; ++kk_) {
        const int ci = tid + 512 * kk_;
        { const int row = ci >> 3, c8 = ci & 7; u32x4 v = (u32x4){0u, 0u, 0u, 0u};
          if (!(nb == 0 && row < 128)) v = *(const u32x4*)(proj + (size_t)(row0 - 128 + row) * NPROJ + 2048 + kvh * 64 + c8 * 8);
          *(LAS u32x4*)(Ks + row * PK + c8 * 8) = v; }
        { const int d = ci >> 5, c = ci & 31; u32x4 v = (u32x4){0u, 0u, 0u, 0u};
          if (!(nb == 0 && c < 16)) v = *(const u32x4*)(kvt + (size_t)(128 + kvh * 64 + d) * TT + row0 - 128 + c * 8);
          *(LAS u32x4*)(VT + d * PV + c * 8) = v; }
    }
    __syncthreads();
    const int r = wave >> 1, head = kvh * 4 + r; const float sink = P->in[17][head];
    bf16x8 qn[2];
#pragma unroll
    for (int ks = 0; ks < 2; ++ks) qn[ks] = *(const bf16x8*)(proj + (size_t)(row0 + (wave & 1) * 64 + fr) * NPROJ + 1536 + head * 64 + ks * 32 + 8 * fq);
    for (int st = 0; st < 4; ++st) {
        const int q0 = (wave & 1) * 64 + 16 * st, qi = q0 + fr;
        bf16x8 qf[2];
#pragma unroll
        for (int ks = 0; ks < 2; ++ks) qf[ks] = qn[ks];
        if (st < 3) {
#pragma unroll
            for (int ks = 0; ks < 2; ++ks) qn[ks] = *(const bf16x8*)(proj + (size_t)(row0 + qi + 16) * NPROJ + 1536 + head * 64 + ks * 32 + 8 * fq);
        }
        f32x4 s[16];
#pragma unroll
        for (int n = 0; n < 16; ++n) s[n] = (f32x4){0.f, 0.f, 0.f, 0.f};
        mma_areg<16, 2, 0, 2>(s, qf, Ks, PK, lane);
        float mx = sink;
#pragma unroll
        for (int n = 0; n < 16; ++n)
#pragma unroll
            for (int e = 0; e < 4; ++e) { const int kj = 16 * n + 4 * fq + e; const bool ok = (kj > qi) && (kj <= qi + 128) && (nb > 0 || kj >= 128);
                const float v = ok ? s[n][e] * 0.125f : -INFINITY; s[n][e] = v; mx = fmaxf(mx, v); }
        mx = fmaxf(mx, __shfl_xor(mx, 16)); mx = fmaxf(mx, __shfl_xor(mx, 32));
        float sum = 0.f;
#pragma unroll
        for (int n = 0; n < 16; ++n)
#pragma unroll
            for (int e = 0; e < 4; ++e) { const float ev = __expf(s[n][e] - mx); s[n][e] = ev; sum += ev; }
        sum += __shfl_xor(sum, 16); sum += __shfl_xor(sum, 32);
        const float inv = 1.f / (sum + __expf(sink - mx));
        bf16x8 pf[8];
#pragma unroll
        for (int ks = 0; ks < 8; ++ks) { u32x4 w; w.x = pk2(s[2 * ks][0] * inv, s[2 * ks][1] * inv); w.y = pk2(s[2 * ks][2] * inv, s[2 * ks][3] * inv);
            w.z = pk2(s[2 * ks + 1][0] * inv, s[2 * ks + 1][1] * inv); w.w = pk2(s[2 * ks + 1][2] * inv, s[2 * ks + 1][3] * inv); pf[ks] = __builtin_bit_cast(bf16x8, w); }
        f32x4 o[4];
#pragma unroll
        for (int n = 0; n < 4; ++n) o[n] = (f32x4){0.f, 0.f, 0.f, 0.f};
#pragma unroll
        for (int ks = 0; ks < 8; ++ks) {
#pragma unroll
            for (int n = 0; n < 4; ++n) {
                const LAS bf16_t* vp = VT + (16 * n + fr) * PV + 32 * ks + 4 * fq;
                const u32x2 a0 = *(const LAS u32x2*)vp, a1 = *(const LAS u32x2*)(vp + 16);
                o[n] = __builtin_amdgcn_mfma_f32_16x16x32_bf16(__builtin_bit_cast(bf16x8, (u32x4){a0.x, a0.y, a1.x, a1.y}), pf[ks], o[n], 0, 0, 0);
            }
            __builtin_amdgcn_sched_barrier(0);
        }
        asm volatile("s_nop 7\n\ts_nop 7\n\ts_nop 7" ::: "memory");
        bf16_t* op = (bf16_t*)(P->ws + WS_MIXIN) + (size_t)(row0 + qi) * 1024 + 512 + head * 64 + 4 * fq;
#pragma unroll
        for (int n = 0; n < 4; ++n) { u32x2 w2; w2.x = pk2(o[n][0], o[n][1]); w2.y = pk2(o[n][2], o[n][3]); *(u32x2*)(op + 16 * n) = w2; }
        LDSW();
    }
    __syncthreads();
}

__device__ __forceinline__ void ssd_sample(CP P, LAS unsigned char* lds, int unit, int tid, int wave, int lane) {
    const int b = unit >> 1, g = unit & 1, row0 = TP + b * 4;
    LAS float* xs = (LAS float*)lds;
    LAS float* Bsm = xs + 1024;
    LAS float* Csm = Bsm + 512;
    LAS float* ys = Csm + 512;
    LAS float* dts = ys + 1024;
    const bf16_t* proj = (const bf16_t*)(P->ws + WS_PROJ);
    {
        const int ch = tid < 256 ? g * 256 + tid : (tid < 384 ? 512 + g * 128 + (tid - 256) : 768 + g * 128 + (tid - 384));
        float up[7];
#pragma unroll
        for (int i = 0; i < 3; ++i) up[i] = P->in[3][(size_t)(b * 3 + i) * 1024 + ch];
#pragma unroll
        for (int i = 0; i < 4; ++i) up[3 + i] = bf2f(proj[(size_t)(row0 + i) * NPROJ + 512 + ch]);
        float w[4];
#pragma unroll
        for (int j = 0; j < 4; ++j) w[j] = P->in[11][j * 1024 + ch];
        const float bias = P->in[12][ch];
        LAS float* dst = tid < 256 ? xs + tid : (tid < 384 ? Bsm + (tid - 256) : Csm + (tid - 384)); const int pitch = tid < 256 ? 256 : 128;
#pragma unroll
        for (int i = 0; i < 4; ++i) dst[i * pitch] = silu_f(bias + w[0] * up[i] + w[1] * up[i + 1] + w[2] * up[i + 2] + w[3] * up[i + 3]);
#pragma unroll
        for (int i = 0; i < 3; ++i) P->out[O_SCONV + (size_t)(b * 3 + i) * 1024 + ch] = up[4 + i];
        if (tid < 16) { const int tt = tid >> 2, hh = tid & 3, h = g * 4 + hh; dts[tid] = softplus_f(((const float*)(P->ws + WS_DTRAW))[(size_t)(row0 + tt) * 8 + h] + P->in[13][h]); }
    }
    __syncthreads();
    const int p = tid >> 3, n0 = (tid & 7) * 16;
    f32x4 stv[4][4];
#pragma unroll
    for (int hh = 0; hh < 4; ++hh)
#pragma unroll
        for (int q = 0; q < 4; ++q) stv[hh][q] = *(const f32x4*)(P->in[2] + (size_t)((b * 8 + g * 4 + hh) * 64 + p) * 128 + n0 + 4 * q);
#pragma unroll
    for (int hh = 0; hh < 4; ++hh) {
        const int h = g * 4 + hh; const float a = -__expf(P->in[14][h]), dsk = P->in[15][h];
        float st[16];
#pragma unroll
        for (int q = 0; q < 4; ++q) { const f32x4 v = stv[hh][q]; st[4 * q] = v[0]; st[4 * q + 1] = v[1]; st[4 * q + 2] = v[2]; st[4 * q + 3] = v[3]; }
#pragma unroll
        for (int tt = 0; tt < 4; ++tt) {
            const float dt = dts[tt * 4 + hh], dA = __expf(a * dt), xv = xs[tt * 256 + hh * 64 + p], dx = dt * xv; float yv = 0.f;
#pragma unroll
            for (int q = 0; q < 16; ++q) { st[q] = dA * st[q] + dx * Bsm[tt * 128 + n0 + q]; yv += st[q] * Csm[tt * 128 + n0 + q]; }
            yv += __shfl_xor(yv, 1); yv += __shfl_xor(yv, 2); yv += __shfl_xor(yv, 4);
            if ((tid & 7) == 0) ys[tt * 256 + hh * 64 + p] = yv + dsk * xv;
        }
        float* op = P->out + O_SSSM + (size_t)((b * 8 + h) * 64 + p) * 128 + n0;
#pragma unroll
        for (int q = 0; q < 4; ++q) *(f32x4*)(op + 4 * q) = (f32x4){st[4 * q], st[4 * q + 1], st[4 * q + 2], st[4 * q + 3]};
    }
    __syncthreads();
    if (wave < 4) {
        const int tt = wave; const bf16_t* zr = proj + (size_t)(row0 + tt) * NPROJ + g * 256 + 4 * lane;
        const u32x2 zw = *(const u32x2*)zr; const float z[4] = {__uint_as_float(zw.x << 16), __uint_as_float(zw.x & 0xffff0000u), __uint_as_float(zw.y << 16), __uint_as_float(zw.y & 0xffff0000u)};
        float u[4], ss = 0.f;
#pragma unroll
        for (int e = 0; e < 4; ++e) { u[e] = ys[tt * 256 + 4 * lane + e] * silu_f(z[e]); ss += u[e] * u[e]; }
        const float r = rsqrtf(wave_sum(ss) * (1.f / 256.f) + EPS); const f32x4 gv = *(const f32x4*)(P->in[16] + g * 256 + 4 * lane);
        u32x2 w2; w2.x = pk2(u[0] * r * gv[0], u[1] * r * gv[1]); w2.y = pk2(u[2] * r * gv[2], u[3] * r * gv[3]);
        *(u32x2*)((bf16_t*)(P->ws + WS_MIXIN) + (size_t)(row0 + tt) * 1024 + g * 256 + 4 * lane) = w2;
    }
    __syncthreads();
}

__device__ __forceinline__ void swa_sample(CP P, LAS unsigned char* lds, int unit, int tid, int wave, int lane) {
    const int b = unit >> 1, kvh = unit & 1, row0 = TP + b * 4;
    LAS float* Kf = (LAS float*)lds;
    LAS float* Vf = Kf + 132 * 65;
    LAS float* qf = Vf + 132 * 64;
    LAS float* sc = qf + 16 * 65;
    const bf16_t* proj = (const bf16_t*)(P->ws + WS_PROJ);
    {
        f32x4 kq[5], vq[5];
#pragma unroll
        for (int it = 0; it < 5; ++it) {
            const int i4 = tid + 512 * it, kk = i4 >> 4, d4 = (i4 & 15) * 4; kq[it] = (f32x4){0.f, 0.f, 0.f, 0.f}; vq[it] = kq[it];
            if (i4 < 132 * 16) {
                if (kk < 128) { const size_t o = (size_t)((b * 128 + kk) * 2 + kvh) * 64 + d4; kq[it] = *(const f32x4*)(P->in[4] + o); vq[it] = *(const f32x4*)(P->in[5] + o); }
                else { const bf16_t* pr = proj + (size_t)(row0 + kk - 128) * NPROJ + kvh * 64 + d4; const u32x2 a = *(const u32x2*)(pr + 2048), c = *(const u32x2*)(pr + 2176);
                    kq[it] = (f32x4){__uint_as_float(a.x << 16), __uint_as_float(a.x & 0xffff0000u), __uint_as_float(a.y << 16), __uint_as_float(a.y & 0xffff0000u)};
                    vq[it] = (f32x4){__uint_as_float(c.x << 16), __uint_as_float(c.x & 0xffff0000u), __uint_as_float(c.y << 16), __uint_as_float(c.y & 0xffff0000u)}; }
            }
        }
#pragma unroll
        for (int it = 0; it < 5; ++it) {
            const int i4 = tid + 512 * it, kk = i4 >> 4, d4 = (i4 & 15) * 4;
            if (i4 < 132 * 16) { Kf[kk * 65 + d4] = kq[it][0]; Kf[kk * 65 + d4 + 1] = kq[it][1]; Kf[kk * 65 + d4 + 2] = kq[it][2]; Kf[kk * 65 + d4 + 3] = kq[it][3]; *(LAS f32x4*)(Vf + kk * 64 + d4) = vq[it]; }
        }
    }
    for (int kk_ = 0; kk_ < 2; ++kk_) { const int i = tid + 512 * kk_; const int r16 = i >> 6, d = i & 63, tt = r16 >> 2, r = r16 & 3;
        qf[r16 * 65 + d] = bf2f(proj[(size_t)(row0 + tt) * NPROJ + 1536 + (kvh * 4 + r) * 64 + d]); }
    __syncthreads();
    { const int r16 = tid & 15, kg = tid >> 4, tt = r16 >> 2;
      for (int j_ = 0; j_ < 5; ++j_) {
          const int kk = kg + 32 * j_; if (kk >= 132) continue;
          float s = 0.f;
#pragma unroll 16
          for (int d = 0; d < 64; ++d) s += qf[r16 * 65 + d] * Kf[kk * 65 + d];
          const bool ok = kk < 128 ? (kk >= tt + 1) : (kk - 128 <= tt);
          sc[r16 * 136 + kk] = ok ? s * 0.125f : -INFINITY;
      } }
    __syncthreads();
#pragma unroll
    for (int rr = 0; rr < 2; ++rr) {
        const int r16 = 2 * wave + rr; const float sink = P->in[17][kvh * 4 + (r16 & 3)];
        float v[3]; float mx = sink;
#pragma unroll
        for (int j = 0; j < 3; ++j) { const int kk = lane + 64 * j; v[j] = kk < 132 ? sc[r16 * 136 + kk] : -INFINITY; mx = fmaxf(mx, v[j]); }
        mx = wave_max(mx); float sum = 0.f;
#pragma unroll
        for (int j = 0; j < 3; ++j) { v[j] = __expf(v[j] - mx); sum += v[j]; }
        const float inv = 1.f / (wave_sum(sum) + __expf(sink - mx));
#pragma unroll
        for (int j = 0; j < 3; ++j) { const int kk = lane + 64 * j; if (kk < 132) sc[r16 * 136 + kk] = v[j] * inv; }
    }
    __syncthreads();
    { const int r16 = tid >> 5, d2 = (tid & 31) * 2, tt = r16 >> 2, r = r16 & 3; float o0 = 0.f, o1 = 0.f;
      for (int kk = 0; kk < 132; ++kk) { const float p = sc[r16 * 136 + kk]; o0 += p * Vf[kk * 64 + d2]; o1 += p * Vf[kk * 64 + d2 + 1]; }
      *(unsigned*)((bf16_t*)(P->ws + WS_MIXIN) + (size_t)(row0 + tt) * 1024 + 512 + (kvh * 4 + r) * 64 + d2) = pk2(o0, o1); }
    __syncthreads();
}

__device__ __forceinline__ void xattn_prompt(CP P, LAS unsigned char* lds, int unit, int tid, int wave, int lane) {
    const int b = unit >> 6, h = (unit >> 4) & 3, qb = unit & 15;
    const int fr = lane & 15, fq = lane >> 4;
    LAS bf16_t* KV = (LAS bf16_t*)lds;
    LAS bf16_t* Ps = (LAS bf16_t*)(lds + 256 * PK * 2) + wave * 16 * PV;
    const bf16_t* q2 = (const bf16_t*)(P->ws + WS_Q2); const bf16_t* mk = (const bf16_t*)(P->ws + WS_MK); const bf16_t* mvt = (const bf16_t*)(P->ws + WS_MVT);
    const int row = b * SEQ + qb * 128 + 16 * wave + fr;
    f32x4 s[16];
#pragma unroll
    for (int n = 0; n < 16; ++n) s[n] = (f32x4){0.f, 0.f, 0.f, 0.f};
    u32x4 tmp[4];
#define XLOADK(dcv) { _Pragma("unroll") for (int it = 0; it < 4; ++it) { const int ci = tid + 512 * it, m = ci >> 3, c8 = ci & 7; tmp[it] = *(const u32x4*)(mk + (size_t)(b * 256 + m) * 1024 + h * 256 + (dcv) * 64 + c8 * 8); } }
#define XLOADV(dcv) { _Pragma("unroll") for (int it = 0; it < 4; ++it) { const int ci = tid + 512 * it, d = ci >> 5, c = ci & 31; tmp[it] = *(const u32x4*)(mvt + (size_t)(h * 256 + (dcv) * 64 + d) * 2048 + b * 256 + c * 8); } }
    XLOADK(0)
    for (int dc = 0; dc < 4; ++dc) {
        bf16x8 qf[2];
#pragma unroll
        for (int ks = 0; ks < 2; ++ks) qf[ks] = *(const bf16x8*)(q2 + (size_t)row * 1024 + h * 256 + dc * 64 + ks * 32 + 8 * fq);
        __syncthreads();
#pragma unroll
        for (int it = 0; it < 4; ++it) { const int ci = tid + 512 * it, m = ci >> 3, c8 = ci & 7; *(LAS u32x4*)(KV + m * PK + c8 * 8) = tmp[it]; }
        if (dc < 3) XLOADK(dc + 1) else XLOADV(0)
        __syncthreads();
        mma_areg<16, 2, 0, 2>(s, qf, KV, PK, lane);
    }
    float mx = -INFINITY;
#pragma unroll
    for (int n = 0; n < 16; ++n)
#pragma unroll
        for (int e = 0; e < 4; ++e) { s[n][e] *= 0.0625f; mx = fmaxf(mx, s[n][e]); }
    mx = fmaxf(mx, __shfl_xor(mx, 16)); mx = fmaxf(mx, __shfl_xor(mx, 32));
    float sum = 0.f;
#pragma unroll
    for (int n = 0; n < 16; ++n)
#pragma unroll
        for (int e = 0; e < 4; ++e) { const float ev = __expf(s[n][e] - mx); s[n][e] = ev; sum += ev; }
    sum += __shfl_xor(sum, 16); sum += __shfl_xor(sum, 32);
    const float inv = 1.f / sum;
    bf16x8 pf[8];
#pragma unroll
    for (int ks = 0; ks < 8; ++ks) { u32x4 w; w.x = pk2(s[2 * ks][0] * inv, s[2 * ks][1] * inv); w.y = pk2(s[2 * ks][2] * inv, s[2 * ks][3] * inv);
        w.z = pk2(s[2 * ks + 1][0] * inv, s[2 * ks + 1][1] * inv); w.w = pk2(s[2 * ks + 1][2] * inv, s[2 * ks + 1][3] * inv); pf[ks] = __builtin_bit_cast(bf16x8, w); }
    for (int dc = 0; dc < 4; ++dc) {
        __syncthreads();
#pragma unroll
        for (int it = 0; it < 4; ++it) { const int ci = tid + 512 * it, d = ci >> 5, c = ci & 31; *(LAS u32x4*)(KV + d * PV + c * 8) = tmp[it]; }
        if (dc < 3) XLOADV(dc + 1)
        __syncthreads();
        f32x4 o[4];
#pragma unroll
        for (int n = 0; n < 4; ++n) o[n] = (f32x4){0.f, 0.f, 0.f, 0.f};
#pragma unroll
        for (int ks = 0; ks < 8; ++ks) {
#pragma unroll
            for (int n = 0; n < 4; ++n) {
                const LAS bf16_t* vp = KV + (16 * n + fr) * PV + 32 * ks + 4 * fq;
                const u32x2 a0 = *(const LAS u32x2*)vp, a1 = *(const LAS u32x2*)(vp + 16);
                const u32x4 av = (u32x4){a0.x, a0.y, a1.x, a1.y};
                o[n] = __builtin_amdgcn_mfma_f32_16x16x32_bf16(__builtin_bit_cast(bf16x8, av), pf[ks], o[n], 0, 0, 0);
            }
            __builtin_amdgcn_sched_barrier(0);
        }
        bf16_t* op = (bf16_t*)(P->ws + WS_OX) + (size_t)row * 1024 + h * 256 + dc * 64 + 4 * fq;
#pragma unroll
        for (int n = 0; n < 4; ++n) { u32x2 w2; w2.x = pk2(o[n][0], o[n][1]); w2.y = pk2(o[n][2], o[n][3]); *(u32x2*)(op + 16 * n) = w2; }
    }
#undef XLOADK
#undef XLOADV
    __syncthreads();
}

__device__ __forceinline__ void xattn_prompt2(CP P, LAS unsigned char* lds, int unit, int tid, int wave, int lane) {
    const int b = unit >> 5, h = (unit >> 3) & 3, qb = unit & 7;
    const int fr = lane & 15, fq = lane >> 4;
    LAS bf16_t* KV = (LAS bf16_t*)lds;
    const bf16_t* q2 = (const bf16_t*)(P->ws + WS_Q2); const bf16_t* mk = (const bf16_t*)(P->ws + WS_MK); const bf16_t* mvt = (const bf16_t*)(P->ws + WS_MVT);
    const int row = b * SEQ + qb * 256 + 32 * wave + fr;
    f32x4 s[2][16];
#pragma unroll
    for (int mt = 0; mt < 2; ++mt)
#pragma unroll
        for (int n = 0; n < 16; ++n) s[mt][n] = (f32x4){0.f, 0.f, 0.f, 0.f};
    u32x4 tmp[4];
#define XLOADK(dcv) { _Pragma("unroll") for (int it = 0; it < 4; ++it) { const int ci = tid + 512 * it, m = ci >> 3, c8 = ci & 7; tmp[it] = *(const u32x4*)(mk + (size_t)(b * 256 + m) * 1024 + h * 256 + (dcv) * 64 + c8 * 8); } }
#define XLOADV(dcv) { _Pragma("unroll") for (int it = 0; it < 4; ++it) { const int ci = tid + 512 * it, d = ci >> 5, c = ci & 31; tmp[it] = *(const u32x4*)(mvt + (size_t)(h * 256 + (dcv) * 64 + d) * 2048 + b * 256 + c * 8); } }
    XLOADK(0)
    for (int dc = 0; dc < 4; ++dc) {
        bf16x8 qf[2][2];
#pragma unroll
        for (int mt = 0; mt < 2; ++mt)
#pragma unroll
            for (int ks = 0; ks < 2; ++ks) qf[mt][ks] = *(const bf16x8*)(q2 + (size_t)(row + 16 * mt) * 1024 + h * 256 + dc * 64 + ks * 32 + 8 * fq);
        __syncthreads();
#pragma unroll
        for (int it = 0; it < 4; ++it) { const int ci = tid + 512 * it, m = ci >> 3, c8 = ci & 7; *(LAS u32x4*)(KV + m * PK + c8 * 8) = tmp[it]; }
        if (dc < 3) XLOADK(dc + 1)
        __syncthreads();
        __builtin_amdgcn_s_setprio(1);
#pragma unroll
        for (int ks = 0; ks < 2; ++ks) {
#pragma unroll
            for (int n = 0; n < 16; ++n) {
                const bf16x8 bfr = *(const LAS bf16x8*)(KV + (16 * n + fr) * PK + ks * 32 + 8 * fq);
                s[0][n] = __builtin_amdgcn_mfma_f32_16x16x32_bf16(bfr, qf[0][ks], s[0][n], 0, 0, 0);
                s[1][n] = __builtin_amdgcn_mfma_f32_16x16x32_bf16(bfr, qf[1][ks], s[1][n], 0, 0, 0);
                if ((n & 3) == 3) __builtin_amdgcn_sched_barrier(0);
            }
        }
        __builtin_amdgcn_s_setprio(0);
    }
    bf16x8 pf[2][8];
#pragma unroll
    for (int mt = 0; mt < 2; ++mt) {
        float mx = -INFINITY;
#pragma unroll
        for (int n = 0; n < 16; ++n)
#pragma unroll
            for (int e = 0; e < 4; ++e) { s[mt][n][e] *= 0.0625f; mx = fmaxf(mx, s[mt][n][e]); }
        mx = fmaxf(mx, __shfl_xor(mx, 16)); mx = fmaxf(mx, __shfl_xor(mx, 32));
        float sum = 0.f;
#pragma unroll
        for (int n = 0; n < 16; ++n)
#pragma unroll
            for (int e = 0; e < 4; ++e) { const float ev = __expf(s[mt][n][e] - mx); s[mt][n][e] = ev; sum += ev; }
        sum += __shfl_xor(sum, 16); sum += __shfl_xor(sum, 32);
        const float inv = 1.f / sum;
#pragma unroll
        for (int ks = 0; ks < 8; ++ks) { u32x4 w; w.x = pk2(s[mt][2 * ks][0] * inv, s[mt][2 * ks][1] * inv); w.y = pk2(s[mt][2 * ks][2] * inv, s[mt][2 * ks][3] * inv);
            w.z = pk2(s[mt][2 * ks + 1][0] * inv, s[mt][2 * ks + 1][1] * inv); w.w = pk2(s[mt][2 * ks + 1][2] * inv, s[mt][2 * ks + 1][3] * inv); pf[mt][ks] = __builtin_bit_cast(bf16x8, w); }
    }
    XLOADV(0)
    for (int dc = 0; dc < 4; ++dc) {
        __syncthreads();
#pragma unroll
        for (int it = 0; it < 4; ++it) { const int ci = tid + 512 * it, d = ci >> 5, c = ci & 31; *(LAS u32x4*)(KV + d * PV + c * 8) = tmp[it]; }
        if (dc < 3) XLOADV(dc + 1)
        __syncthreads();
        f32x4 o[2][4];
#pragma unroll
        for (int mt = 0; mt < 2; ++mt)
#pragma unroll
            for (int n = 0; n < 4; ++n) o[mt][n] = (f32x4){0.f, 0.f, 0.f, 0.f};
        __builtin_amdgcn_s_setprio(1);
#pragma unroll
        for (int ks = 0; ks < 8; ++ks) {
#pragma unroll
            for (int n = 0; n < 4; ++n) {
                const LAS bf16_t* vp = KV + (16 * n + fr) * PV + 32 * ks + 4 * fq;
                const u32x2 a0 = *(const LAS u32x2*)vp, a1 = *(const LAS u32x2*)(vp + 16);
                const bf16x8 av = __builtin_bit_cast(bf16x8, (u32x4){a0.x, a0.y, a1.x, a1.y});
                o[0][n] = __builtin_amdgcn_mfma_f32_16x16x32_bf16(av, pf[0][ks], o[0][n], 0, 0, 0);
                o[1][n] = __builtin_amdgcn_mfma_f32_16x16x32_bf16(av, pf[1][ks], o[1][n], 0, 0, 0);
            }
            __builtin_amdgcn_sched_barrier(0);
        }
        __builtin_amdgcn_s_setprio(0);
        asm volatile("s_nop 7\n\ts_nop 7\n\ts_nop 7" ::: "memory");
#pragma unroll
        for (int mt = 0; mt < 2; ++mt) {
            bf16_t* op = (bf16_t*)(P->ws + WS_OX) + (size_t)(row + 16 * mt) * 1024 + h * 256 + dc * 64 + 4 * fq;
#pragma unroll
            for (int n = 0; n < 4; ++n) { u32x2 w2; w2.x = pk2(o[mt][n][0], o[mt][n][1]); w2.y = pk2(o[mt][n][2], o[mt][n][3]); *(u32x2*)(op + 16 * n) = w2; }
        }
    }
#undef XLOADK
#undef XLOADV
    __syncthreads();
}

__device__ __forceinline__ void xattn_sample(CP P, LAS unsigned char* lds, int unit, int tid, int wave, int lane) {
    const int b = unit >> 2, h = unit & 3, row0 = TP + b * 4;
    LAS float* sc = (LAS float*)lds;
    LAS float* red = sc + 1024;
    const bf16_t* q2 = (const bf16_t*)(P->ws + WS_Q2);
    const float* kb = P->in[6] + ((size_t)(b * 256) * 4 + h) * 256;
    const float* vb = P->in[7] + ((size_t)(b * 256) * 4 + h) * 256 + 4 * lane;
    {
        const int fr = lane & 15, fq = lane >> 4;
        bf16x8 qf[8];
#pragma unroll
        for (int ks = 0; ks < 8; ++ks) { u32x4 z = (u32x4){0u, 0u, 0u, 0u}; if (fr < 4) z = *(const u32x4*)(q2 + (size_t)(row0 + fr) * 1024 + h * 256 + ks * 32 + 8 * fq); qf[ks] = __builtin_bit_cast(bf16x8, z); }
#pragma unroll
        for (int mt = 0; mt < 2; ++mt) {
            const int m0 = 32 * wave + 16 * mt; const float* kr = kb + (size_t)(m0 + fr) * 1024 + 8 * fq;
            f32x4 kv[16];
#pragma unroll
            for (int ks = 0; ks < 8; ++ks) { kv[2 * ks] = *(const f32x4*)(kr + ks * 32); kv[2 * ks + 1] = *(const f32x4*)(kr + ks * 32 + 4); }
            f32x4 acc = (f32x4){0.f, 0.f, 0.f, 0.f};
#pragma unroll
            for (int ks = 0; ks < 8; ++ks) { u32x4 a; a.x = pk2(kv[2 * ks][0], kv[2 * ks][1]); a.y = pk2(kv[2 * ks][2], kv[2 * ks][3]); a.z = pk2(kv[2 * ks + 1][0], kv[2 * ks + 1][1]); a.w = pk2(kv[2 * ks + 1][2], kv[2 * ks + 1][3]);
                acc = __builtin_amdgcn_mfma_f32_16x16x32_bf16(__builtin_bit_cast(bf16x8, a), qf[ks], acc, 0, 0, 0); }
            if (fr < 4) *(LAS f32x4*)(sc + fr * 256 + m0 + 4 * fq) = acc * 0.0625f;
        }
    }
    __syncthreads();
    if (wave < 4) {
        float v[4]; float mx = -INFINITY;
#pragma unroll
        for (int j = 0; j < 4; ++j) { v[j] = sc[wave * 256 + lane + 64 * j]; mx = fmaxf(mx, v[j]); }
        mx = wave_max(mx); float sum = 0.f;
#pragma unroll
        for (int j = 0; j < 4; ++j) { v[j] = __expf(v[j] - mx); sum += v[j]; }
        const float inv = 1.f / wave_sum(sum);
#pragma unroll
        for (int j = 0; j < 4; ++j) sc[wave * 256 + lane + 64 * j] = v[j] * inv;
    }
    __syncthreads();
    f32x4 acc[4];
#pragma unroll
    for (int tt = 0; tt < 4; ++tt) acc[tt] = (f32x4){0.f, 0.f, 0.f, 0.f};
#pragma unroll 8
    for (int i = 0; i < 32; ++i) {
        const int m = 32 * wave + i; const f32x4 v = *(const f32x4*)(vb + (size_t)m * 1024);
#pragma unroll
        for (int tt = 0; tt < 4; ++tt) acc[tt] += v * sc[tt * 256 + m];
    }
#pragma unroll
    for (int tt = 0; tt < 4; ++tt) *(LAS f32x4*)(red + (wave * 4 + tt) * 256 + 4 * lane) = acc[tt];
    __syncthreads();
    for (int kk_ = 0; kk_ < 2; ++kk_) { const int i = tid + 512 * kk_; float s = 0.f;
#pragma unroll
        for (int w = 0; w < 8; ++w) s += red[w * 1024 + i];
        const int tt = i >> 8, d = i & 255; ((bf16_t*)(P->ws + WS_OX))[(size_t)(row0 + tt) * 1024 + h * 256 + d] = f2bf(s); }
    __syncthreads();
}

__device__ __forceinline__ void skinny_gemm(const bf16_t* A, const bf16_t* Wt, bf16_t* C, int K, int bid, int G, int wave, int lane) {
    const int fr = lane & 15, fq = lane >> 4;
    for (int t = bid; t < 256; t += G) {
        const int r0 = TP + 32 * (t & 15) + 16 * (wave & 1), c0 = 64 * (t >> 4) + 16 * (wave >> 1);
        const bf16_t* ap = A + (size_t)(r0 + fr) * K + 8 * fq; const bf16_t* bp = Wt + (size_t)(c0 + fr) * K + 8 * fq;
        f32x4 acc = (f32x4){0.f, 0.f, 0.f, 0.f};
        for (int kb = 0; kb < K; kb += 512) {
            bf16x8 av[16], bv[16];
#pragma unroll
            for (int j = 0; j < 16; ++j) { av[j] = *(const bf16x8*)(ap + kb + 32 * j); bv[j] = *(const bf16x8*)(bp + kb + 32 * j); }
#pragma unroll
            for (int j = 0; j < 16; ++j) acc = __builtin_amdgcn_mfma_f32_16x16x32_bf16(bv[j], av[j], acc, 0, 0, 0);
        }
        __builtin_amdgcn_sched_barrier(0);
        asm volatile("s_nop 7\n\ts_nop 7\n\ts_nop 7" ::: "memory");
        u32x2 w; w.x = pk2(acc[0], acc[1]); w.y = pk2(acc[2], acc[3]);
        *(u32x2*)(C + (size_t)(r0 + fr) * 1024 + c0 + 4 * fq) = w;
    }
}

__device__ __forceinline__ void copy_caches(CP P, int part, int t0_, int NT_) {
    unsigned char* ws = P->ws; const bf16_t* proj = (const bf16_t*)(ws + WS_PROJ);
    if (part == 0) {
        for (int base_ = 0; base_ < 2048 * 1024 / 4; base_ += 4 * NT_) {
            u32x2 a[4], c[4];
#pragma unroll
            for (int k = 0; k < 4; ++k) { const int i = base_ + k * NT_ + t0_; a[k] = (u32x2){0u, 0u}; c[k] = a[k]; if (i < 2048 * 1024 / 4) { a[k] = ((const u32x2*)(ws + WS_MK))[i]; c[k] = ((const u32x2*)(ws + WS_MV))[i]; } }
#pragma unroll
            for (int k = 0; k < 4; ++k) { const int i = base_ + k * NT_ + t0_; if (i < 2048 * 1024 / 4) {
                ((f32x4*)(P->out + O_PMK))[i] = (f32x4){__uint_as_float(a[k].x << 16), __uint_as_float(a[k].x & 0xffff0000u), __uint_as_float(a[k].y << 16), __uint_as_float(a[k].y & 0xffff0000u)};
                ((f32x4*)(P->out + O_PMV))[i] = (f32x4){__uint_as_float(c[k].x << 16), __uint_as_float(c[k].x & 0xffff0000u), __uint_as_float(c[k].y << 16), __uint_as_float(c[k].y & 0xffff0000u)}; } }
        }
        for (int base_ = 0; base_ < 8 * 128 * 128; base_ += NT_) { const int i = base_ + t0_; if (i >= 8 * 128 * 128) continue; const int b = i >> 14, r = (i >> 7) & 127, cidx = i & 127;
            const bf16_t* pr = proj + (size_t)(b * SEQ + 1920 + r) * NPROJ + cidx; P->out[O_PWK + i] = bf2f(pr[2048]); P->out[O_PWV + i] = bf2f(pr[2176]); }
        for (int base_ = 0; base_ < 128 * 4 * 128; base_ += NT_) { const int j = base_ + t0_; if (j >= 128 * 4 * 128) continue; const int b = j >> 9, t = (j >> 7) & 3, cidx = j & 127;
            const bf16_t* pr = proj + (size_t)(TP + b * 4 + t) * NPROJ + cidx; const size_t o = (size_t)(b * 128 + 124 + t) * 128 + cidx; P->out[O_SWK + o] = bf2f(pr[2048]); P->out[O_SWV + o] = bf2f(pr[2176]); }
    } else {
        for (int base_ = 0; base_ < 128 * 124 * 32; base_ += 4 * NT_) {
            f32x4 kv[4], vv[4];
#pragma unroll
            for (int k = 0; k < 4; ++k) { const int j = base_ + k * NT_ + t0_; kv[k] = (f32x4){0.f, 0.f, 0.f, 0.f}; vv[k] = kv[k];
                if (j < 128 * 124 * 32) { const int b = j / (124 * 32), rem = j - b * (124 * 32); const size_t i = (size_t)b * 16384 + 4 * rem; kv[k] = *(const f32x4*)(P->in[4] + i + 512); vv[k] = *(const f32x4*)(P->in[5] + i + 512); } }
#pragma unroll
            for (int k = 0; k < 4; ++k) { const int j = base_ + k * NT_ + t0_;
                if (j < 128 * 124 * 32) { const int b = j / (124 * 32), rem = j - b * (124 * 32); const size_t i = (size_t)b * 16384 + 4 * rem; *(f32x4*)(P->out + O_SWK + i) = kv[k]; *(f32x4*)(P->out + O_SWV + i) = vv[k]; } }
        }
    }
}

#define XB_TMO      128
#define XB_XCNT(j)  (256  + 64 * (j))
#define XB_XSUB(j)  (1280 + 64 * (j))
#define XB_XGEN(j)  (2304 + 64 * (j))
#define XB_TOP      3328
#define XB_TOPGEN   3392
#define XCD_BAR_WORDS 3456
#define XB_SPIN_CAP (1u << 18)

__device__ __forceinline__ unsigned xb_ld(unsigned* p)              { return __hip_atomic_load(p, __ATOMIC_RELAXED, __HIP_MEMORY_SCOPE_AGENT); }
__device__ __forceinline__ unsigned xb_add(unsigned* p, unsigned v) { return __hip_atomic_fetch_add(p, v, __ATOMIC_RELAXED, __HIP_MEMORY_SCOPE_AGENT); }
__device__ __forceinline__ unsigned xb_xcc_id() { return (unsigned)__builtin_amdgcn_s_getreg((3 << 11) | 20) & 0xFu; }
#define XB_SPIN(cond, bar) do { unsigned _sp = 0; while (cond) { __builtin_amdgcn_s_sleep(1); \
    if ((++_sp & 255u) == 0u) { if (xb_ld(&(bar)[XB_TMO])) break; if (_sp > XB_SPIN_CAP) { atomicAdd(&(bar)[XB_TMO], 1u); break; } } } } while (0)

struct XcdBarrier {
    unsigned* bar; unsigned x;
    volatile LAS unsigned* st;
};

__device__ __forceinline__ XcdBarrier xcd_barrier_post(unsigned* bar, volatile LAS unsigned* st) {
    XcdBarrier b; b.bar = bar; b.x = xb_xcc_id(); b.st = st;
    if (threadIdx.x == 0) (void)xb_add(&bar[XB_XCNT(b.x)], 1u);
    return b;
}
__device__ __forceinline__ void xcd_barrier_complete(unsigned* bar, unsigned x, unsigned& nloc, unsigned& nx) {
    const unsigned G = gridDim.x * gridDim.y * gridDim.z;
    unsigned sum, cnt, mine, sp = 0u;
    for (;;) {
        sum = 0u; cnt = 0u; mine = 0u;
#pragma unroll
        for (unsigned j = 0; j < 16; ++j) { const unsigned c = xb_ld(&bar[XB_XCNT(j)]); sum += c; cnt += (c > 0u) ? 1u : 0u; mine = (j == x) ? c : mine; }
        if (sum == G) break;
        __builtin_amdgcn_s_sleep(1);
        if ((++sp & 255u) == 0u) { if (xb_ld(&bar[XB_TMO])) break; if (sp > XB_SPIN_CAP) { atomicAdd(&bar[XB_TMO], 1u); break; } }
    }
    nloc = mine > 0u ? mine : 1u; nx = cnt > 0u ? cnt : 1u;
}

__device__ __forceinline__ void xcd_barrier(const XcdBarrier& b) {
    asm volatile("s_waitcnt vmcnt(0)" ::: "memory");
    __syncthreads();
    if (threadIdx.x == 0) {
        unsigned* bar = b.bar;
        __builtin_amdgcn_s_waitcnt(0);
        unsigned nloc = b.st[0], nx = b.st[1];
        if (nloc == 0u) { xcd_barrier_complete(bar, b.x, nloc, nx); b.st[0] = nloc; b.st[1] = nx; }
        const unsigned old = xb_add(&bar[XB_XSUB(b.x)], 1u);
        const unsigned gen = old / nloc;
        if (old + 1u == (gen + 1u) * nloc) {
            __builtin_amdgcn_fence(__ATOMIC_RELEASE, "agent");
            asm volatile("s_waitcnt vmcnt(0)" ::: "memory");
            const unsigned og = xb_add(&bar[XB_TOP], 1u);
            const unsigned tg = og / nx;
            if (og + 1u == (tg + 1u) * nx) xb_add(&bar[XB_TOPGEN], 1u);
            else XB_SPIN(xb_ld(&bar[XB_TOPGEN]) == tg, bar);
            __builtin_amdgcn_fence(__ATOMIC_ACQUIRE, "agent");
            xb_add(&bar[XB_XGEN(b.x)], 1u);
            asm volatile("s_waitcnt vmcnt(0)" ::: "memory");
        } else {
            XB_SPIN(xb_ld(&bar[XB_XGEN(b.x)]) == gen, bar);
            __builtin_amdgcn_fence(__ATOMIC_ACQUIRE, "agent");
            asm volatile("s_waitcnt vmcnt(0)" ::: "memory");
        }
    }
    __syncthreads();
}

constexpr int NPHASE = 13;
#ifndef SKN
#define SKN 2
#endif
#ifndef MK_MULTI
#define MK_MULTI 0
#endif
#ifndef TSW
#define TSW 0
#endif
__global__ void __launch_bounds__(512, 2) mk_fwd(Params P_) {
    CP P = (CP)__builtin_amdgcn_kernarg_segment_ptr(); asm volatile("" : "+s"(P));
    extern __shared__ __attribute__((aligned(16))) unsigned char lds_raw[];
    LAS unsigned char* lds = (LAS unsigned char*)lds_raw;
    const int G = gridDim.x, bid = blockIdx.x;
    volatile LAS unsigned* bar_st = (volatile LAS unsigned*)(lds + LDS_BYTES - 16);
    if (threadIdx.x < 4) bar_st[threadIdx.x] = 0u;
    __syncthreads();
    XcdBarrier xbar = xcd_barrier_post((unsigned*)P_.ws, bar_st);
#define SWZ ((G % 8 == 0) ? (bid % 8) * (G / 8) + bid / 8 : bid)
#define TLW CP P = (CP)__builtin_amdgcn_kernarg_segment_ptr(); asm volatile("" : "+s"(P)); unsigned char* ws = P->ws; (void)ws; int tid = threadIdx.x; asm volatile("" : "+v"(tid)); const int lane = tid & 63, wave = __builtin_amdgcn_readfirstlane(tid >> 6); const int gw = bid * 8 + wave, NGW = G * 8; (void)gw; (void)NGW; (void)lane;
    unsigned char* ws = P->ws;
    const int lo = P->ph_lo, hi = P->ph_hi;
#ifndef PHMASK
#define PHMASK 0xffff
#endif
#define IN(k) (((PHMASK >> (k)) & 1) && lo <= (k) && (k) < hi)
#ifndef REP_PHASE
#define REP_PHASE -1
#endif
#define NREP(k) ((k) == REP_PHASE ? 2 : 1)
#define SEAM(k) do { if (IN(k) && IN((k) + 1)) xcd_barrier(xbar); } while (0)
    bf16_t* R = (bf16_t*)(ws + WS_R);
#ifdef DUMP_BUF
    if (lo == 100) { TLW const bf16_t* src = (const bf16_t*)(ws + DUMP_BUF);
        for (size_t i = (size_t)bid * 512 + tid; i < (size_t)TT * 1024; i += (size_t)G * 512) { float v = bf2f(src[i]); if (!(fabsf(v) < 1e30f)) v = 12345.f; P->out[i] = v; } }
#endif

    if (IN(0)) for (int rep = 0; rep < NREP(0); ++rep) { TLW phase_prologue(P, lds, gw, NGW, wave, lane); }
    SEAM(0);
    if (IN(1)) {
        pg8::Gemm g{R, R, 0, 0, 1024}; Order S{754, G, bid, 0, 0};
        EpiP1 E{(bf16_t*)(ws + WS_PROJ), (bf16_t*)(ws + WS_MK), (bf16_t*)(ws + WS_MV), (bf16_t*)(ws + WS_MVT), (bf16_t*)(ws + WS_KVT)};
        pg8::gemm_phase<EpiP1, Order, true, true>(lds, g, S, E);
    }
    SEAM(1);
    if (IN(2)) for (int rep = 0; rep < NREP(2); ++rep) {
        TLW
        if (!(TSW & 4)) for (int u = SWZ; u < 256; u += G) ssd_pass_a(P, lds, u, tid, wave, lane);
        if (!(TSW & 8)) for (int u = SWZ; u < 256; u += G) swa_prompt(P, lds, u, tid, wave, lane);
        if (!(TSW & 16)) for (int u = bid; u < 256; u += G) ssd_sample(P, lds, u, tid, wave, lane);
        if (!(TSW & 32)) for (int u = bid; u < 256; u += G) swa_sample(P, lds, u, tid, wave, lane);
    }
    SEAM(2);
    if (IN(3)) { { TLW ssd_state_scan(P, bid, G, tid); } xcd_barrier(xbar); }
    if (IN(3)) for (int rep = 0; rep < NREP(3); ++rep) { TLW for (int u = SWZ; u < 256; u += G) ssd_pass_b(P, lds, u, tid, wave, lane); }
    SEAM(3);
    if (IN(4)) for (int rep = 0; rep < NREP(4); ++rep) {
        pg8::Gemm g{(const bf16_t*)(ws + WS_MIXIN), (const bf16_t*)(ws + WS_WOUT), TT, 1024, 1024}; Order S{272, G, bid, 3, 16};
        EpiBf E{(bf16_t*)(ws + WS_CB16), 1024, 1.f, (float*)(ws + WS_SPLIT)};
        pg8::gemm_phase<EpiBf, Order, true, true>(lds, g, S, E);
        if (bid + G >= 272 && rep == 0) { TLW const int nb_ = G - (272 - G > 0 ? 272 - G : 0); tr_items(P, lds, 1, (bid - (G - nb_)) * 8 + wave, nb_ * 8, wave, lane); }
        if ((SKN >> 0) & 1) { TLW skinny_gemm((const bf16_t*)(ws + WS_MIXIN), (const bf16_t*)(ws + WS_WOUT), (bf16_t*)(ws + WS_CB16), 1024, bid, G, wave, lane); }
    }
    SEAM(4);
#ifdef SYNC_EXTRA
    for (int r_ = 0; r_ < SYNC_EXTRA; ++r_) cg::this_grid().sync();
#endif
    if (IN(5)) for (int rep = 0; rep < NREP(5); ++rep) { TLW phase_resid(P, 0, gw, NGW, lane); }
    SEAM(5);
    if (IN(6)) {
        pg8::Gemm g{(const bf16_t*)(ws + WS_H0), (const bf16_t*)(ws + WS_WXQ), TT, 1024, 1024}; Order S{256, G, bid, 1, 4};
        EpiBf E{(bf16_t*)(ws + WS_Q2), 1024, 1.f, nullptr};
        pg8::gemm_phase<EpiBf, Order, true, true>(lds, g, S, E);
        if ((SKN >> 1) & 1) { TLW skinny_gemm((const bf16_t*)(ws + WS_H0), (const bf16_t*)(ws + WS_WXQ), (bf16_t*)(ws + WS_Q2), 1024, bid, G, wave, lane); }
    }
    SEAM(6);
    if (IN(7)) for (int rep = 0; rep < NREP(7); ++rep) {
        TLW
        if ((bid >> 3) & 1) { for (int u = SWZ; u < 256; u += G) xattn_prompt2(P, lds, u, tid, wave, lane); }
        for (int u = bid; u < 512; u += G) xattn_sample(P, lds, u, tid, wave, lane);
        if (!((bid >> 3) & 1)) { for (int u = SWZ; u < 256; u += G) xattn_prompt2(P, lds, u, tid, wave, lane); }
    }
    SEAM(7);
    if (IN(8)) {
        pg8::Gemm g{(const bf16_t*)(ws + WS_OX), (const bf16_t*)(ws + WS_WXO), TT, 1024, 1024}; Order S{272, G, bid, 3, 16};
        EpiBf E{(bf16_t*)(ws + WS_CB16), 1024, 1.f, (float*)(ws + WS_SPLIT) + 8 * 512 * 1024};
        pg8::gemm_phase<EpiBf, Order, true, true>(lds, g, S, E);
        { TLW const int first_ = G > 16 ? 16 : 0; if (bid >= first_) copy_caches(P, 0, (bid - first_) * 512 + tid, (G - first_) * 512); }
        if ((SKN >> 2) & 1) { TLW skinny_gemm((const bf16_t*)(ws + WS_OX), (const bf16_t*)(ws + WS_WXO), (bf16_t*)(ws + WS_CB16), 1024, bid, G, wave, lane); }
    }
    SEAM(8);
    if (IN(9)) { TLW phase_resid(P, 1, gw, NGW, lane); }
    SEAM(9);
    if (IN(10)) for (int rep = 0; rep < NREP(10); ++rep) {
        pg8::Gemm g{(const bf16_t*)(ws + WS_H0), (const bf16_t*)(ws + WS_WGU), TT, 2 * DFF, 1024}; Order S{66 * 22, G, bid, 1, 22};
        EpiGU E{(bf16_t*)(ws + WS_ACT)};
        pg8::gemm_phase<EpiGU, Order, true, true>(lds, g, S, E);
    }
    SEAM(10);
    if (IN(11)) for (int rep = 0; rep < NREP(11); ++rep) {
        pg8::Gemm g{(const bf16_t*)(ws + WS_ACT), (const bf16_t*)(ws + WS_WDN), TT, 1024, DFF}; Order S{288, G, bid, 2, 44};
        EpiBf E{(bf16_t*)(ws + WS_CB16), 1024, 1.f, (float*)(ws + WS_SPLIT) + 12 * 512 * 1024};
        pg8::gemm_phase<EpiBf, Order, true, true>(lds, g, S, E);
        if (rep == 0) { TLW const int first_ = G > 32 ? 32 : 0; if (bid >= first_) copy_caches(P, 1, (bid - first_) * 512 + tid, (G - first_) * 512); }
        if ((SKN >> 3) & 1) { TLW skinny_gemm((const bf16_t*)(ws + WS_ACT), (const bf16_t*)(ws + WS_WDN), (bf16_t*)(ws + WS_CB16), DFF, bid, G, wave, lane); }
    }
    SEAM(11);
    if (IN(12)) { TLW phase_resid(P, 2, gw, NGW, lane); }
#undef IN
#undef SEAM
}

#ifndef MK_MULTI
#define MK_MULTI 0
#endif
#ifndef NPH_RUN
#define NPH_RUN 13
#endif
extern "C" void kernel_launch(void* const* d_in, const int* in_sizes, int n_in, void* d_out, int out_size, void* d_ws, size_t ws_size, hipStream_t stream) {
    static int grid = 0;
    if (grid == 0) {
        if (n_in != 32 || ws_size < WS_END) { fprintf(stderr, "kernel_launch: n_in %d ws %zu (need %zu)\n", n_in, ws_size, (size_t)WS_END); grid = -1; return; }
        int dev = 0, cus = 0, per_cu = 0;
        hipGetDevice(&dev); hipDeviceGetAttribute(&cus, hipDeviceAttributeMultiprocessorCount, dev);
        hipFuncSetAttribute((const void*)mk_fwd, hipFuncAttributeMaxDynamicSharedMemorySize, LDS_BYTES);
        hipOccupancyMaxActiveBlocksPerMultiprocessor(&per_cu, (const void*)mk_fwd, 512, LDS_BYTES);
        if (per_cu < 1) { fprintf(stderr, "kernel_launch: occupancy query says %d blocks per CU\n", per_cu); per_cu = 1; }
        grid = cus;
        (void)hipGetLastError();
    }
    if (grid < 0) return;
    (void)hipMemsetAsync(d_ws, 0, 16384, stream);
    Params p{};
    for (int i = 0; i < 32; ++i) p.in[i] = (const float*)d_in[i];
    p.out = (float*)d_out; p.ws = (unsigned char*)d_ws;
#if MK_MULTI
    for (int ph = 0; ph < NPH_RUN; ++ph) { p.ph_lo = ph; p.ph_hi = ph + 1; hipLaunchKernelGGL(mk_fwd, dim3(grid), dim3(512), LDS_BYTES, stream, p); }
#ifdef DUMP_BUF
    p.ph_lo = 100; p.ph_hi = 100; hipLaunchKernelGGL(mk_fwd, dim3(grid), dim3(512), LDS_BYTES, stream, p);
#endif
#else
    p.ph_lo = 0; p.ph_hi = NPHASE;
    void* args[] = {&p};
    hipError_t e = hipLaunchCooperativeKernel((const void*)mk_fwd, dim3(grid), dim3(512), args, LDS_BYTES, stream);
    if (e != hipSuccess) fprintf(stderr, "cooperative launch failed: %s (grid %d)\n", hipGetErrorString(e), grid);
#endif
}
```

```cpp
#include <hip/hip_runtime.h>
#include <hip/hip_cooperative_groups.h>
#include <cstdio>
#include <cstdint>
namespace cg = cooperative_groups;
namespace pg8 {
#define PG8_LAS __attribute__((address_space(3)))
typedef unsigned short bf16_t;
typedef short bf16x8 __attribute__((ext_vector_type(8)));
typedef float f32x4 __attribute__((ext_vector_type(4)));
typedef unsigned u32x4 __attribute__((ext_vector_type(4)));
constexpr int BM = 256, BK = 64, HALF = 128, HTB = HALF * BK * 2  , STAGE_BYTES = 8 * HTB, NXCD = 8, WGM = 8;

__host__ __device__ __forceinline__ int lds_byte(int r, int c) { const int st = (r >> 4) * 2 + (c >> 5), rr = r & 15, cc = c & 31, ob = rr * 64 + cc * 2; return st * 1024 + (ob ^ (((ob >> 9) & 1) << 5)); }
__host__ __device__ __forceinline__ void stage_rc(int b, int& R, int& C) { const int st = b / 1024, sb = b % 1024, swz = sb ^ (((sb >> 9) & 1) << 5); R = (st >> 1) * 16 + swz / 64; C = (st & 1) * 32 + (swz % 64) / 2; }
__host__ __device__ __forceinline__ int perm32(int rho) { const int n = rho >> 4, i = rho & 15; return 8 * (i >> 2) + 4 * n + (i & 3); }

struct Unit { int pm, pn, kofs, nt, q; };
struct Gemm { const bf16_t* A; const bf16_t* Bt; int M, N, K; };

struct StaticOrder {
    int nM, nN, nwg, G, c;
    __host__ __device__ void init(int M, int N, int G_, int c_) { nM = M / BM; nN = N / BM; nwg = nM * nN; G = G_; c = c_; }
    __host__ __device__ bool next(int i, Unit& u) const {
        const long L = (long)i * G + c; if (L >= nwg) return false;
        int wgid = (int)L; { const int q = nwg / NXCD, r = nwg % NXCD, xcd = wgid % NXCD, off = wgid / NXCD; wgid = (xcd < r ? xcd * (q + 1) : r * (q + 1) + (xcd - r) * q) + off; }
        const int nig = WGM * nN, gid = wgid / nig, fm = gid * WGM, gsz = (nM - fm) < WGM ? (nM - fm) : WGM;
        u.pm = fm + ((wgid % nig) % gsz); u.pn = (wgid % nig) / gsz; return true;
    }
    __device__ __forceinline__ void a_ready(const Unit&) const {}
    __device__ __forceinline__ void done(const Unit&) const {}
};

__device__ __forceinline__ unsigned cvt_pk_bf16(float lo, float hi) { unsigned r; asm volatile("v_cvt_pk_bf16_f32 %0, %1, %2" : "=v"(r) : "v"(lo), "v"(hi)); return r; }
typedef float f32x2 __attribute__((ext_vector_type(2)));
template <class Epi, class Sched, bool ALIGN_EPI = false, bool SP2 = false>
__device__ __forceinline__ void gemm_phase(PG8_LAS unsigned char* lds, const Gemm g, const Sched& S, const Epi& E) {
    int tid_ = threadIdx.x; asm volatile("" : "+v"(tid_));
    const int tid = tid_, wid = __builtin_amdgcn_readfirstlane(tid >> 6), lane = tid & 63, wr = wid >> 2, wc = wid & 3, fr = lane & 15, fq = lane >> 4;
    const int K = g.K; int nt = K / BK;
    unsigned voffA[2], voffB[2];
#pragma unroll
    for (int i = 0; i < 2; ++i) { int R, C; stage_rc(tid * 16 + i * 8192, R, C); const int Rb = Epi::PERM ? ((R & ~31) + perm32(R & 31)) : R;
        voffA[i] = (unsigned)(R * K + C) * 2u; voffB[i] = (unsigned)(Rb * K + C) * 2u; }
    const size_t kstep = (size_t)(BK * 2);
    const size_t hstep = (size_t)HALF * K * 2;
    const size_t tstep = 2 * hstep;
    const unsigned ldsw = (unsigned)wid * 1024u;
    const int aoff = lds_byte(wr * 64 + fr, fq * 8), boff = lds_byte(wc * 32 + fr, fq * 8);
#define PG8_SA(b, h) (((b) * 2 + (h)) * HTB)
#define PG8_SB(b, h) ((4 + (b) * 2 + (h)) * HTB)
#define PG8_STAGE(bufoff, gbase, voff) do { _Pragma("unroll") for (int _i = 0; _i < 2; ++_i) \
        __builtin_amdgcn_global_load_lds((const unsigned*)((const char*)(gbase) + (voff)[_i]), (PG8_LAS unsigned*)(lds + (bufoff) + ldsw + _i * 8192), 16, 0, 0); } while (0)
#define PG8_LDA(dst, b, h) do { _Pragma("unroll") for (int m = 0; m < 4; ++m) _Pragma("unroll") for (int k = 0; k < 2; ++k) dst[m][k] = *(const PG8_LAS bf16x8*)(lds + PG8_SA(b, h) + aoff + m * 2048 + k * 1024); } while (0)
#define PG8_LDB(dst, b, h) do { _Pragma("unroll") for (int n = 0; n < 2; ++n) _Pragma("unroll") for (int k = 0; k < 2; ++k) dst[n][k] = *(const PG8_LAS bf16x8*)(lds + PG8_SB(b, h) + boff + n * 2048 + k * 1024); } while (0)
#define PG8_MMA(ai, bj, At, Bt) do { __builtin_amdgcn_s_setprio(1); _Pragma("unroll") for (int m = 0; m < 4; ++m) _Pragma("unroll") for (int n = 0; n < 2; ++n) _Pragma("unroll") for (int k = 0; k < 2; ++k) \
        acc[ai][bj][m][n] = __builtin_amdgcn_mfma_f32_16x16x32_bf16(Bt[n][k], At[m][k], acc[ai][bj][m][n], 0, 0, 0); __builtin_amdgcn_s_setprio(0); } while (0)
#define PG8_WAIT_V(n) asm volatile("s_waitcnt vmcnt(" #n ")" ::: "memory")
#define PG8_WAIT_L(n) asm volatile("s_waitcnt lgkmcnt(" #n ")" ::: "memory")
#define PG8_BAR __builtin_amdgcn_s_barrier()
#define PG8_SCHED __builtin_amdgcn_sched_barrier(0)
    Unit cur, nxt; int ui = 0;
    if (!S.next(0, cur)) return;
    f32x4 acc[2][2][4][2];
#pragma unroll
    for (int a = 0; a < 2; ++a)
#pragma unroll
        for (int b = 0; b < 2; ++b)
#pragma unroll
            for (int m = 0; m < 4; ++m)
#pragma unroll
                for (int n = 0; n < 2; ++n) acc[a][b][m][n] = (f32x4){0.f, 0.f, 0.f, 0.f};
    bf16x8 At[4][2], B0[2][2], B1[2][2];
    const char* cA = (const char*)g.A + (size_t)cur.pm * tstep + (size_t)cur.kofs * 2; const char* cB = (const char*)g.Bt + (size_t)cur.pn * tstep + (size_t)cur.kofs * 2;
    if (cur.nt) nt = cur.nt;
    S.a_ready(cur);
    if constexpr (SP2) {
        PG8_STAGE(PG8_SB(0, 0), cB, voffB); PG8_STAGE(PG8_SB(0, 1), cB + hstep, voffB); PG8_STAGE(PG8_SA(0, 0), cA, voffA); PG8_STAGE(PG8_SA(0, 1), cA + hstep, voffA);
        if (wr == 1) PG8_BAR;
        PG8_WAIT_V(2); PG8_BAR;
        PG8_STAGE(PG8_SB(1, 0), cB + kstep, voffB); PG8_STAGE(PG8_SA(1, 0), cA + kstep, voffA); PG8_STAGE(PG8_SB(1, 1), cB + hstep + kstep, voffB);
        PG8_WAIT_V(6); PG8_BAR;
    } else {
        PG8_STAGE(PG8_SB(0, 0), cB, voffB); PG8_STAGE(PG8_SA(0, 0), cA, voffA); PG8_STAGE(PG8_SB(0, 1), cB + hstep, voffB); PG8_STAGE(PG8_SA(0, 1), cA + hstep, voffA);
        if (wr == 1) PG8_BAR;
        PG8_WAIT_V(4); PG8_BAR;
        PG8_STAGE(PG8_SB(1, 0), cB + kstep, voffB); PG8_STAGE(PG8_SA(1, 0), cA + kstep, voffA); PG8_STAGE(PG8_SB(1, 1), cB + hstep + kstep, voffB);
        PG8_WAIT_V(6); PG8_BAR;
    }
    for (;;) {
        const bool has_next = S.next(ui + 1, nxt);
        const char* nA = has_next ? (const char*)g.A + (size_t)nxt.pm * tstep + (size_t)nxt.kofs * 2 : cA; const char* nB = has_next ? (const char*)g.Bt + (size_t)nxt.pn * tstep + (size_t)nxt.kofs * 2 : cB;
        for (int t = 0; t < nt; t += 2) {
            const bool last = (t == nt - 2);
            const char* a1 = cA + (size_t)(t + 1) * kstep;
            const char* a2 = last ? nA : cA + (size_t)(t + 2) * kstep; const char* b2 = last ? nB : cB + (size_t)(t + 2) * kstep;
            const char* a3 = a2 + kstep; const char* b3 = b2 + kstep;
            if (last && has_next) S.a_ready(nxt);
            if constexpr (SP2) {
            PG8_LDB(B0, 0, 0); PG8_LDB(B1, 0, 1); PG8_SCHED; PG8_LDA(At, 0, 0); PG8_STAGE(PG8_SA(1, 1), a1 + hstep, voffA);
            PG8_WAIT_V(8); PG8_WAIT_L(0); PG8_BAR; PG8_MMA(0, 0, At, B0); PG8_MMA(0, 1, At, B1); PG8_BAR; PG8_SCHED;
            PG8_LDA(At, 0, 1); PG8_STAGE(PG8_SB(0, 0), b2, voffB); PG8_STAGE(PG8_SB(0, 1), b2 + hstep, voffB); PG8_STAGE(PG8_SA(0, 0), a2, voffA);
            PG8_WAIT_V(8); PG8_WAIT_L(0); PG8_BAR; PG8_MMA(1, 0, At, B0); PG8_MMA(1, 1, At, B1); PG8_BAR; PG8_SCHED;
            PG8_LDB(B0, 1, 0); PG8_LDB(B1, 1, 1); PG8_SCHED; PG8_LDA(At, 1, 0); PG8_STAGE(PG8_SA(0, 1), a2 + hstep, voffA);
            PG8_WAIT_V(8); PG8_WAIT_L(0); PG8_BAR; PG8_MMA(0, 0, At, B0); PG8_MMA(0, 1, At, B1); PG8_BAR; PG8_SCHED;
            PG8_LDA(At, 1, 1); PG8_STAGE(PG8_SB(1, 0), b3, voffB); PG8_STAGE(PG8_SB(1, 1), b3 + hstep, voffB); PG8_STAGE(PG8_SA(1, 0), a3, voffA);
            PG8_WAIT_V(8); PG8_WAIT_L(0); PG8_BAR; PG8_MMA(1, 0, At, B0); PG8_MMA(1, 1, At, B1); PG8_BAR; PG8_SCHED;
            } else {
            PG8_LDB(B0, 0, 0); PG8_SCHED; PG8_LDA(At, 0, 0); PG8_STAGE(PG8_SA(1, 1), a1 + hstep, voffA);
            PG8_WAIT_L(8); PG8_BAR; PG8_WAIT_L(0); PG8_MMA(0, 0, At, B0); PG8_BAR; PG8_SCHED;
            PG8_LDB(B1, 0, 1); PG8_STAGE(PG8_SB(0, 0), b2, voffB);
            PG8_BAR; PG8_WAIT_L(0); PG8_MMA(0, 1, At, B1); PG8_BAR;
            PG8_LDA(At, 0, 1); PG8_STAGE(PG8_SA(0, 0), a2, voffA);
            PG8_BAR; PG8_WAIT_L(0); PG8_MMA(1, 0, At, B0); PG8_BAR; PG8_SCHED;
            PG8_STAGE(PG8_SB(0, 1), b2 + hstep, voffB);
            PG8_WAIT_V(6); PG8_BAR; PG8_MMA(1, 1, At, B1); PG8_BAR;
            PG8_LDB(B0, 1, 0); PG8_SCHED; PG8_LDA(At, 1, 0); PG8_STAGE(PG8_SA(0, 1), a2 + hstep, voffA);
            PG8_WAIT_L(8); PG8_BAR; PG8_WAIT_L(0); PG8_MMA(0, 0, At, B0); PG8_BAR; PG8_SCHED;
            PG8_LDB(B1, 1, 1); PG8_STAGE(PG8_SB(1, 0), b3, voffB);
            PG8_BAR; PG8_WAIT_L(0); PG8_MMA(0, 1, At, B1); PG8_BAR;
            PG8_LDA(At, 1, 1); PG8_STAGE(PG8_SA(1, 0), a3, voffA);
            PG8_BAR; PG8_WAIT_L(0); PG8_MMA(1, 0, At, B0); PG8_BAR; PG8_SCHED;
            PG8_STAGE(PG8_SB(1, 1), b3 + hstep, voffB);
            PG8_WAIT_V(6); PG8_BAR; PG8_MMA(1, 1, At, B1); PG8_BAR;
            }
        }
        if constexpr (ALIGN_EPI) { if (wr == 0) PG8_BAR; }
        if constexpr (!Epi::AFTER_DRAIN) { E(acc, cur, wr, wc, fr, fq); S.done(cur); }
        if (!has_next) break;
#pragma unroll
        for (int a = 0; a < 2; ++a)
#pragma unroll
            for (int b = 0; b < 2; ++b)
#pragma unroll
                for (int m = 0; m < 4; ++m)
#pragma unroll
                    for (int n = 0; n < 2; ++n) acc[a][b][m][n] = (f32x4){0.f, 0.f, 0.f, 0.f};
        cur = nxt; cA = nA; cB = nB; ++ui; nt = cur.nt ? cur.nt : K / BK;
        if constexpr (ALIGN_EPI) { if (wr == 1) PG8_BAR; }
    }
    PG8_WAIT_V(0);
    if constexpr (!ALIGN_EPI) { if (wr == 0) PG8_BAR; }
    PG8_BAR;
    if constexpr (Epi::AFTER_DRAIN) { E.fused(acc, cur, wr, wc, fr, fq, lds, wid, lane); S.done(cur); }
#undef PG8_SA
#undef PG8_SB
#undef PG8_STAGE
#undef PG8_LDA
#undef PG8_LDB
#undef PG8_MMA
#undef PG8_WAIT_V
#undef PG8_WAIT_L
#undef PG8_BAR
#undef PG8_SCHED
}
}
#define LAS __attribute__((address_space(3)))
typedef unsigned short bf16_t;
typedef float f32x4 __attribute__((ext_vector_type(4)));
typedef short bf16x8 __attribute__((ext_vector_type(8)));
typedef unsigned u32x4 __attribute__((ext_vector_type(4)));
typedef unsigned u32x2 __attribute__((ext_vector_type(2)));

constexpr int DM = 1024, TP = 16384, TS = 512, TT = TP + TS, SEQ = 2048, NB = 8, NSB = 128;
constexpr int NPROJ = 2304, INDIM = 2312, DFF = 2816;
constexpr float EPS = 1e-6f;
constexpr int RT_H0 = 0, RT_MN = 66, RT_WIN = 74, RT_WXKV = 83, RT_END = 91;
constexpr size_t WS_R = 1u << 20;
constexpr size_t WS_H0 = WS_R;
constexpr size_t WS_MN = WS_R + (size_t)RT_MN * 256 * 2048;
constexpr size_t WS_WIN = WS_R + (size_t)RT_WIN * 256 * 2048;
constexpr size_t WS_WXKV = WS_R + (size_t)RT_WXKV * 256 * 2048;
constexpr size_t WS_WOUT = WS_R + (size_t)RT_END * 256 * 2048;
constexpr size_t WS_WXQ = WS_WOUT + 2097152;
constexpr size_t WS_WXO = WS_WXQ + 2097152;
constexpr size_t WS_WGU = WS_WXO + 2097152;
constexpr size_t WS_WDN = WS_WGU + (size_t)2 * DFF * 1024 * 2;
constexpr size_t WS_DTRAW = WS_WDN + (size_t)1024 * DFF * 2;
constexpr size_t WS_SPLIT = WS_DTRAW + (size_t)TT * 8 * 4;
constexpr size_t WS_ATOT = WS_SPLIT + (size_t)16 * 512 * 1024 * 4;
constexpr size_t WS_MIXIN = WS_ATOT + 8192;
constexpr size_t WS_CB16 = WS_MIXIN + (size_t)TT * 1024 * 2;
constexpr size_t WS_Q2 = WS_CB16 + (size_t)TT * 1024 * 2;
constexpr size_t WS_OX = WS_Q2 + (size_t)TT * 1024 * 2;
constexpr size_t WS_PROJ = WS_OX + (size_t)TT * 1024 * 2;
constexpr size_t WS_KVT = WS_PROJ + (size_t)TT * NPROJ * 2;
constexpr size_t WS_MK = WS_KVT + (size_t)256 * TT * 2;
constexpr size_t WS_MVT = WS_MK + (size_t)2048 * 1024 * 2;
constexpr size_t WS_MV = WS_MVT + (size_t)2048 * 1024 * 2;
constexpr size_t WS_CS = WS_MV + (size_t)2048 * 1024 * 2;
constexpr size_t WS_X1 = WS_CS;
constexpr size_t WS_END1 = WS_X1 + (size_t)TT * 1024 * 2 > WS_CS + (size_t)8 * 16 * 8 * 8192 * 4 ? WS_X1 + (size_t)TT * 1024 * 2 : WS_CS + (size_t)8 * 16 * 8 * 8192 * 4;
constexpr size_t WS_ACT = WS_PROJ;
constexpr size_t WS_END2 = WS_ACT + (size_t)TT * DFF * 2;
constexpr size_t WS_END = WS_END1 > WS_END2 ? WS_END1 : WS_END2;
constexpr size_t O_Y = 0, O_PSSM = 17301504, O_PCONV = 17825792, O_PWK = 17850368, O_PWV = 17981440, O_PMK = 18112512, O_PMV = 20209664,
                 O_SSSM = 22306816, O_SCONV = 30695424, O_SWK = 31088640, O_SWV = 33185792;
constexpr int LDS_BYTES = 147456;

struct Params {
    const float* in[32]; float* out; unsigned char* ws; int ph_lo, ph_hi;
};
typedef const __attribute__((address_space(4))) Params* CP;

__device__ __forceinline__ float bf2f(bf16_t h) { return __uint_as_float(((unsigned)h) << 16); }
__device__ __forceinline__ unsigned pk2(float lo, float hi) { return pg8::cvt_pk_bf16(lo, hi); }
__device__ __forceinline__ bf16_t f2bf(float f) { return (bf16_t)(pk2(f, 0.f) & 0xffffu); }
__device__ __forceinline__ float wave_sum(float v) {
#pragma unroll
    for (int o = 1; o < 64; o <<= 1) v += __shfl_xor(v, o);
    return v;
}
__device__ __forceinline__ float wave_max(float v) {
#pragma unroll
    for (int o = 1; o < 64; o <<= 1) v = fmaxf(v, __shfl_xor(v, o));
    return v;
}
__device__ __forceinline__ float silu_f(float x) { return x / (1.f + __expf(-x)); }
__device__ __forceinline__ float softplus_f(float x) { return x > 20.f ? x : log1pf(__expf(x)); }
#define LDSW() asm volatile("s_waitcnt lgkmcnt(0)" ::: "memory")

template <int NT>
__device__ __forceinline__ void mma_lds(f32x4 (&acc)[NT], const LAS bf16_t* A, int lda, const LAS bf16_t* B, int ldb, int K, int lane) {
    const int fr = lane & 15, fq = lane >> 4;
    for (int k0 = 0; k0 < K; k0 += 32) {
        const bf16x8 a = *(const LAS bf16x8*)(A + fr * lda + k0 + 8 * fq);
#pragma unroll
        for (int n = 0; n < NT; ++n) {
            const bf16x8 b = *(const LAS bf16x8*)(B + (16 * n + fr) * ldb + k0 + 8 * fq);
            acc[n] = __builtin_amdgcn_mfma_f32_16x16x32_bf16(b, a, acc[n], 0, 0, 0);
        }
    }
}
template <int NT, int KS, int ks0, int nks>
__device__ __forceinline__ void mma_areg(f32x4 (&acc)[NT], const bf16x8 (&a)[KS], const LAS bf16_t* B, int ldb, int lane) {
    const int fr = lane & 15, fq = lane >> 4;
#pragma unroll
    for (int ks = 0; ks < nks; ++ks) {
#pragma unroll
        for (int n = 0; n < NT; ++n) {
            const bf16x8 b = *(const LAS bf16x8*)(B + (16 * n + fr) * ldb + ks * 32 + 8 * fq);
            acc[n] = __builtin_amdgcn_mfma_f32_16x16x32_bf16(b, a[ks0 + ks], acc[n], 0, 0, 0);
        }
        __builtin_amdgcn_sched_barrier(0);
    }
}

struct Order {
    int n, G, c, mode, nN;
    __device__ __forceinline__ bool next(int i, pg8::Unit& u) const {
        const long L0 = (long)i * G + c; if (L0 >= n) return false;
        u.kofs = 0; u.nt = 0; u.q = 0;
        if (mode == 2) { const int L = (int)L0; if (L < 256) { const int v = (L % 8) * 32 + L / 8; u.pm = v / 4; u.pn = v % 4; }
            else { const int l = L - 256, q = l & 3, hi = ((nN + 7) / 8) * 2, lo = (nN - 2 * hi) / 2; u.pm = 64 + (l >> 4); u.pn = (l >> 2) & 3; u.q = q; u.nt = q < 2 ? hi : lo; u.kofs = 64 * (q < 2 ? q * hi : 2 * hi + (q - 2) * lo); } return true; }
        if (mode == 3) { const int L = (int)L0; if (L < 256) { const int v = (L % 8) * 32 + L / 8; u.pm = v / 4; u.pn = v % 4; }
            else { const int l = L - 256, q = l & 1; u.pm = 64 + (l >> 3); u.pn = (l >> 1) & 3; u.q = q; u.nt = nN / 2; u.kofs = 64 * q * (nN / 2); } return true; }
        int L = (int)L0; { const int q = n / 8, r = n % 8, xcd = L % 8, off = L / 8; L = (xcd < r ? xcd * (q + 1) : r * (q + 1) + (xcd - r) * q) + off; }
        if (mode == 0) {
            if (L < 594) { u.pm = L / 9; u.pn = RT_WIN + L % 9; }
            else if (L < 658) { const int l = L - 594; u.pm = RT_MN + l / 8; u.pn = RT_WXKV + l % 8; }
            else if (L < 690) { const int l = L - 658; u.pm = RT_WXKV + 4 + l / 8; u.pn = RT_MN + l % 8; }
            else { u.pm = RT_WIN + 8; u.pn = L - 690; }
        } else { u.pm = L / nN; u.pn = L % nN; }
        return true;
    }
    __device__ __forceinline__ void a_ready(const pg8::Unit&) const {}
    __device__ __forceinline__ void done(const pg8::Unit&) const {}
};
struct EpiP1 {
    static constexpr bool PERM = false, AFTER_DRAIN = false;
    bf16_t* proj; bf16_t* mk; bf16_t* mv; bf16_t* mvt; bf16_t* kvt;
    __device__ __forceinline__ void operator()(const f32x4 (&acc)[2][2][4][2], const pg8::Unit& u, int wr, int wc, int fr, int fq) const {
        bf16_t* base; int ld;
        if (u.pm < RT_MN) { base = proj + (size_t)(u.pm * 256) * NPROJ + (u.pn - RT_WIN) * 256; ld = NPROJ; }
        else if (u.pm < RT_WIN) { const int ct = u.pn - RT_WXKV; base = (ct < 4 ? mk + ct * 256 : mv + (ct - 4) * 256) + (size_t)((u.pm - RT_MN) * 256) * 1024; ld = 1024; }
        else if (u.pm == RT_WIN + 8) { base = kvt + u.pn * 256; ld = TT; }
        else { base = mvt + (size_t)((u.pm - RT_WXKV - 4) * 256) * 2048 + (u.pn - RT_MN) * 256; ld = 2048; }
#pragma unroll
        for (int ai = 0; ai < 2; ++ai)
#pragma unroll
            for (int m = 0; m < 4; ++m) {
                bf16_t* rowp = base + (size_t)(128 * ai + 64 * wr + 16 * m + fr) * ld + 32 * wc + 4 * fq;
#pragma unroll
                for (int bj = 0; bj < 2; ++bj)
#pragma unroll
                    for (int n = 0; n < 2; ++n) { const f32x4 v = acc[ai][bj][m][n]; u32x2 w; w.x = pk2(v[0], v[1]); w.y = pk2(v[2], v[3]); *(u32x2*)(rowp + 128 * bj + 16 * n) = w; }
            }
    }
};
struct EpiBf {
    static constexpr bool PERM = false, AFTER_DRAIN = false;
    bf16_t* O; int ldc; float scale; float* part;
    __device__ __forceinline__ void operator()(const f32x4 (&acc)[2][2][4][2], const pg8::Unit& u, int wr, int wc, int fr, int fq) const {
        if (u.nt) {
#pragma unroll
            for (int ai = 0; ai < 2; ++ai)
#pragma unroll
                for (int m = 0; m < 4; ++m) { float* rowp = part + (size_t)u.q * 512 * 1024 + (size_t)((u.pm - 64) * 256 + 128 * ai + 64 * wr + 16 * m + fr) * 1024 + u.pn * 256 + 32 * wc + 4 * fq;
#pragma unroll
                    for (int bj = 0; bj < 2; ++bj)
#pragma unroll
                        for (int n = 0; n < 2; ++n) *(f32x4*)(rowp + 128 * bj + 16 * n) = acc[ai][bj][m][n]; }
            return;
        }
#pragma unroll
        for (int ai = 0; ai < 2; ++ai)
#pragma unroll
            for (int m = 0; m < 4; ++m) {
                bf16_t* rowp = O + (size_t)(u.pm * 256 + 128 * ai + 64 * wr + 16 * m + fr) * ldc + u.pn * 256 + 32 * wc + 4 * fq;
#pragma unroll
                for (int bj = 0; bj < 2; ++bj)
#pragma unroll
                    for (int n = 0; n < 2; ++n) { const f32x4 v = acc[ai][bj][m][n] * scale; u32x2 w; w.x = pk2(v[0], v[1]); w.y = pk2(v[2], v[3]); *(u32x2*)(rowp + 128 * bj + 16 * n) = w; }
            }
    }
};
struct EpiGU {
    static constexpr bool PERM = false, AFTER_DRAIN = false;
    bf16_t* O;
    __device__ __forceinline__ void operator()(const f32x4 (&acc)[2][2][4][2], const pg8::Unit& u, int wr, int wc, int fr, int fq) const {
#pragma unroll
        for (int ai = 0; ai < 2; ++ai)
#pragma unroll
            for (int m = 0; m < 4; ++m) {
                bf16_t* rowp = O + (size_t)(u.pm * 256 + 128 * ai + 64 * wr + 16 * m + fr) * DFF + u.pn * 128 + 16 * wc + 4 * fq;
#pragma unroll
                for (int bj = 0; bj < 2; ++bj) { const f32x4 g = acc[ai][bj][m][0], up = acc[ai][bj][m][1];
                    u32x2 w; w.x = pk2(silu_f(g[0]) * up[0], silu_f(g[1]) * up[1]); w.y = pk2(silu_f(g[2]) * up[2], silu_f(g[3]) * up[3]); *(u32x2*)(rowp + 64 * bj) = w; }
            }
    }
};

struct TrSrc { const float* lo; const float* hi; int ld; };
__device__ __forceinline__ void tr_item(const TrSrc s, int k0, bf16_t* dst, int K, LAS float* scr, int lane) {
    const float* p = (lane & 16) ? s.hi + (lane & 15) : s.lo + (lane & 15);
    float tv[32];
#pragma unroll
    for (int i = 0; i < 32; ++i) { const int kk = 2 * i + (lane >> 5); tv[i] = p[(size_t)(k0 + kk) * s.ld]; }
#pragma unroll
    for (int i = 0; i < 32; ++i) { const int kk = 2 * i + (lane >> 5); scr[kk * 33 + (lane & 31)] = tv[i]; }
    LDSW();
    const int c = lane & 7;
#pragma unroll
    for (int j = 0; j < 4; ++j) { const int n = (lane >> 3) + 8 * j; const LAS float* q = scr + (8 * c) * 33 + n;
        u32x4 o; o.x = pk2(q[0], q[33]); o.y = pk2(q[2 * 33], q[3 * 33]); o.z = pk2(q[4 * 33], q[5 * 33]); o.w = pk2(q[6 * 33], q[7 * 33]);
        *(u32x4*)(dst + (size_t)n * K + 8 * c) = o; }
    LDSW();
}
__device__ __forceinline__ void rms_apply(f32x4 (&v)[4], const float* g, int lane) {
    float ss = 0.f;
#pragma unroll
    for (int j = 0; j < 4; ++j) ss += (v[j][0] * v[j][0] + v[j][1] * v[j][1]) + (v[j][2] * v[j][2] + v[j][3] * v[j][3]);
    const float r = rsqrtf(wave_sum(ss) * (1.f / 1024.f) + EPS);
#pragma unroll
    for (int j = 0; j < 4; ++j) { const f32x4 gv = *(const f32x4*)(g + 4 * lane + 256 * j); v[j] = v[j] * r * gv; }
}
__device__ __forceinline__ void store_row_bf16(bf16_t* o, const f32x4 (&v)[4], int lane) {
#pragma unroll
    for (int j = 0; j < 4; ++j) { u32x2 w; w.x = pk2(v[j][0], v[j][1]); w.y = pk2(v[j][2], v[j][3]); *(u32x2*)(o + 4 * lane + 256 * j) = w; }
}
__device__ __forceinline__ void load_row_f32(f32x4 (&v)[4], const float* x, int lane) {
#pragma unroll
    for (int j = 0; j < 4; ++j) v[j] = *(const f32x4*)(x + 4 * lane + 256 * j);
}

__device__ __forceinline__ void tr_items(CP P, LAS unsigned char* lds, int part, int gw, int NGW, int wave, int lane) {
    unsigned char* ws = P->ws;
    LAS float* scr = (LAS float*)(lds + wave * 16384);
    constexpr int I_IN = 72 * 16, I_SQ = 512, I_GU = 176 * 16, I_DN = 32 * 44;
    const int nitems = part == 0 ? I_IN + 3 * I_SQ : 2 * I_SQ + I_GU + I_DN;
    for (int it = gw; it < nitems; it += NGW) {
        int r = it; TrSrc s; bf16_t* dst; int K = 1024, k0; int which = -1;
        if (part == 0) { if (r >= I_IN) { r -= I_IN; const int w3 = r / I_SQ; r %= I_SQ; which = w3 == 0 ? 0 : w3 + 2; } }
        else { if (r < 2 * I_SQ) { which = 1 + r / I_SQ; r %= I_SQ; } else r -= 2 * I_SQ; }
        if (part == 0 && which < 0) { const int nb = r / 16, kb = r % 16, n0 = nb * 32, sc = n0 + (n0 >= 1536 ? 8 : 0);
            s.lo = P->in[10] + sc; s.hi = s.lo + 16; s.ld = INDIM; k0 = kb * 64; dst = (bf16_t*)(ws + WS_WIN) + (size_t)n0 * 1024 + k0; }
        else if (which >= 0) { const int nb = r / 16, kb = r % 16;
            const float* W = which == 0 ? P->in[18] : which == 1 ? P->in[21] : which == 2 ? P->in[25] : which == 3 ? P->in[23] : P->in[24];
            bf16_t* D = which == 0 ? (bf16_t*)(ws + WS_WOUT) : which == 1 ? (bf16_t*)(ws + WS_WXQ) : which == 2 ? (bf16_t*)(ws + WS_WXO) : which == 3 ? (bf16_t*)(ws + WS_WXKV) : (bf16_t*)(ws + WS_WXKV) + (size_t)1024 * 1024;
            s.lo = W + nb * 32; s.hi = s.lo + 16; s.ld = 1024; k0 = kb * 64; dst = D + (size_t)nb * 32 * 1024 + k0; }
        else if (r < I_GU) { const int nb = r / 16, kb = r % 16;
            s.lo = P->in[28] + nb * 16; s.hi = P->in[29] + nb * 16; s.ld = DFF; k0 = kb * 64; dst = (bf16_t*)(ws + WS_WGU) + (size_t)nb * 32 * 1024 + k0; }
        else { r -= I_GU; const int nb = r / 44, kb = r % 44; K = DFF;
            s.lo = P->in[30] + nb * 32; s.hi = s.lo + 16; s.ld = 1024; k0 = kb * 64; dst = (bf16_t*)(ws + WS_WDN) + (size_t)nb * 32 * DFF + k0; }
        tr_item(s, k0, dst, K, scr, lane);
    }
}
__device__ __forceinline__ void phase_prologue(CP P, LAS unsigned char* lds, int gw, int NGW, int wave, int lane) {
    unsigned char* ws = P->ws;
    tr_items(P, lds, 0, gw, NGW, wave, lane);
    __syncthreads();
    LAS float* wT = (LAS float*)lds;
    { const int tid = wave * 64 + lane;
#pragma unroll
      for (int it = 0; it < 4; ++it) { const int idx = tid + 512 * it, c = idx >> 1, hf = idx & 1; const f32x4 w = *(const f32x4*)(P->in[10] + (size_t)c * INDIM + 1536 + 4 * hf);
          wT[(4 * hf + 0) * 1024 + c] = w[0]; wT[(4 * hf + 1) * 1024 + c] = w[1]; wT[(4 * hf + 2) * 1024 + c] = w[2]; wT[(4 * hf + 3) * 1024 + c] = w[3]; } }
    __syncthreads();
    {
        f32x4 nx[4];
        if (gw < TT) load_row_f32(nx, gw < TP ? P->in[0] + (size_t)gw * 1024 : P->in[1] + (size_t)(gw - TP) * 1024, lane);
        for (int m = gw; m < TT; m += NGW) {
            f32x4 v[4];
#pragma unroll
            for (int j = 0; j < 4; ++j) v[j] = nx[j];
            const int m2 = m + NGW;
            if (m2 < TT) load_row_f32(nx, m2 < TP ? P->in[0] + (size_t)m2 * 1024 : P->in[1] + (size_t)(m2 - TP) * 1024, lane);
            rms_apply(v, P->in[9], lane);
            store_row_bf16((bf16_t*)(ws + WS_H0) + (size_t)m * 1024, v, lane);
            float d[8];
#pragma unroll
            for (int e = 0; e < 8; ++e) { float a = 0.f;
#pragma unroll
                for (int j = 0; j < 4; ++j) { const f32x4 w = *(const LAS f32x4*)(wT + e * 1024 + 4 * lane + 256 * j); a += (v[j][0] * w[0] + v[j][1] * w[1]) + (v[j][2] * w[2] + v[j][3] * w[3]); }
                d[e] = wave_sum(a); }
            if (lane == 0) { float* o = (float*)(ws + WS_DTRAW) + (size_t)m * 8; *(f32x4*)o = (f32x4){d[0], d[1], d[2], d[3]}; *(f32x4*)(o + 4) = (f32x4){d[4], d[5], d[6], d[7]}; }
        }
    }
    __syncthreads();
    for (int m = gw; m < 2048; m += NGW) {
        f32x4 v[4]; load_row_f32(v, P->in[8] + (size_t)m * 1024, lane); rms_apply(v, P->in[22], lane);
        store_row_bf16((bf16_t*)(ws + WS_MN) + (size_t)m * 1024, v, lane);
    }
}

__device__ __forceinline__ void phase_resid(CP P, int stage, int gw, int NGW, int lane) {
    unsigned char* ws = P->ws; const bf16_t* C = (const bf16_t*)(ws + WS_CB16); bf16_t* XB = (bf16_t*)(ws + WS_X1);
    const float* g1 = stage == 0 ? P->in[19] : stage == 1 ? P->in[26] : P->in[31];
    const float* g2 = stage == 0 ? P->in[20] : P->in[27];
    for (int m = gw; m < TT; m += NGW) {
        f32x4 c[4], x[4];
        if (m >= TP) { const float* pp_ = (const float*)(ws + WS_SPLIT) + (size_t)(stage == 0 ? 0 : stage == 1 ? 8 : 12) * 512 * 1024 + (size_t)(m - TP) * 1024; f32x4 c1[4], c2[4], c3[4];
            load_row_f32(c, pp_, lane); load_row_f32(c1, pp_ + 512 * 1024, lane);
            if (stage == 2) { load_row_f32(c2, pp_ + 2 * 512 * 1024, lane); load_row_f32(c3, pp_ + 3 * 512 * 1024, lane); }
#pragma unroll
            for (int j = 0; j < 4; ++j) c[j] = stage == 2 ? (c[j] + c1[j]) + (c2[j] + c3[j]) : c[j] + c1[j]; }
        else {
#pragma unroll
        for (int j = 0; j < 4; ++j) { const u32x2 w = *(const u32x2*)(C + (size_t)m * 1024 + 4 * lane + 256 * j);
            c[j] = (f32x4){__uint_as_float(w.x << 16), __uint_as_float(w.x & 0xffff0000u), __uint_as_float(w.y << 16), __uint_as_float(w.y & 0xffff0000u)}; }
        }
        if (stage == 0) load_row_f32(x, m < TP ? P->in[0] + (size_t)m * 1024 : P->in[1] + (size_t)(m - TP) * 1024, lane);
        else {
#pragma unroll
            for (int j = 0; j < 4; ++j) { const u32x2 w = *(const u32x2*)(XB + (size_t)m * 1024 + 4 * lane + 256 * j);
                x[j] = (f32x4){__uint_as_float(w.x << 16), __uint_as_float(w.x & 0xffff0000u), __uint_as_float(w.y << 16), __uint_as_float(w.y & 0xffff0000u)}; }
        }
        rms_apply(c, g1, lane);
#pragma unroll
        for (int j = 0; j < 4; ++j) x[j] = x[j] + c[j];
        if (stage == 2) {
#pragma unroll
            for (int j = 0; j < 4; ++j) *(f32x4*)(P->out + (size_t)m * 1024 + 4 * lane + 256 * j) = x[j];
        } else {
#pragma unroll
            for (int j = 0; j < 4; ++j) { u32x2 w; w.x = pk2(x[j][0], x[j][1]); w.y = pk2(x[j][2], x[j][3]); *(u32x2*)(XB + (size_t)m * 1024 + 4 * lane + 256 * j) = w;
                x[j] = (f32x4){__uint_as_float(w.x << 16), __uint_as_float(w.x & 0xffff0000u), __uint_as_float(w.y << 16), __uint_as_float(w.y & 0xffff0000u)}; }
            rms_apply(x, g2, lane); store_row_bf16((bf16_t*)(ws + WS_H0) + (size_t)m * 1024, x, lane);
        }
    }
}

__device__ __forceinline__ void conv8(const bf16_t* col, int t0, bool zero_hist, const float (&w)[4], float bias, float (&out)[8], float (&raw)[11]) {
#pragma unroll
    for (int i = 0; i < 11; ++i) { const int r = t0 - 3 + i; raw[i] = (r < 0 && zero_hist) ? 0.f : bf2f(col[(long)r * NPROJ]); }
#pragma unroll
    for (int j = 0; j < 8; ++j) out[j] = silu_f(bias + w[0] * raw[j] + w[1] * raw[j + 1] + w[2] * raw[j + 2] + w[3] * raw[j + 3]);
}
__device__ __forceinline__ void conv8x2(const bf16_t* col, int t0, bool zero_hist, const float* cw, const float* cb, int ch, float (&o0)[8], float (&o1)[8]) {
    float r0[11], r1[11];
#pragma unroll
    for (int i = 0; i < 11; ++i) { const int r = t0 - 3 + i; unsigned w = 0u; if (!(r < 0 && zero_hist)) w = *(const unsigned*)(col + (long)r * NPROJ); r0[i] = __uint_as_float(w << 16); r1[i] = __uint_as_float(w & 0xffff0000u); }
    const float b0 = cb[ch], b1 = cb[ch + 1];
    float w0[4], w1[4];
#pragma unroll
    for (int j = 0; j < 4; ++j) { w0[j] = cw[j * 1024 + ch]; w1[j] = cw[j * 1024 + ch + 1]; }
#pragma unroll
    for (int j = 0; j < 8; ++j) { o0[j] = silu_f(b0 + w0[0] * r0[j] + w0[1] * r0[j + 1] + w0[2] * r0[j + 2] + w0[3] * r0[j + 3]);
                                  o1[j] = silu_f(b1 + w1[0] * r1[j] + w1[1] * r1[j + 1] + w1[2] * r1[j + 2] + w1[3] * r1[j + 3]); }
}
__device__ __forceinline__ void dt_acum(CP P, int row0, int g, LAS float* dtv, LAS float* acum, int wave, int lane) {
    if (wave < 4) {
        const int h = g * 4 + wave; const float* dr = (const float*)(P->ws + WS_DTRAW);
        const float bias = P->in[13][h], a = -__expf(P->in[14][h]);
        const float d0 = softplus_f(dr[(size_t)(row0 + 2 * lane) * 8 + h] + bias), d1 = softplus_f(dr[(size_t)(row0 + 2 * lane + 1) * 8 + h] + bias);
        const float a0 = a * d0, a1 = a * d1; float s = a0 + a1;
#pragma unroll
        for (int o = 1; o < 64; o <<= 1) { const float t = __shfl_up(s, o); if (lane >= o) s += t; }
        dtv[(2 * lane) * 4 + wave] = d0; dtv[(2 * lane + 1) * 4 + wave] = d1;
        acum[(2 * lane) * 4 + wave] = s - a1; acum[(2 * lane + 1) * 4 + wave] = s;
    }
}

constexpr int PT = 136;
__device__ __forceinline__ void ssd_pass_a(CP P, LAS unsigned char* lds, int unit, int tid, int wave, int lane) {
    const int b = unit >> 5, c = (unit >> 1) & 15, g = unit & 1, row0 = b * SEQ + c * 128;
    LAS bf16_t* BT = (LAS bf16_t*)lds;
    LAS bf16_t* XW = (LAS bf16_t*)(lds + 128 * PT * 2);
    LAS float* dtv = (LAS float*)(lds + 384 * PT * 2); LAS float* acum = dtv + 512;
    const bf16_t* proj = (const bf16_t*)(P->ws + WS_PROJ);
    dt_acum(P, row0, g, dtv, acum, wave, lane);
    __syncthreads();
#pragma unroll 3
    for (int kk_ = 0; kk_ < 6; ++kk_) {
        const int it = tid + 512 * kk_;
        const int pr = it % 192, tb = it / 192, t0 = tb * 8, chl = 2 * pr;
        const int ch = chl < 256 ? g * 256 + chl : 512 + g * 128 + (chl - 256);
        float o0[8], o1[8]; conv8x2(proj + (size_t)row0 * NPROJ + 512 + ch, t0, c == 0, P->in[11], P->in[12], ch, o0, o1);
        if (chl < 256) { const int hh = chl >> 6; const float aend = acum[127 * 4 + hh];
#pragma unroll
            for (int j = 0; j < 8; ++j) { const float wg = dtv[(t0 + j) * 4 + hh] * __expf(aend - acum[(t0 + j) * 4 + hh]); o0[j] *= wg; o1[j] *= wg; } }
        u32x4 pk0, pk1; pk0.x = pk2(o0[0], o0[1]); pk0.y = pk2(o0[2], o0[3]); pk0.z = pk2(o0[4], o0[5]); pk0.w = pk2(o0[6], o0[7]);
        pk1.x = pk2(o1[0], o1[1]); pk1.y = pk2(o1[2], o1[3]); pk1.z = pk2(o1[4], o1[5]); pk1.w = pk2(o1[6], o1[7]);
        LAS bf16_t* d = chl < 256 ? XW + chl * PT + t0 : BT + (chl - 256) * PT + t0;
        *(LAS u32x4*)d = pk0; *(LAS u32x4*)(d + PT) = pk1;
    }
    __syncthreads();
    float* cs = (float*)(P->ws + WS_CS) + (size_t)((b * 16 + c) * 8 + g * 4) * 8192;
#pragma unroll
    for (int mt = 0; mt < 2; ++mt) {
        f32x4 acc[8];
#pragma unroll
        for (int n = 0; n < 8; ++n) acc[n] = (f32x4){0.f, 0.f, 0.f, 0.f};
        const int r0 = 32 * wave + 16 * mt;
        mma_lds<8>(acc, XW + r0 * PT, PT, BT, PT, 128, lane);
        const int fr = lane & 15, fq = lane >> 4;
#pragma unroll
        for (int n = 0; n < 8; ++n) *(f32x4*)(cs + (size_t)(r0 + fr) * 128 + 16 * n + 4 * fq) = acc[n];
    }
    if (tid < 4) ((float*)(P->ws + WS_ATOT))[(b * 16 + c) * 8 + g * 4 + tid] = acum[127 * 4 + tid];
    __syncthreads();
}

__device__ __forceinline__ void ssd_state_scan(CP P, int bid, int G, int tid) {
    for (int base_ = bid * 512; base_ < 8 * 8 * 2048; base_ += G * 512) {
        const int i = base_ + tid, bh = i >> 11, e4 = i & 2047, b = bh >> 3, h = bh & 7;
        float* cs = (float*)(P->ws + WS_CS) + (size_t)(b * 16 * 8 + h) * 8192 + 4 * e4;
        const float* at = (const float*)(P->ws + WS_ATOT) + b * 16 * 8 + h;
        f32x4 v[16]; float dec[16];
#pragma unroll
        for (int c = 0; c < 16; ++c) { v[c] = *(const f32x4*)(cs + (size_t)c * 8 * 8192); dec[c] = __expf(at[c * 8]); }
        f32x4 st = (f32x4){0.f, 0.f, 0.f, 0.f};
#pragma unroll
        for (int c = 0; c < 16; ++c) { *(f32x4*)(cs + (size_t)c * 8 * 8192) = st; st = st * dec[c] + v[c]; }
        *(f32x4*)(P->out + O_PSSM + (size_t)(b * 8 + h) * 8192 + 4 * e4) = st;
    }
}

__device__ __forceinline__ void ssd_pass_b(CP P, LAS unsigned char* lds, int unit, int tid, int wave, int lane) {
    const int b = unit >> 5, c = (unit >> 1) & 15, g = unit & 1, row0 = b * SEQ + c * 128;
    const int fr = lane & 15, fq = lane >> 4;
    LAS bf16_t* Cs = (LAS bf16_t*)lds;
    LAS bf16_t* Bs = (LAS bf16_t*)(lds + 128 * PT * 2);
    LAS bf16_t* XT = (LAS bf16_t*)(lds + 256 * PT * 2);
    LAS bf16_t* SI = (LAS bf16_t*)(lds + 320 * PT * 2);
    LAS float* dtv = (LAS float*)(lds + 384 * PT * 2); LAS float* acum = dtv + 512;
    const bf16_t* proj = (const bf16_t*)(P->ws + WS_PROJ);
    dt_acum(P, row0, g, dtv, acum, wave, lane);
#pragma unroll 4
    for (int kk_ = 0; kk_ < 4; ++kk_) {
        const int it = tid + 512 * kk_;
        const int chl = 2 * (it & 127), tb = it >> 7, t0 = tb * 8;
        const int ch = chl < 128 ? 512 + g * 128 + chl : 768 + g * 128 + (chl - 128);
        float o0[8], o1[8]; conv8x2(proj + (size_t)row0 * NPROJ + 512 + ch, t0, c == 0, P->in[11], P->in[12], ch, o0, o1);
        LAS bf16_t* d = chl < 128 ? Bs + chl : Cs + (chl - 128);
#pragma unroll
        for (int j = 0; j < 8; ++j) *(LAS unsigned*)(d + (t0 + j) * PT) = pk2(o0[j], o1[j]);
    }
    if (c == 15) {
        const int ch = tid < 256 ? g * 256 + tid : (tid < 384 ? 512 + g * 128 + (tid - 256) : 768 + g * 128 + (tid - 384));
#pragma unroll
        for (int i = 0; i < 3; ++i) P->out[O_PCONV + (size_t)(b * 3 + i) * 1024 + ch] = bf2f(proj[(size_t)(row0 + 125 + i) * NPROJ + 512 + ch]);
    }
    __syncthreads();
    f32x4 cb[8];
#pragma unroll
    for (int n = 0; n < 8; ++n) cb[n] = (f32x4){0.f, 0.f, 0.f, 0.f};
    mma_lds<8>(cb, Cs + 16 * wave * PT, PT, Bs, PT, 128, lane);
    __syncthreads();
    LAS bf16_t* Ls = Bs;
    const int t = 16 * wave + fr;
    float ss = 0.f;
    const bf16_t* zr = proj + (size_t)(row0 + t) * NPROJ + g * 256;
    bf16_t* orow = (bf16_t*)(P->ws + WS_MIXIN) + (size_t)(row0 + t) * 1024 + g * 256;
#pragma unroll 1
    for (int hh = 0; hh < 4; ++hh) {
        const int h = g * 4 + hh;
        u32x2 zw4[4];
#pragma unroll
        for (int n = 0; n < 4; ++n) zw4[n] = *(const u32x2*)(zr + hh * 64 + 16 * n + 4 * fq);
        {
            const int p = 2 * (tid & 31), tb = tid >> 5, t0 = tb * 8, ch = h * 64 + p;
            float o0[8], o1[8]; conv8x2(proj + (size_t)row0 * NPROJ + 512 + ch, t0, c == 0, P->in[11], P->in[12], ch, o0, o1);
            u32x4 pk0, pk1; pk0.x = pk2(o0[0], o0[1]); pk0.y = pk2(o0[2], o0[3]); pk0.z = pk2(o0[4], o0[5]); pk0.w = pk2(o0[6], o0[7]);
            pk1.x = pk2(o1[0], o1[1]); pk1.y = pk2(o1[2], o1[3]); pk1.z = pk2(o1[4], o1[5]); pk1.w = pk2(o1[6], o1[7]);
            *(LAS u32x4*)(XT + p * PT + t0) = pk0; *(LAS u32x4*)(XT + (p + 1) * PT + t0) = pk1;
        }
        {
            const int p = tid >> 3, n0 = (tid & 7) * 16;
            const float* src = (const float*)(P->ws + WS_CS) + (size_t)((b * 16 + c) * 8 + h) * 8192 + p * 128 + n0;
#pragma unroll
            for (int q = 0; q < 4; ++q) { const f32x4 sv = *(const f32x4*)(src + 4 * q); u32x2 w2; w2.x = pk2(sv[0], sv[1]); w2.y = pk2(sv[2], sv[3]); *(LAS u32x2*)(SI + p * PT + n0 + 4 * q) = w2; }
        }
        {
            const float at_ = acum[t * 4 + hh];
#pragma unroll
            for (int n = 0; n < 8; ++n) {
                float l[4];
#pragma unroll
                for (int e = 0; e < 4; ++e) { const int s_ = 16 * n + 4 * fq + e; l[e] = (s_ <= t) ? cb[n][e] * __expf(at_ - acum[s_ * 4 + hh]) * dtv[s_ * 4 + hh] : 0.f; }
                u32x2 w2; w2.x = pk2(l[0], l[1]); w2.y = pk2(l[2], l[3]); *(LAS u32x2*)(Ls + t * PT + 16 * n + 4 * fq) = w2;
            }
        }
        __syncthreads();
        {
            f32x4 yd[4], yo[4];
#pragma unroll
            for (int n = 0; n < 4; ++n) { yd[n] = (f32x4){0.f, 0.f, 0.f, 0.f}; yo[n] = (f32x4){0.f, 0.f, 0.f, 0.f}; }
            mma_lds<4>(yd, Ls + 16 * wave * PT, PT, XT, PT, 128, lane);
            mma_lds<4>(yo, Cs + 16 * wave * PT, PT, SI, PT, 128, lane);
            const float ea = __expf(acum[t * 4 + hh]), dsk = P->in[15][h];
#pragma unroll
            for (int n = 0; n < 4; ++n) {
                const u32x2 zw = zw4[n];
                const float z[4] = {__uint_as_float(zw.x << 16), __uint_as_float(zw.x & 0xffff0000u), __uint_as_float(zw.y << 16), __uint_as_float(zw.y & 0xffff0000u)};
                float u[4];
#pragma unroll
                for (int e = 0; e < 4; ++e) { u[e] = (yd[n][e] + ea * yo[n][e] + dsk * bf2f(XT[(16 * n + 4 * fq + e) * PT + t])) * silu_f(z[e]); ss += u[e] * u[e]; }
                u32x2 w2; w2.x = pk2(u[0], u[1]); w2.y = pk2(u[2], u[3]); *(u32x2*)(orow + hh * 64 + 16 * n + 4 * fq) = w2;
            }
        }
        __syncthreads();
    }
    {
        ss += __shfl_xor(ss, 16); ss += __shfl_xor(ss, 32);
        const float r = rsqrtf(ss * (1.f / 256.f) + EPS);
#pragma unroll
        for (int hh = 0; hh < 4; ++hh)
#pragma unroll
            for (int n = 0; n < 4; ++n) { const int col = hh * 64 + 16 * n + 4 * fq; const f32x4 gv = *(const f32x4*)(P->in[16] + g * 256 + col);
                const u32x2 uw = *(const u32x2*)(orow + col);
                const float u0 = __uint_as_float(uw.x << 16) * r * gv[0], u1 = __uint_as_float(uw.x & 0xffff0000u) * r * gv[1], u2 = __uint_as_float(uw.y << 16) * r * gv[2], u3 = __uint_as_float(uw.y & 0xffff0000u) * r * gv[3];
                u32x2 w2; w2.x = pk2(u0, u1); w2.y = pk2(u2, u3); *(u32x2*)(orow + col) = w2; }
    }
    __syncthreads();
}

constexpr int PK = 72, PV = 264;
__device__ __forceinline__ void swa_prompt(CP P, LAS unsigned char* lds, int unit, int tid, int wave, int lane) {
    const int b = unit >> 5, nb = (unit >> 1) & 15, kvh = unit & 1, row0 = b * SEQ + nb * 128;
    const int fr = lane & 15, fq = lane >> 4;
    LAS bf16_t* Ks = (LAS bf16_t*)lds;
    LAS bf16_t* VT = (LAS bf16_t*)(lds + 256 * PK * 2);
    const bf16_t* proj = (const bf16_t*)(P->ws + WS_PROJ); const bf16_t* kvt = (const bf16_t*)(P->ws + WS_KVT);
#pragma unroll
    for (int kk_ = 0; kk_ < 4; ++kk_) {
        const int ci = tid + 512 * kk_;
        { const int row = ci >> 3, c8 = ci & 7; u32x4 v = (u32x4){0u, 0u, 0u, 0u};
          if (!(nb == 0 && row < 128)) v = *(const u32x4*)(proj + (size_t)(row0 - 128 + row) * NPROJ + 2048 + kvh * 64 + c8 * 8);
          *(LAS u32x4*)(Ks + row * PK + c8 * 8) = v; }
        { const int d = ci >> 5, c = ci & 31; u32x4 v = (u32x4){0u, 0u, 0u, 0u};
          if (!(nb == 0 && c < 16)) v = *(const u32x4*)(kvt + (size_t)(128 + kvh * 64 + d) * TT + row0 - 128 + c * 8);
          *(LAS u32x4*)(VT + d * PV + c * 8) = v; }
    }
    __syncthreads();
    const int r = wave >> 1, head = kvh * 4 + r; const float sink = P->in[17][head];
    bf16x8 qn[2];
#pragma unroll
    for (int ks = 0; ks < 2; ++ks) qn[ks] = *(const bf16x8*)(proj + (size_t)(row0 + (wave & 1) * 64 + fr) * NPROJ + 1536 + head * 64 + ks * 32 + 8 * fq);
    for (int st = 0; st < 4; ++st) {
        const int q0 = (wave & 1) * 64 + 16 * st, qi = q0 + fr;
        bf16x8 qf[2];
#pragma unroll
        for (int ks = 0; ks < 2; ++ks) qf[ks] = qn[ks];
        if (st < 3) {
#pragma unroll
            for (int ks = 0; ks < 2; ++ks) qn[ks] = *(const bf16x8*)(proj + (size_t)(row0 + qi + 16) * NPROJ + 1536 + head * 64 + ks * 32 + 8 * fq);
        }
        f32x4 s[16];
#pragma unroll
        for (int n = 0; n < 16; ++n) s[n] = (f32x4){0.f, 0.f, 0.f, 0.f};
        mma_areg<16, 2, 0, 2>(s, qf, Ks, PK, lane);
        float mx = sink;
#pragma unroll
        for (int n = 0; n < 16; ++n)
#pragma unroll
            for (int e = 0; e < 4; ++e) { const int kj = 16 * n + 4 * fq + e; const bool ok = (kj > qi) && (kj <= qi + 128) && (nb > 0 || kj >= 128);
                const float v = ok ? s[n][e] * 0.125f : -INFINITY; s[n][e] = v; mx = fmaxf(mx, v); }
        mx = fmaxf(mx, __shfl_xor(mx, 16)); mx = fmaxf(mx, __shfl_xor(mx, 32));
        float sum = 0.f;
#pragma unroll
        for (int n = 0; n < 16; ++n)
#pragma unroll
            for (int e = 0; e < 4; ++e) { const float ev = __expf(s[n][e] - mx); s[n][e] = ev; sum += ev; }
        sum += __shfl_xor(sum, 16); sum += __shfl_xor(sum, 32);
        const float inv = 1.f / (sum + __expf(sink - mx));
        bf16x8 pf[8];
#pragma unroll
        for (int ks = 0; ks < 8; ++ks) { u32x4 w; w.x = pk2(s[2 * ks][0] * inv, s[2 * ks][1] * inv); w.y = pk2(s[2 * ks][2] * inv, s[2 * ks][3] * inv);
            w.z = pk2(s[2 * ks + 1][0] * inv, s[2 * ks + 1][1] * inv); w.w = pk2(s[2 * ks + 1][2] * inv, s[2 * ks + 1][3] * inv); pf[ks] = __builtin_bit_cast(bf16x8, w); }
        f32x4 o[4];
#pragma unroll
        for (int n = 0; n < 4; ++n) o[n] = (f32x4){0.f, 0.f, 0.f, 0.f};
#pragma unroll
        for (int ks = 0; ks < 8; ++ks) {
#pragma unroll
            for (int n = 0; n < 4; ++n) {
                const LAS bf16_t* vp = VT + (16 * n + fr) * PV + 32 * ks + 4 * fq;
                const u32x2 a0 = *(const LAS u32x2*)vp, a1 = *(const LAS u32x2*)(vp + 16);
                o[n] = __builtin_amdgcn_mfma_f32_16x16x32_bf16(__builtin_bit_cast(bf16x8, (u32x4){a0.x, a0.y, a1.x, a1.y}), pf[ks], o[n], 0, 0, 0);
            }
            __builtin_amdgcn_sched_barrier(0);
        }
        asm volatile("s_nop 7\n\ts_nop 7\n\ts_nop 7" ::: "memory");
        bf16_t* op = (bf16_t*)(P->ws + WS_MIXIN) + (size_t)(row0 + qi) * 1024 + 512 + head * 64 + 4 * fq;
#pragma unroll
        for (int n = 0; n < 4; ++n) { u32x2 w2; w2.x = pk2(o[n][0], o[n][1]); w2.y = pk2(o[n][2], o[n][3]); *(u32x2*)(op + 16 * n) = w2; }
        LDSW();
    }
    __syncthreads();
}

__device__ __forceinline__ void ssd_sample(CP P, LAS unsigned char* lds, int unit, int tid, int wave, int lane) {
    const int b = unit >> 1, g = unit & 1, row0 = TP + b * 4;
    LAS float* xs = (LAS float*)lds;
    LAS float* Bsm = xs + 1024;
    LAS float* Csm = Bsm + 512;
    LAS float* ys = Csm + 512;
    LAS float* dts = ys + 1024;
    const bf16_t* proj = (const bf16_t*)(P->ws + WS_PROJ);
    {
        const int ch = tid < 256 ? g * 256 + tid : (tid < 384 ? 512 + g * 128 + (tid - 256) : 768 + g * 128 + (tid - 384));
        float up[7];
#pragma unroll
        for (int i = 0; i < 3; ++i) up[i] = P->in[3][(size_t)(b * 3 + i) * 1024 + ch];
#pragma unroll
        for (int i = 0; i < 4; ++i) up[3 + i] = bf2f(proj[(size_t)(row0 + i) * NPROJ + 512 + ch]);
        float w[4];
#pragma unroll
        for (int j = 0; j < 4; ++j) w[j] = P->in[11][j * 1024 + ch];
        const float bias = P->in[12][ch];
        LAS float* dst = tid < 256 ? xs + tid : (tid < 384 ? Bsm + (tid - 256) : Csm + (tid - 384)); const int pitch = tid < 256 ? 256 : 128;
#pragma unroll
        for (int i = 0; i < 4; ++i) dst[i * pitch] = silu_f(bias + w[0] * up[i] + w[1] * up[i + 1] + w[2] * up[i + 2] + w[3] * up[i + 3]);
#pragma unroll
        for (int i = 0; i < 3; ++i) P->out[O_SCONV + (size_t)(b * 3 + i) * 1024 + ch] = up[4 + i];
        if (tid < 16) { const int tt = tid >> 2, hh = tid & 3, h = g * 4 + hh; dts[tid] = softplus_f(((const float*)(P->ws + WS_DTRAW))[(size_t)(row0 + tt) * 8 + h] + P->in[13][h]); }
    }
    __syncthreads();
    const int p = tid >> 3, n0 = (tid & 7) * 16;
    f32x4 stv[4][4];
#pragma unroll
    for (int hh = 0; hh < 4; ++hh)
#pragma unroll
        for (int q = 0; q < 4; ++q) stv[hh][q] = __builtin_nontemporal_load((const f32x4*)(P->in[2] + (size_t)((b * 8 + g * 4 + hh) * 64 + p) * 128 + n0 + 4 * q));
#pragma unroll
    for (int hh = 0; hh < 4; ++hh) {
        const int h = g * 4 + hh; const float a = -__expf(P->in[14][h]), dsk = P->in[15][h];
        float st[16];
#pragma unroll
        for (int q = 0; q < 4; ++q) { const f32x4 v = stv[hh][q]; st[4 * q] = v[0]; st[4 * q + 1] = v[1]; st[4 * q + 2] = v[2]; st[4 * q + 3] = v[3]; }
#pragma unroll
        for (int tt = 0; tt < 4; ++tt) {
            const float dt = dts[tt * 4 + hh], dA = __expf(a * dt), xv = xs[tt * 256 + hh * 64 + p], dx = dt * xv; float yv = 0.f;
#pragma unroll
            for (int q = 0; q < 16; ++q) { st[q] = dA * st[q] + dx * Bsm[tt * 128 + n0 + q]; yv += st[q] * Csm[tt * 128 + n0 + q]; }
            yv += __shfl_xor(yv, 1); yv += __shfl_xor(yv, 2); yv += __shfl_xor(yv, 4);
            if ((tid & 7) == 0) ys[tt * 256 + hh * 64 + p] = yv + dsk * xv;
        }
        float* op = P->out + O_SSSM + (size_t)((b * 8 + h) * 64 + p) * 128 + n0;
#pragma unroll
        for (int q = 0; q < 4; ++q) *(f32x4*)(op + 4 * q) = (f32x4){st[4 * q], st[4 * q + 1], st[4 * q + 2], st[4 * q + 3]};
    }
    __syncthreads();
    if (wave < 4) {
        const int tt = wave; const bf16_t* zr = proj + (size_t)(row0 + tt) * NPROJ + g * 256 + 4 * lane;
        const u32x2 zw = *(const u32x2*)zr; const float z[4] = {__uint_as_float(zw.x << 16), __uint_as_float(zw.x & 0xffff0000u), __uint_as_float(zw.y << 16), __uint_as_float(zw.y & 0xffff0000u)};
        float u[4], ss = 0.f;
#pragma unroll
        for (int e = 0; e < 4; ++e) { u[e] = ys[tt * 256 + 4 * lane + e] * silu_f(z[e]); ss += u[e] * u[e]; }
        const float r = rsqrtf(wave_sum(ss) * (1.f / 256.f) + EPS); const f32x4 gv = *(const f32x4*)(P->in[16] + g * 256 + 4 * lane);
        u32x2 w2; w2.x = pk2(u[0] * r * gv[0], u[1] * r * gv[1]); w2.y = pk2(u[2] * r * gv[2], u[3] * r * gv[3]);
        *(u32x2*)((bf16_t*)(P->ws + WS_MIXIN) + (size_t)(row0 + tt) * 1024 + g * 256 + 4 * lane) = w2;
    }
    __syncthreads();
}

__device__ __forceinline__ void swa_sample(CP P, LAS unsigned char* lds, int unit, int tid, int wave, int lane) {
    const int b = unit >> 1, kvh = unit & 1, row0 = TP + b * 4;
    LAS float* Kf = (LAS float*)lds;
    LAS float* Vf = Kf + 132 * 65;
    LAS float* qf = Vf + 132 * 64;
    LAS float* sc = qf + 16 * 65;
    const bf16_t* proj = (const bf16_t*)(P->ws + WS_PROJ);
    {
        f32x4 kq[5], vq[5];
#pragma unroll
        for (int it = 0; it < 5; ++it) {
            const int i4 = tid + 512 * it, kk = i4 >> 4, d4 = (i4 & 15) * 4; kq[it] = (f32x4){0.f, 0.f, 0.f, 0.f}; vq[it] = kq[it];
            if (i4 < 132 * 16) {
                if (kk < 128) { const size_t o = (size_t)((b * 128 + kk) * 2 + kvh) * 64 + d4; kq[it] = *(const f32x4*)(P->in[4] + o); vq[it] = *(const f32x4*)(P->in[5] + o); }
                else { const bf16_t* pr = proj + (size_t)(row0 + kk - 128) * NPROJ + kvh * 64 + d4; const u32x2 a = *(const u32x2*)(pr + 2048), c = *(const u32x2*)(pr + 2176);
                    kq[it] = (f32x4){__uint_as_float(a.x << 16), __uint_as_float(a.x & 0xffff0000u), __uint_as_float(a.y << 16), __uint_as_float(a.y & 0xffff0000u)};
                    vq[it] = (f32x4){__uint_as_float(c.x << 16), __uint_as_float(c.x & 0xffff0000u), __uint_as_float(c.y << 16), __uint_as_float(c.y & 0xffff0000u)}; }
            }
        }
#pragma unroll
        for (int it = 0; it < 5; ++it) {
            const int i4 = tid + 512 * it, kk = i4 >> 4, d4 = (i4 & 15) * 4;
            if (i4 < 132 * 16) { Kf[kk * 65 + d4] = kq[it][0]; Kf[kk * 65 + d4 + 1] = kq[it][1]; Kf[kk * 65 + d4 + 2] = kq[it][2]; Kf[kk * 65 + d4 + 3] = kq[it][3]; *(LAS f32x4*)(Vf + kk * 64 + d4) = vq[it]; }
        }
    }
    for (int kk_ = 0; kk_ < 2; ++kk_) { const int i = tid + 512 * kk_; const int r16 = i >> 6, d = i & 63, tt = r16 >> 2, r = r16 & 3;
        qf[r16 * 65 + d] = bf2f(proj[(size_t)(row0 + tt) * NPROJ + 1536 + (kvh * 4 + r) * 64 + d]); }
    __syncthreads();
    { const int r16 = tid & 15, kg = tid >> 4, tt = r16 >> 2;
      for (int j_ = 0; j_ < 5; ++j_) {
          const int kk = kg + 32 * j_; if (kk >= 132) continue;
          float s = 0.f;
#pragma unroll 16
          for (int d = 0; d < 64; ++d) s += qf[r16 * 65 + d] * Kf[kk * 65 + d];
          const bool ok = kk < 128 ? (kk >= tt + 1) : (kk - 128 <= tt);
          sc[r16 * 136 + kk] = ok ? s * 0.125f : -INFINITY;
      } }
    __syncthreads();
#pragma unroll
    for (int rr = 0; rr < 2; ++rr) {
        const int r16 = 2 * wave + rr; const float sink = P->in[17][kvh * 4 + (r16 & 3)];
        float v[3]; float mx = sink;
#pragma unroll
        for (int j = 0; j < 3; ++j) { const int kk = lane + 64 * j; v[j] = kk < 132 ? sc[r16 * 136 + kk] : -INFINITY; mx = fmaxf(mx, v[j]); }
        mx = wave_max(mx); float sum = 0.f;
#pragma unroll
        for (int j = 0; j < 3; ++j) { v[j] = __expf(v[j] - mx); sum += v[j]; }
        const float inv = 1.f / (wave_sum(sum) + __expf(sink - mx));
#pragma unroll
        for (int j = 0; j < 3; ++j) { const int kk = lane + 64 * j; if (kk < 132) sc[r16 * 136 + kk] = v[j] * inv; }
    }
    __syncthreads();
    { const int r16 = tid >> 5, d2 = (tid & 31) * 2, tt = r16 >> 2, r = r16 & 3; float o0 = 0.f, o1 = 0.f;
      for (int kk = 0; kk < 132; ++kk) { const float p = sc[r16 * 136 + kk]; o0 += p * Vf[kk * 64 + d2]; o1 += p * Vf[kk * 64 + d2 + 1]; }
      *(unsigned*)((bf16_t*)(P->ws + WS_MIXIN) + (size_t)(row0 + tt) * 1024 + 512 + (kvh * 4 + r) * 64 + d2) = pk2(o0, o1); }
    __syncthreads();
}

__device__ __forceinline__ void xattn_prompt(CP P, LAS unsigned char* lds, int unit, int tid, int wave, int lane) {
    const int b = unit >> 6, h = (unit >> 4) & 3, qb = unit & 15;
    const int fr = lane & 15, fq = lane >> 4;
    LAS bf16_t* KV = (LAS bf16_t*)lds;
    LAS bf16_t* Ps = (LAS bf16_t*)(lds + 256 * PK * 2) + wave * 16 * PV;
    const bf16_t* q2 = (const bf16_t*)(P->ws + WS_Q2); const bf16_t* mk = (const bf16_t*)(P->ws + WS_MK); const bf16_t* mvt = (const bf16_t*)(P->ws + WS_MVT);
    const int row = b * SEQ + qb * 128 + 16 * wave + fr;
    f32x4 s[16];
#pragma unroll
    for (int n = 0; n < 16; ++n) s[n] = (f32x4){0.f, 0.f, 0.f, 0.f};
    u32x4 tmp[4];
#define XLOADK(dcv) { _Pragma("unroll") for (int it = 0; it < 4; ++it) { const int ci = tid + 512 * it, m = ci >> 3, c8 = ci & 7; tmp[it] = *(const u32x4*)(mk + (size_t)(b * 256 + m) * 1024 + h * 256 + (dcv) * 64 + c8 * 8); } }
#define XLOADV(dcv) { _Pragma("unroll") for (int it = 0; it < 4; ++it) { const int ci = tid + 512 * it, d = ci >> 5, c = ci & 31; tmp[it] = *(const u32x4*)(mvt + (size_t)(h * 256 + (dcv) * 64 + d) * 2048 + b * 256 + c * 8); } }
    XLOADK(0)
    for (int dc = 0; dc < 4; ++dc) {
        bf16x8 qf[2];
#pragma unroll
        for (int ks = 0; ks < 2; ++ks) qf[ks] = *(const bf16x8*)(q2 + (size_t)row * 1024 + h * 256 + dc * 64 + ks * 32 + 8 * fq);
        __syncthreads();
#pragma unroll
        for (int it = 0; it < 4; ++it) { const int ci = tid + 512 * it, m = ci >> 3, c8 = ci & 7; *(LAS u32x4*)(KV + m * PK + c8 * 8) = tmp[it]; }
        if (dc < 3) XLOADK(dc + 1) else XLOADV(0)
        __syncthreads();
        mma_areg<16, 2, 0, 2>(s, qf, KV, PK, lane);
    }
    float mx = -INFINITY;
#pragma unroll
    for (int n = 0; n < 16; ++n)
#pragma unroll
        for (int e = 0; e < 4; ++e) { s[n][e] *= 0.0625f; mx = fmaxf(mx, s[n][e]); }
    mx = fmaxf(mx, __shfl_xor(mx, 16)); mx = fmaxf(mx, __shfl_xor(mx, 32));
    float sum = 0.f;
#pragma unroll
    for (int n = 0; n < 16; ++n)
#pragma unroll
        for (int e = 0; e < 4; ++e) { const float ev = __expf(s[n][e] - mx); s[n][e] = ev; sum += ev; }
    sum += __shfl_xor(sum, 16); sum += __shfl_xor(sum, 32);
    const float inv = 1.f / sum;
    bf16x8 pf[8];
#pragma unroll
    for (int ks = 0; ks < 8; ++ks) { u32x4 w; w.x = pk2(s[2 * ks][0] * inv, s[2 * ks][1] * inv); w.y = pk2(s[2 * ks][2] * inv, s[2 * ks][3] * inv);
        w.z = pk2(s[2 * ks + 1][0] * inv, s[2 * ks + 1][1] * inv); w.w = pk2(s[2 * ks + 1][2] * inv, s[2 * ks + 1][3] * inv); pf[ks] = __builtin_bit_cast(bf16x8, w); }
    for (int dc = 0; dc < 4; ++dc) {
        __syncthreads();
#pragma unroll
        for (int it = 0; it < 4; ++it) { const int ci = tid + 512 * it, d = ci >> 5, c = ci & 31; *(LAS u32x4*)(KV + d * PV + c * 8) = tmp[it]; }
        if (dc < 3) XLOADV(dc + 1)
        __syncthreads();
        f32x4 o[4];
#pragma unroll
        for (int n = 0; n < 4; ++n) o[n] = (f32x4){0.f, 0.f, 0.f, 0.f};
#pragma unroll
        for (int ks = 0; ks < 8; ++ks) {
#pragma unroll
            for (int n = 0; n < 4; ++n) {
                const LAS bf16_t* vp = KV + (16 * n + fr) * PV + 32 * ks + 4 * fq;
                const u32x2 a0 = *(const LAS u32x2*)vp, a1 = *(const LAS u32x2*)(vp + 16);
                const u32x4 av = (u32x4){a0.x, a0.y, a1.x, a1.y};
                o[n] = __builtin_amdgcn_mfma_f32_16x16x32_bf16(__builtin_bit_cast(bf16x8, av), pf[ks], o[n], 0, 0, 0);
            }
            __builtin_amdgcn_sched_barrier(0);
        }
        bf16_t* op = (bf16_t*)(P->ws + WS_OX) + (size_t)row * 1024 + h * 256 + dc * 64 + 4 * fq;
#pragma unroll
        for (int n = 0; n < 4; ++n) { u32x2 w2; w2.x = pk2(o[n][0], o[n][1]); w2.y = pk2(o[n][2], o[n][3]); *(u32x2*)(op + 16 * n) = w2; }
    }
#undef XLOADK
#undef XLOADV
    __syncthreads();
}

__device__ __forceinline__ void xattn_prompt2(CP P, LAS unsigned char* lds, int unit, int tid, int wave, int lane) {
    const int b = unit >> 5, h = (unit >> 3) & 3, qb = unit & 7;
    const int fr = lane & 15, fq = lane >> 4;
    LAS bf16_t* KV = (LAS bf16_t*)lds;
    const bf16_t* q2 = (const bf16_t*)(P->ws + WS_Q2); const bf16_t* mk = (const bf16_t*)(P->ws + WS_MK); const bf16_t* mvt = (const bf16_t*)(P->ws + WS_MVT);
    const int row = b * SEQ + qb * 256 + 32 * wave + fr;
    f32x4 s[2][16];
#pragma unroll
    for (int mt = 0; mt < 2; ++mt)
#pragma unroll
        for (int n = 0; n < 16; ++n) s[mt][n] = (f32x4){0.f, 0.f, 0.f, 0.f};
    u32x4 tmp[4];
#define XLOADK(dcv) { _Pragma("unroll") for (int it = 0; it < 4; ++it) { const int ci = tid + 512 * it, m = ci >> 3, c8 = ci & 7; tmp[it] = *(const u32x4*)(mk + (size_t)(b * 256 + m) * 1024 + h * 256 + (dcv) * 64 + c8 * 8); } }
#define XLOADV(dcv) { _Pragma("unroll") for (int it = 0; it < 4; ++it) { const int ci = tid + 512 * it, d = ci >> 5, c = ci & 31; tmp[it] = *(const u32x4*)(mvt + (size_t)(h * 256 + (dcv) * 64 + d) * 2048 + b * 256 + c * 8); } }
    XLOADK(0)
    for (int dc = 0; dc < 4; ++dc) {
        bf16x8 qf[2][2];
#pragma unroll
        for (int mt = 0; mt < 2; ++mt)
#pragma unroll
            for (int ks = 0; ks < 2; ++ks) qf[mt][ks] = *(const bf16x8*)(q2 + (size_t)(row + 16 * mt) * 1024 + h * 256 + dc * 64 + ks * 32 + 8 * fq);
        __syncthreads();
#pragma unroll
        for (int it = 0; it < 4; ++it) { const int ci = tid + 512 * it, m = ci >> 3, c8 = ci & 7; *(LAS u32x4*)(KV + m * PK + c8 * 8) = tmp[it]; }
        if (dc < 3) XLOADK(dc + 1)
        __syncthreads();
#pragma unroll
        for (int ks = 0; ks < 2; ++ks) {
#pragma unroll
            for (int n = 0; n < 16; ++n) {
                const bf16x8 bfr = *(const LAS bf16x8*)(KV + (16 * n + fr) * PK + ks * 32 + 8 * fq);
                s[0][n] = __builtin_amdgcn_mfma_f32_16x16x32_bf16(bfr, qf[0][ks], s[0][n], 0, 0, 0);
                s[1][n] = __builtin_amdgcn_mfma_f32_16x16x32_bf16(bfr, qf[1][ks], s[1][n], 0, 0, 0);
                if ((n & 3) == 3) __builtin_amdgcn_sched_barrier(0);
            }
        }
    }
    bf16x8 pf[2][8];
#pragma unroll
    for (int mt = 0; mt < 2; ++mt) {
        float mx = -INFINITY;
#pragma unroll
        for (int n = 0; n < 16; ++n)
#pragma unroll
            for (int e = 0; e < 4; ++e) { s[mt][n][e] *= 0.0625f; mx = fmaxf(mx, s[mt][n][e]); }
        mx = fmaxf(mx, __shfl_xor(mx, 16)); mx = fmaxf(mx, __shfl_xor(mx, 32));
        float sum = 0.f;
#pragma unroll
        for (int n = 0; n < 16; ++n)
#pragma unroll
            for (int e = 0; e < 4; ++e) { const float ev = __expf(s[mt][n][e] - mx); s[mt][n][e] = ev; sum += ev; }
        sum += __shfl_xor(sum, 16); sum += __shfl_xor(sum, 32);
        const float inv = 1.f / sum;
#pragma unroll
        for (int ks = 0; ks < 8; ++ks) { u32x4 w; w.x = pk2(s[mt][2 * ks][0] * inv, s[mt][2 * ks][1] * inv); w.y = pk2(s[mt][2 * ks][2] * inv, s[mt][2 * ks][3] * inv);
            w.z = pk2(s[mt][2 * ks + 1][0] * inv, s[mt][2 * ks + 1][1] * inv); w.w = pk2(s[mt][2 * ks + 1][2] * inv, s[mt][2 * ks + 1][3] * inv); pf[mt][ks] = __builtin_bit_cast(bf16x8, w); }
    }
    XLOADV(0)
    for (int dc = 0; dc < 4; ++dc) {
        __syncthreads();
#pragma unroll
        for (int it = 0; it < 4; ++it) { const int ci = tid + 512 * it, d = ci >> 5, c = ci & 31; *(LAS u32x4*)(KV + d * PV + c * 8) = tmp[it]; }
        if (dc < 3) XLOADV(dc + 1)
        __syncthreads();
        f32x4 o[2][4];
#pragma unroll
        for (int mt = 0; mt < 2; ++mt)
#pragma unroll
            for (int n = 0; n < 4; ++n) o[mt][n] = (f32x4){0.f, 0.f, 0.f, 0.f};
#pragma unroll
        for (int ks = 0; ks < 8; ++ks) {
#pragma unroll
            for (int n = 0; n < 4; ++n) {
                const LAS bf16_t* vp = KV + (16 * n + fr) * PV + 32 * ks + 4 * fq;
                const u32x2 a0 = *(const LAS u32x2*)vp, a1 = *(const LAS u32x2*)(vp + 16);
                const bf16x8 av = __builtin_bit_cast(bf16x8, (u32x4){a0.x, a0.y, a1.x, a1.y});
                o[0][n] = __builtin_amdgcn_mfma_f32_16x16x32_bf16(av, pf[0][ks], o[0][n], 0, 0, 0);
                o[1][n] = __builtin_amdgcn_mfma_f32_16x16x32_bf16(av, pf[1][ks], o[1][n], 0, 0, 0);
            }
            __builtin_amdgcn_sched_barrier(0);
        }
        asm volatile("s_nop 7\n\ts_nop 7\n\ts_nop 7" ::: "memory");
#pragma unroll
        for (int mt = 0; mt < 2; ++mt) {
            bf16_t* op = (bf16_t*)(P->ws + WS_OX) + (size_t)(row + 16 * mt) * 1024 + h * 256 + dc * 64 + 4 * fq;
#pragma unroll
            for (int n = 0; n < 4; ++n) { u32x2 w2; w2.x = pk2(o[mt][n][0], o[mt][n][1]); w2.y = pk2(o[mt][n][2], o[mt][n][3]); *(u32x2*)(op + 16 * n) = w2; }
        }
    }
#undef XLOADK
#undef XLOADV
    __syncthreads();
}

__device__ __forceinline__ void xattn_sample(CP P, LAS unsigned char* lds, int unit, int tid, int wave, int lane) {
    const int b = unit >> 2, h = unit & 3, row0 = TP + b * 4;
    LAS float* sc = (LAS float*)lds;
    LAS float* red = sc + 1024;
    const bf16_t* q2 = (const bf16_t*)(P->ws + WS_Q2);
    const float* kb = P->in[6] + ((size_t)(b * 256) * 4 + h) * 256;
    const float* vb = P->in[7] + ((size_t)(b * 256) * 4 + h) * 256 + 4 * lane;
    {
        const int fr = lane & 15, fq = lane >> 4;
        bf16x8 qf[8];
#pragma unroll
        for (int ks = 0; ks < 8; ++ks) { u32x4 z = (u32x4){0u, 0u, 0u, 0u}; if (fr < 4) z = *(const u32x4*)(q2 + (size_t)(row0 + fr) * 1024 + h * 256 + ks * 32 + 8 * fq); qf[ks] = __builtin_bit_cast(bf16x8, z); }
#pragma unroll
        for (int mt = 0; mt < 2; ++mt) {
            const int m0 = 32 * wave + 16 * mt; const float* kr = kb + (size_t)(m0 + fr) * 1024 + 8 * fq;
            f32x4 kv[16];
#pragma unroll
            for (int ks = 0; ks < 8; ++ks) { kv[2 * ks] = __builtin_nontemporal_load((const f32x4*)(kr + ks * 32)); kv[2 * ks + 1] = __builtin_nontemporal_load((const f32x4*)(kr + ks * 32 + 4)); }
            f32x4 acc = (f32x4){0.f, 0.f, 0.f, 0.f};
#pragma unroll
            for (int ks = 0; ks < 8; ++ks) { u32x4 a; a.x = pk2(kv[2 * ks][0], kv[2 * ks][1]); a.y = pk2(kv[2 * ks][2], kv[2 * ks][3]); a.z = pk2(kv[2 * ks + 1][0], kv[2 * ks + 1][1]); a.w = pk2(kv[2 * ks + 1][2], kv[2 * ks + 1][3]);
                acc = __builtin_amdgcn_mfma_f32_16x16x32_bf16(__builtin_bit_cast(bf16x8, a), qf[ks], acc, 0, 0, 0); }
            if (fr < 4) *(LAS f32x4*)(sc + fr * 256 + m0 + 4 * fq) = acc * 0.0625f;
        }
    }
    __syncthreads();
    if (wave < 4) {
        float v[4]; float mx = -INFINITY;
#pragma unroll
        for (int j = 0; j < 4; ++j) { v[j] = sc[wave * 256 + lane + 64 * j]; mx = fmaxf(mx, v[j]); }
        mx = wave_max(mx); float sum = 0.f;
#pragma unroll
        for (int j = 0; j < 4; ++j) { v[j] = __expf(v[j] - mx); sum += v[j]; }
        const float inv = 1.f / wave_sum(sum);
#pragma unroll
        for (int j = 0; j < 4; ++j) sc[wave * 256 + lane + 64 * j] = v[j] * inv;
    }
    __syncthreads();
    f32x4 acc[4];
#pragma unroll
    for (int tt = 0; tt < 4; ++tt) acc[tt] = (f32x4){0.f, 0.f, 0.f, 0.f};
#pragma unroll 8
    for (int i = 0; i < 32; ++i) {
        const int m = 32 * wave + i; const f32x4 v = __builtin_nontemporal_load((const f32x4*)(vb + (size_t)m * 1024));
#pragma unroll
        for (int tt = 0; tt < 4; ++tt) acc[tt] += v * sc[tt * 256 + m];
    }
#pragma unroll
    for (int tt = 0; tt < 4; ++tt) *(LAS f32x4*)(red + (wave * 4 + tt) * 256 + 4 * lane) = acc[tt];
    __syncthreads();
    for (int kk_ = 0; kk_ < 2; ++kk_) { const int i = tid + 512 * kk_; float s = 0.f;
#pragma unroll
        for (int w = 0; w < 8; ++w) s += red[w * 1024 + i];
        const int tt = i >> 8, d = i & 255; ((bf16_t*)(P->ws + WS_OX))[(size_t)(row0 + tt) * 1024 + h * 256 + d] = f2bf(s); }
    __syncthreads();
}

__device__ __forceinline__ void skinny_gemm(const bf16_t* A, const bf16_t* Wt, bf16_t* C, int K, int bid, int G, int wave, int lane) {
    const int fr = lane & 15, fq = lane >> 4;
    for (int t = bid; t < 256; t += G) {
        const int r0 = TP + 32 * (t & 15) + 16 * (wave & 1), c0 = 64 * (t >> 4) + 16 * (wave >> 1);
        const bf16_t* ap = A + (size_t)(r0 + fr) * K + 8 * fq; const bf16_t* bp = Wt + (size_t)(c0 + fr) * K + 8 * fq;
        f32x4 acc = (f32x4){0.f, 0.f, 0.f, 0.f};
        for (int kb = 0; kb < K; kb += 512) {
            bf16x8 av[16], bv[16];
#pragma unroll
            for (int j = 0; j < 16; ++j) { av[j] = *(const bf16x8*)(ap + kb + 32 * j); bv[j] = *(const bf16x8*)(bp + kb + 32 * j); }
#pragma unroll
            for (int j = 0; j < 16; ++j) acc = __builtin_amdgcn_mfma_f32_16x16x32_bf16(bv[j], av[j], acc, 0, 0, 0);
        }
        __builtin_amdgcn_sched_barrier(0);
        asm volatile("s_nop 7\n\ts_nop 7\n\ts_nop 7" ::: "memory");
        u32x2 w; w.x = pk2(acc[0], acc[1]); w.y = pk2(acc[2], acc[3]);
        *(u32x2*)(C + (size_t)(r0 + fr) * 1024 + c0 + 4 * fq) = w;
    }
}

__device__ __forceinline__ void copy_caches(CP P, int part, int t0_, int NT_) {
    unsigned char* ws = P->ws; const bf16_t* proj = (const bf16_t*)(ws + WS_PROJ);
    if (part == 0) {
        for (int base_ = 0; base_ < 2048 * 1024 / 4; base_ += 4 * NT_) {
            u32x2 a[4], c[4];
#pragma unroll
            for (int k = 0; k < 4; ++k) { const int i = base_ + k * NT_ + t0_; a[k] = (u32x2){0u, 0u}; c[k] = a[k]; if (i < 2048 * 1024 / 4) { a[k] = ((const u32x2*)(ws + WS_MK))[i]; c[k] = ((const u32x2*)(ws + WS_MV))[i]; } }
#pragma unroll
            for (int k = 0; k < 4; ++k) { const int i = base_ + k * NT_ + t0_; if (i < 2048 * 1024 / 4) {
                ((f32x4*)(P->out + O_PMK))[i] = (f32x4){__uint_as_float(a[k].x << 16), __uint_as_float(a[k].x & 0xffff0000u), __uint_as_float(a[k].y << 16), __uint_as_float(a[k].y & 0xffff0000u)};
                ((f32x4*)(P->out + O_PMV))[i] = (f32x4){__uint_as_float(c[k].x << 16), __uint_as_float(c[k].x & 0xffff0000u), __uint_as_float(c[k].y << 16), __uint_as_float(c[k].y & 0xffff0000u)}; } }
        }
        for (int base_ = 0; base_ < 8 * 128 * 128; base_ += NT_) { const int i = base_ + t0_; if (i >= 8 * 128 * 128) continue; const int b = i >> 14, r = (i >> 7) & 127, cidx = i & 127;
            const bf16_t* pr = proj + (size_t)(b * SEQ + 1920 + r) * NPROJ + cidx; P->out[O_PWK + i] = bf2f(pr[2048]); P->out[O_PWV + i] = bf2f(pr[2176]); }
        for (int base_ = 0; base_ < 128 * 4 * 128; base_ += NT_) { const int j = base_ + t0_; if (j >= 128 * 4 * 128) continue; const int b = j >> 9, t = (j >> 7) & 3, cidx = j & 127;
            const bf16_t* pr = proj + (size_t)(TP + b * 4 + t) * NPROJ + cidx; const size_t o = (size_t)(b * 128 + 124 + t) * 128 + cidx; P->out[O_SWK + o] = bf2f(pr[2048]); P->out[O_SWV + o] = bf2f(pr[2176]); }
    } else {
        for (int base_ = 0; base_ < 128 * 124 * 32; base_ += 4 * NT_) {
            f32x4 kv[4], vv[4];
#pragma unroll
            for (int k = 0; k < 4; ++k) { const int j = base_ + k * NT_ + t0_; kv[k] = (f32x4){0.f, 0.f, 0.f, 0.f}; vv[k] = kv[k];
                if (j < 128 * 124 * 32) { const int b = j / (124 * 32), rem = j - b * (124 * 32); const size_t i = (size_t)b * 16384 + 4 * rem; kv[k] = __builtin_nontemporal_load((const f32x4*)(P->in[4] + i + 512)); vv[k] = __builtin_nontemporal_load((const f32x4*)(P->in[5] + i + 512)); } }
#pragma unroll
            for (int k = 0; k < 4; ++k) { const int j = base_ + k * NT_ + t0_;
                if (j < 128 * 124 * 32) { const int b = j / (124 * 32), rem = j - b * (124 * 32); const size_t i = (size_t)b * 16384 + 4 * rem; *(f32x4*)(P->out + O_SWK + i) = kv[k]; *(f32x4*)(P->out + O_SWV + i) = vv[k]; } }
        }
    }
}

#define XB_TMO      128
#define XB_XCNT(j)  (256  + 64 * (j))
#define XB_XSUB(j)  (1280 + 64 * (j))
#define XB_XGEN(j)  (2304 + 64 * (j))
#define XB_TOP      3328
#define XB_TOPGEN   3392
#define XCD_BAR_WORDS 3456
#define XB_SPIN_CAP (1u << 18)

__device__ __forceinline__ unsigned xb_ld(unsigned* p)              { return __hip_atomic_load(p, __ATOMIC_RELAXED, __HIP_MEMORY_SCOPE_AGENT); }
__device__ __forceinline__ unsigned xb_add(unsigned* p, unsigned v) { return __hip_atomic_fetch_add(p, v, __ATOMIC_RELAXED, __HIP_MEMORY_SCOPE_AGENT); }
__device__ __forceinline__ unsigned xb_xcc_id() { return (unsigned)__builtin_amdgcn_s_getreg((3 << 11) | 20) & 0xFu; }
#define XB_SPIN(cond, bar) do { unsigned _sp = 0; while (cond) { __builtin_amdgcn_s_sleep(1); \
    if ((++_sp & 255u) == 0u) { if (xb_ld(&(bar)[XB_TMO])) break; if (_sp > XB_SPIN_CAP) { atomicAdd(&(bar)[XB_TMO], 1u); break; } } } } while (0)

struct XcdBarrier {
    unsigned* bar; unsigned x;
    volatile LAS unsigned* st;
};

__device__ __forceinline__ XcdBarrier xcd_barrier_post(unsigned* bar, volatile LAS unsigned* st) {
    XcdBarrier b; b.bar = bar; b.x = xb_xcc_id(); b.st = st;
    if (threadIdx.x == 0) (void)xb_add(&bar[XB_XCNT(b.x)], 1u);
    return b;
}
__device__ __forceinline__ void xcd_barrier_complete(unsigned* bar, unsigned x, unsigned& nloc, unsigned& nx) {
    const unsigned G = gridDim.x * gridDim.y * gridDim.z;
    unsigned sum, cnt, mine, sp = 0u;
    for (;;) {
        sum = 0u; cnt = 0u; mine = 0u;
#pragma unroll
        for (unsigned j = 0; j < 16; ++j) { const unsigned c = xb_ld(&bar[XB_XCNT(j)]); sum += c; cnt += (c > 0u) ? 1u : 0u; mine = (j == x) ? c : mine; }
        if (sum == G) break;
        __builtin_amdgcn_s_sleep(1);
        if ((++sp & 255u) == 0u) { if (xb_ld(&bar[XB_TMO])) break; if (sp > XB_SPIN_CAP) { atomicAdd(&bar[XB_TMO], 1u); break; } }
    }
    nloc = mine > 0u ? mine : 1u; nx = cnt > 0u ? cnt : 1u;
}

__device__ __forceinline__ void xcd_barrier(const XcdBarrier& b) {
    asm volatile("s_waitcnt vmcnt(0)" ::: "memory");
    __syncthreads();
    if (threadIdx.x == 0) {
        unsigned* bar = b.bar;
        __builtin_amdgcn_s_waitcnt(0);
        unsigned nloc = b.st[0], nx = b.st[1];
        if (nloc == 0u) { xcd_barrier_complete(bar, b.x, nloc, nx); b.st[0] = nloc; b.st[1] = nx; }
        const unsigned old = xb_add(&bar[XB_XSUB(b.x)], 1u);
        const unsigned gen = old / nloc;
        if (old + 1u == (gen + 1u) * nloc) {
            __builtin_amdgcn_fence(__ATOMIC_RELEASE, "agent");
            asm volatile("s_waitcnt vmcnt(0)" ::: "memory");
            const unsigned og = xb_add(&bar[XB_TOP], 1u);
            const unsigned tg = og / nx;
            if (og + 1u == (tg + 1u) * nx) xb_add(&bar[XB_TOPGEN], 1u);
            else XB_SPIN(xb_ld(&bar[XB_TOPGEN]) == tg, bar);
            __builtin_amdgcn_fence(__ATOMIC_ACQUIRE, "agent");
            xb_add(&bar[XB_XGEN(b.x)], 1u);
            asm volatile("s_waitcnt vmcnt(0)" ::: "memory");
        } else {
            XB_SPIN(xb_ld(&bar[XB_XGEN(b.x)]) == gen, bar);
            __builtin_amdgcn_fence(__ATOMIC_ACQUIRE, "agent");
            asm volatile("s_waitcnt vmcnt(0)" ::: "memory");
        }
    }
    __syncthreads();
}

constexpr int NPHASE = 13;
#ifndef SKN
#define SKN 2
#endif
#ifndef MK_MULTI
#define MK_MULTI 0
#endif
#ifndef TSW
#define TSW 0
#endif
__global__ void __launch_bounds__(512, 2) mk_fwd(Params P_) {
    CP P = (CP)__builtin_amdgcn_kernarg_segment_ptr(); asm volatile("" : "+s"(P));
    extern __shared__ __attribute__((aligned(16))) unsigned char lds_raw[];
    LAS unsigned char* lds = (LAS unsigned char*)lds_raw;
    const int G = gridDim.x, bid = blockIdx.x;
    volatile LAS unsigned* bar_st = (volatile LAS unsigned*)(lds + LDS_BYTES - 16);
    if (threadIdx.x < 4) bar_st[threadIdx.x] = 0u;
    __syncthreads();
    XcdBarrier xbar = xcd_barrier_post((unsigned*)P_.ws, bar_st);
#define TLW CP P = (CP)__builtin_amdgcn_kernarg_segment_ptr(); asm volatile("" : "+s"(P)); unsigned char* ws = P->ws; (void)ws; int tid = threadIdx.x; asm volatile("" : "+v"(tid)); const int lane = tid & 63, wave = __builtin_amdgcn_readfirstlane(tid >> 6); const int gw = bid * 8 + wave, NGW = G * 8; (void)gw; (void)NGW; (void)lane;
    unsigned char* ws = P->ws;
    const int lo = P->ph_lo, hi = P->ph_hi;
#ifndef PHMASK
#define PHMASK 0xffff
#endif
#define IN(k) (((PHMASK >> (k)) & 1) && lo <= (k) && (k) < hi)
#ifndef REP_PHASE
#define REP_PHASE -1
#endif
#define NREP(k) ((k) == REP_PHASE ? 2 : 1)
#define SEAM(k) do { if (IN(k) && IN((k) + 1)) xcd_barrier(xbar); } while (0)
    bf16_t* R = (bf16_t*)(ws + WS_R);
#ifdef DUMP_BUF
    if (lo == 100) { TLW const bf16_t* src = (const bf16_t*)(ws + DUMP_BUF);
        for (size_t i = (size_t)bid * 512 + tid; i < (size_t)TT * 1024; i += (size_t)G * 512) { float v = bf2f(src[i]); if (!(fabsf(v) < 1e30f)) v = 12345.f; P->out[i] = v; } }
#endif

    if (IN(0)) for (int rep = 0; rep < NREP(0); ++rep) { TLW phase_prologue(P, lds, gw, NGW, wave, lane); }
    SEAM(0);
    if (IN(1)) {
        pg8::Gemm g{R, R, 0, 0, 1024}; Order S{754, G, bid, 0, 0};
        EpiP1 E{(bf16_t*)(ws + WS_PROJ), (bf16_t*)(ws + WS_MK), (bf16_t*)(ws + WS_MV), (bf16_t*)(ws + WS_MVT), (bf16_t*)(ws + WS_KVT)};
        pg8::gemm_phase<EpiP1, Order, true, true>(lds, g, S, E);
    }
    SEAM(1);
    if (IN(2)) for (int rep = 0; rep < NREP(2); ++rep) {
        TLW
        if (!(TSW & 4)) for (int u = bid; u < 256; u += G) ssd_pass_a(P, lds, u, tid, wave, lane);
        if (!(TSW & 8)) for (int u = bid; u < 256; u += G) swa_prompt(P, lds, u, tid, wave, lane);
        if (!(TSW & 16)) for (int u = bid; u < 256; u += G) ssd_sample(P, lds, u, tid, wave, lane);
        if (!(TSW & 32)) for (int u = bid; u < 256; u += G) swa_sample(P, lds, u, tid, wave, lane);
    }
    SEAM(2);
    if (IN(3)) { { TLW ssd_state_scan(P, bid, G, tid); } xcd_barrier(xbar); }
    if (IN(3)) for (int rep = 0; rep < NREP(3); ++rep) { TLW for (int u = bid; u < 256; u += G) ssd_pass_b(P, lds, u, tid, wave, lane); }
    SEAM(3);
    if (IN(4)) for (int rep = 0; rep < NREP(4); ++rep) {
        pg8::Gemm g{(const bf16_t*)(ws + WS_MIXIN), (const bf16_t*)(ws + WS_WOUT), TT, 1024, 1024}; Order S{272, G, bid, 3, 16};
        EpiBf E{(bf16_t*)(ws + WS_CB16), 1024, 1.f, (float*)(ws + WS_SPLIT)};
        pg8::gemm_phase<EpiBf, Order, true, true>(lds, g, S, E);
        if (bid + G >= 272 && rep == 0) { TLW const int nb_ = G - (272 - G > 0 ? 272 - G : 0); tr_items(P, lds, 1, (bid - (G - nb_)) * 8 + wave, nb_ * 8, wave, lane); }
        if ((SKN >> 0) & 1) { TLW skinny_gemm((const bf16_t*)(ws + WS_MIXIN), (const bf16_t*)(ws + WS_WOUT), (bf16_t*)(ws + WS_CB16), 1024, bid, G, wave, lane); }
    }
    SEAM(4);
#ifdef SYNC_EXTRA
    for (int r_ = 0; r_ < SYNC_EXTRA; ++r_) cg::this_grid().sync();
#endif
    if (IN(5)) for (int rep = 0; rep < NREP(5); ++rep) { TLW phase_resid(P, 0, gw, NGW, lane); }
    SEAM(5);
    if (IN(6)) {
        pg8::Gemm g{(const bf16_t*)(ws + WS_H0), (const bf16_t*)(ws + WS_WXQ), TT, 1024, 1024}; Order S{256, G, bid, 1, 4};
        EpiBf E{(bf16_t*)(ws + WS_Q2), 1024, 1.f, nullptr};
        pg8::gemm_phase<EpiBf, Order, true, true>(lds, g, S, E);
        if ((SKN >> 1) & 1) { TLW skinny_gemm((const bf16_t*)(ws + WS_H0), (const bf16_t*)(ws + WS_WXQ), (bf16_t*)(ws + WS_Q2), 1024, bid, G, wave, lane); }
    }
    SEAM(6);
    if (IN(7)) for (int rep = 0; rep < NREP(7); ++rep) {
        TLW
        if ((bid >> 3) & 1) { for (int u = bid; u < 256; u += G) xattn_prompt2(P, lds, u, tid, wave, lane); }
        for (int u = bid; u < 512; u += G) xattn_sample(P, lds, u, tid, wave, lane);
        if (!((bid >> 3) & 1)) { for (int u = bid; u < 256; u += G) xattn_prompt2(P, lds, u, tid, wave, lane); }
    }
    SEAM(7);
    if (IN(8)) {
        pg8::Gemm g{(const bf16_t*)(ws + WS_OX), (const bf16_t*)(ws + WS_WXO), TT, 1024, 1024}; Order S{272, G, bid, 3, 16};
        EpiBf E{(bf16_t*)(ws + WS_CB16), 1024, 1.f, (float*)(ws + WS_SPLIT) + 8 * 512 * 1024};
        pg8::gemm_phase<EpiBf, Order, true, true>(lds, g, S, E);
        { TLW const int first_ = G > 16 ? 16 : 0; if (bid >= first_) copy_caches(P, 0, (bid - first_) * 512 + tid, (G - first_) * 512); }
        if ((SKN >> 2) & 1) { TLW skinny_gemm((const bf16_t*)(ws + WS_OX), (const bf16_t*)(ws + WS_WXO), (bf16_t*)(ws + WS_CB16), 1024, bid, G, wave, lane); }
    }
    SEAM(8);
    if (IN(9)) { TLW phase_resid(P, 1, gw, NGW, lane); }
    SEAM(9);
    if (IN(10)) for (int rep = 0; rep < NREP(10); ++rep) {
        pg8::Gemm g{(const bf16_t*)(ws + WS_H0), (const bf16_t*)(ws + WS_WGU), TT, 2 * DFF, 1024}; Order S{66 * 22, G, bid, 1, 22};
        EpiGU E{(bf16_t*)(ws + WS_ACT)};
        pg8::gemm_phase<EpiGU, Order, true, true>(lds, g, S, E);
    }
    SEAM(10);
    if (IN(11)) for (int rep = 0; rep < NREP(11); ++rep) {
        pg8::Gemm g{(const bf16_t*)(ws + WS_ACT), (const bf16_t*)(ws + WS_WDN), TT, 1024, DFF}; Order S{288, G, bid, 2, 44};
        EpiBf E{(bf16_t*)(ws + WS_CB16), 1024, 1.f, (float*)(ws + WS_SPLIT) + 12 * 512 * 1024};
        pg8::gemm_phase<EpiBf, Order, true, true>(lds, g, S, E);
        if (rep == 0) { TLW const int first_ = G > 32 ? 32 : 0; if (bid >= first_) copy_caches(P, 1, (bid - first_) * 512 + tid, (G - first_) * 512); }
        if ((SKN >> 3) & 1) { TLW skinny_gemm((const bf16_t*)(ws + WS_ACT), (const bf16_t*)(ws + WS_WDN), (bf16_t*)(ws + WS_CB16), DFF, bid, G, wave, lane); }
    }
    SEAM(11);
    if (IN(12)) { TLW phase_resid(P, 2, gw, NGW, lane); }
#undef IN
#undef SEAM
}

#ifndef MK_MULTI
#define MK_MULTI 0
#endif
#ifndef NPH_RUN
#define NPH_RUN 13
#endif
extern "C" void kernel_launch(void* const* d_in, const int* in_sizes, int n_in, void* d_out, int out_size, void* d_ws, size_t ws_size, hipStream_t stream) {
    static int grid = 0;
    if (grid == 0) {
        if (n_in != 32 || ws_size < WS_END) { fprintf(stderr, "kernel_launch: n_in %d ws %zu (need %zu)\n", n_in, ws_size, (size_t)WS_END); grid = -1; return; }
        int dev = 0, cus = 0, per_cu = 0;
        hipGetDevice(&dev); hipDeviceGetAttribute(&cus, hipDeviceAttributeMultiprocessorCount, dev);
        hipFuncSetAttribute((const void*)mk_fwd, hipFuncAttributeMaxDynamicSharedMemorySize, LDS_BYTES);
        hipOccupancyMaxActiveBlocksPerMultiprocessor(&per_cu, (const void*)mk_fwd, 512, LDS_BYTES);
        if (per_cu < 1) { fprintf(stderr, "kernel_launch: occupancy query says %d blocks per CU\n", per_cu); per_cu = 1; }
        grid = cus;
        (void)hipGetLastError();
    }
    if (grid < 0) return;
    (void)hipMemsetAsync(d_ws, 0, 16384, stream);
    Params p{};
    for (int i = 0; i < 32; ++i) p.in[i] = (const float*)d_in[i];
    p.out = (float*)d_out; p.ws = (unsigned char*)d_ws;
#if MK_MULTI
    for (int ph = 0; ph < NPH_RUN; ++ph) { p.ph_lo = ph; p.ph_hi = ph + 1; hipLaunchKernelGGL(mk_fwd, dim3(grid), dim3(512), LDS_BYTES, stream, p); }
#ifdef DUMP_BUF
    p.ph_lo = 100; p.ph_hi = 100; hipLaunchKernelGGL(mk_fwd, dim3(grid), dim3(512), LDS_BYTES, stream, p);
#endif
#else
    p.ph_lo = 0; p.ph_hi = NPHASE;
    void* args[] = {&p};
    hipError_t e = hipLaunchCooperativeKernel((const void*)mk_fwd, dim3(grid), dim3(512), args, LDS_BYTES, stream);
    if (e != hipSuccess) fprintf(stderr, "cooperative launch failed: %s (grid %d)\n", hipGetErrorString(e), grid);
#endif
}
```

```cpp
#include <hip/hip_runtime.h>
#include <hip/hip_cooperative_groups.h>
#include <cstdio>
#include <cstdint>
namespace cg = cooperative_groups;
namespace pg8 {
#define PG8_LAS __attribute__((address_space(3)))
typedef unsigned short bf16_t;
typedef short bf16x8 __attribute__((ext_vector_type(8)));
typedef float f32x4 __attribute__((ext_vector_type(4)));
typedef unsigned u32x4 __attribute__((ext_vector_type(4)));
constexpr int BM = 256, BK = 64, HALF = 128, HTB = HALF * BK * 2  , STAGE_BYTES = 8 * HTB, NXCD = 8, WGM = 8;

__host__ __device__ __forceinline__ int lds_byte(int r, int c) { const int st = (r >> 4) * 2 + (c >> 5), rr = r & 15, cc = c & 31, ob = rr * 64 + cc * 2; return st * 1024 + (ob ^ (((ob >> 9) & 1) << 5)); }
__host__ __device__ __forceinline__ void stage_rc(int b, int& R, int& C) { const int st = b / 1024, sb = b % 1024, swz = sb ^ (((sb >> 9) & 1) << 5); R = (st >> 1) * 16 + swz / 64; C = (st & 1) * 32 + (swz % 64) / 2; }
__host__ __device__ __forceinline__ int perm32(int rho) { const int n = rho >> 4, i = rho & 15; return 8 * (i >> 2) + 4 * n + (i & 3); }

struct Unit { int pm, pn, kofs, nt, q; };
struct Gemm { const bf16_t* A; const bf16_t* Bt; int M, N, K; };

struct StaticOrder {
    int nM, nN, nwg, G, c;
    __host__ __device__ void init(int M, int N, int G_, int c_) { nM = M / BM; nN = N / BM; nwg = nM * nN; G = G_; c = c_; }
    __host__ __device__ bool next(int i, Unit& u) const {
        const long L = (long)i * G + c; if (L >= nwg) return false;
        int wgid = (int)L; { const int q = nwg / NXCD, r = nwg % NXCD, xcd = wgid % NXCD, off = wgid / NXCD; wgid = (xcd < r ? xcd * (q + 1) : r * (q + 1) + (xcd - r) * q) + off; }
        const int nig = WGM * nN, gid = wgid / nig, fm = gid * WGM, gsz = (nM - fm) < WGM ? (nM - fm) : WGM;
        u.pm = fm + ((wgid % nig) % gsz); u.pn = (wgid % nig) / gsz; return true;
    }
    __device__ __forceinline__ void a_ready(const Unit&) const {}
    __device__ __forceinline__ void done(const Unit&) const {}
};

__device__ __forceinline__ unsigned cvt_pk_bf16(float lo, float hi) { unsigned r; asm volatile("v_cvt_pk_bf16_f32 %0, %1, %2" : "=v"(r) : "v"(lo), "v"(hi)); return r; }
typedef float f32x2 __attribute__((ext_vector_type(2)));
template <class Epi, class Sched, bool ALIGN_EPI = false, bool SP2 = false>
__device__ __forceinline__ void gemm_phase(PG8_LAS unsigned char* lds, const Gemm g, const Sched& S, const Epi& E) {
    int tid_ = threadIdx.x; asm volatile("" : "+v"(tid_));
    const int tid = tid_, wid = __builtin_amdgcn_readfirstlane(tid >> 6), lane = tid & 63, wr = wid >> 2, wc = wid & 3, fr = lane & 15, fq = lane >> 4;
    const int K = g.K; int nt = K / BK;
    unsigned voffA[2], voffB[2];
#pragma unroll
    for (int i = 0; i < 2; ++i) { int R, C; stage_rc(tid * 16 + i * 8192, R, C); const int Rb = Epi::PERM ? ((R & ~31) + perm32(R & 31)) : R;
        voffA[i] = (unsigned)(R * K + C) * 2u; voffB[i] = (unsigned)(Rb * K + C) * 2u; }
    const size_t kstep = (size_t)(BK * 2);
    const size_t hstep = (size_t)HALF * K * 2;
    const size_t tstep = 2 * hstep;
    const unsigned ldsw = (unsigned)wid * 1024u;
    const int aoff = lds_byte(wr * 64 + fr, fq * 8), boff = lds_byte(wc * 32 + fr, fq * 8);
#define PG8_SA(b, h) (((b) * 2 + (h)) * HTB)
#define PG8_SB(b, h) ((4 + (b) * 2 + (h)) * HTB)
#define PG8_STAGE(bufoff, gbase, voff) do { _Pragma("unroll") for (int _i = 0; _i < 2; ++_i) \
        __builtin_amdgcn_global_load_lds((const unsigned*)((const char*)(gbase) + (voff)[_i]), (PG8_LAS unsigned*)(lds + (bufoff) + ldsw + _i * 8192), 16, 0, 0); } while (0)
#define PG8_LDA(dst, b, h) do { _Pragma("unroll") for (int m = 0; m < 4; ++m) _Pragma("unroll") for (int k = 0; k < 2; ++k) dst[m][k] = *(const PG8_LAS bf16x8*)(lds + PG8_SA(b, h) + aoff + m * 2048 + k * 1024); } while (0)
#define PG8_LDB(dst, b, h) do { _Pragma("unroll") for (int n = 0; n < 2; ++n) _Pragma("unroll") for (int k = 0; k < 2; ++k) dst[n][k] = *(const PG8_LAS bf16x8*)(lds + PG8_SB(b, h) + boff + n * 2048 + k * 1024); } while (0)
#define PG8_MMA(ai, bj, At, Bt) do { __builtin_amdgcn_s_setprio(1); _Pragma("unroll") for (int m = 0; m < 4; ++m) _Pragma("unroll") for (int n = 0; n < 2; ++n) _Pragma("unroll") for (int k = 0; k < 2; ++k) \
        acc[ai][bj][m][n] = __builtin_amdgcn_mfma_f32_16x16x32_bf16(Bt[n][k], At[m][k], acc[ai][bj][m][n], 0, 0, 0); __builtin_amdgcn_s_setprio(0); } while (0)
#define PG8_WAIT_V(n) asm volatile("s_waitcnt vmcnt(" #n ")" ::: "memory")
#define PG8_WAIT_L(n) asm volatile("s_waitcnt lgkmcnt(" #n ")" ::: "memory")
#define PG8_BAR __builtin_amdgcn_s_barrier()
#define PG8_SCHED __builtin_amdgcn_sched_barrier(0)
    Unit cur, nxt; int ui = 0;
    if (!S.next(0, cur)) return;
    f32x4 acc[2][2][4][2];
#pragma unroll
    for (int a = 0; a < 2; ++a)
#pragma unroll
        for (int b = 0; b < 2; ++b)
#pragma unroll
            for (int m = 0; m < 4; ++m)
#pragma unroll
                for (int n = 0; n < 2; ++n) acc[a][b][m][n] = (f32x4){0.f, 0.f, 0.f, 0.f};
    bf16x8 At[4][2], B0[2][2], B1[2][2];
    const char* cA = (const char*)g.A + (size_t)cur.pm * tstep + (size_t)cur.kofs * 2; const char* cB = (const char*)g.Bt + (size_t)cur.pn * tstep + (size_t)cur.kofs * 2;
    if (cur.nt) nt = cur.nt;
    S.a_ready(cur);
    if constexpr (SP2) {
        PG8_STAGE(PG8_SB(0, 0), cB, voffB); PG8_STAGE(PG8_SB(0, 1), cB + hstep, voffB); PG8_STAGE(PG8_SA(0, 0), cA, voffA); PG8_STAGE(PG8_SA(0, 1), cA + hstep, voffA);
        if (wr == 1) PG8_BAR;
        PG8_WAIT_V(2); PG8_BAR;
        PG8_STAGE(PG8_SB(1, 0), cB + kstep, voffB); PG8_STAGE(PG8_SA(1, 0), cA + kstep, voffA); PG8_STAGE(PG8_SB(1, 1), cB + hstep + kstep, voffB);
        PG8_WAIT_V(6); PG8_BAR;
    } else {
        PG8_STAGE(PG8_SB(0, 0), cB, voffB); PG8_STAGE(PG8_SA(0, 0), cA, voffA); PG8_STAGE(PG8_SB(0, 1), cB + hstep, voffB); PG8_STAGE(PG8_SA(0, 1), cA + hstep, voffA);
        if (wr == 1) PG8_BAR;
        PG8_WAIT_V(4); PG8_BAR;
        PG8_STAGE(PG8_SB(1, 0), cB + kstep, voffB); PG8_STAGE(PG8_SA(1, 0), cA + kstep, voffA); PG8_STAGE(PG8_SB(1, 1), cB + hstep + kstep, voffB);
        PG8_WAIT_V(6); PG8_BAR;
    }
    for (;;) {
        const bool has_next = S.next(ui + 1, nxt);
        const char* nA = has_next ? (const char*)g.A + (size_t)nxt.pm * tstep + (size_t)nxt.kofs * 2 : cA; const char* nB = has_next ? (const char*)g.Bt + (size_t)nxt.pn * tstep + (size_t)nxt.kofs * 2 : cB;
        for (int t = 0; t < nt; t += 2) {
            const bool last = (t == nt - 2);
            const char* a1 = cA + (size_t)(t + 1) * kstep;
            const char* a2 = last ? nA : cA + (size_t)(t + 2) * kstep; const char* b2 = last ? nB : cB + (size_t)(t + 2) * kstep;
            const char* a3 = a2 + kstep; const char* b3 = b2 + kstep;
            if (last && has_next) S.a_ready(nxt);
            if constexpr (SP2) {
            PG8_LDB(B0, 0, 0); PG8_LDB(B1, 0, 1); PG8_SCHED; PG8_LDA(At, 0, 0); PG8_STAGE(PG8_SA(1, 1), a1 + hstep, voffA);
            PG8_WAIT_V(8); PG8_WAIT_L(0); PG8_BAR; PG8_MMA(0, 0, At, B0); PG8_MMA(0, 1, At, B1); PG8_BAR; PG8_SCHED;
            PG8_LDA(At, 0, 1); PG8_STAGE(PG8_SB(0, 0), b2, voffB); PG8_STAGE(PG8_SB(0, 1), b2 + hstep, voffB); PG8_STAGE(PG8_SA(0, 0), a2, voffA);
            PG8_WAIT_V(8); PG8_WAIT_L(0); PG8_BAR; PG8_MMA(1, 0, At, B0); PG8_MMA(1, 1, At, B1); PG8_BAR; PG8_SCHED;
            PG8_LDB(B0, 1, 0); PG8_LDB(B1, 1, 1); PG8_SCHED; PG8_LDA(At, 1, 0); PG8_STAGE(PG8_SA(0, 1), a2 + hstep, voffA);
            PG8_WAIT_V(8); PG8_WAIT_L(0); PG8_BAR; PG8_MMA(0, 0, At, B0); PG8_MMA(0, 1, At, B1); PG8_BAR; PG8_SCHED;
            PG8_LDA(At, 1, 1); PG8_STAGE(PG8_SB(1, 0), b3, voffB); PG8_STAGE(PG8_SB(1, 1), b3 + hstep, voffB); PG8_STAGE(PG8_SA(1, 0), a3, voffA);
            PG8_WAIT_V(8); PG8_WAIT_L(0); PG8_BAR; PG8_MMA(1, 0, At, B0); PG8_MMA(1, 1, At, B1); PG8_BAR; PG8_SCHED;
            } else {
            PG8_LDB(B0, 0, 0); PG8_SCHED; PG8_LDA(At, 0, 0); PG8_STAGE(PG8_SA(1, 1), a1 + hstep, voffA);
            PG8_WAIT_L(8); PG8_BAR; PG8_WAIT_L(0); PG8_MMA(0, 0, At, B0); PG8_BAR; PG8_SCHED;
            PG8_LDB(B1, 0, 1); PG8_STAGE(PG8_SB(0, 0), b2, voffB);
            PG8_BAR; PG8_WAIT_L(0); PG8_MMA(0, 1, At, B1); PG8_BAR;
            PG8_LDA(At, 0, 1); PG8_STAGE(PG8_SA(0, 0), a2, voffA);
            PG8_BAR; PG8_WAIT_L(0); PG8_MMA(1, 0, At, B0); PG8_BAR; PG8_SCHED;
            PG8_STAGE(PG8_SB(0, 1), b2 + hstep, voffB);
            PG8_WAIT_V(6); PG8_BAR; PG8_MMA(1, 1, At, B1); PG8_BAR;
            PG8_LDB(B0, 1, 0); PG8_SCHED; PG8_LDA(At, 1, 0); PG8_STAGE(PG8_SA(0, 1), a2 + hstep, voffA);
            PG8_WAIT_L(8); PG8_BAR; PG8_WAIT_L(0); PG8_MMA(0, 0, At, B0); PG8_BAR; PG8_SCHED;
            PG8_LDB(B1, 1, 1); PG8_STAGE(PG8_SB(1, 0), b3, voffB);
            PG8_BAR; PG8_WAIT_L(0); PG8_MMA(0, 1, At, B1); PG8_BAR;
            PG8_LDA(At, 1, 1); PG8_STAGE(PG8_SA(1, 0), a3, voffA);
            PG8_BAR; PG8_WAIT_L(0); PG8_MMA(1, 0, At, B0); PG8_BAR; PG8_SCHED;
            PG8_STAGE(PG8_SB(1, 1), b3 + hstep, voffB);
            PG8_WAIT_V(6); PG8_BAR; PG8_MMA(1, 1, At, B1); PG8_BAR;
            }
        }
        if constexpr (ALIGN_EPI) { if (wr == 0) PG8_BAR; }
        if constexpr (!Epi::AFTER_DRAIN) { E(acc, cur, wr, wc, fr, fq); S.done(cur); }
        if (!has_next) break;
#pragma unroll
        for (int a = 0; a < 2; ++a)
#pragma unroll
            for (int b = 0; b < 2; ++b)
#pragma unroll
                for (int m = 0; m < 4; ++m)
#pragma unroll
                    for (int n = 0; n < 2; ++n) acc[a][b][m][n] = (f32x4){0.f, 0.f, 0.f, 0.f};
        cur = nxt; cA = nA; cB = nB; ++ui; nt = cur.nt ? cur.nt : K / BK;
        if constexpr (ALIGN_EPI) { if (wr == 1) PG8_BAR; }
    }
    PG8_WAIT_V(0);
    if constexpr (!ALIGN_EPI) { if (wr == 0) PG8_BAR; }
    PG8_BAR;
    if constexpr (Epi::AFTER_DRAIN) { E.fused(acc, cur, wr, wc, fr, fq, lds, wid, lane); S.done(cur); }
#undef PG8_SA
#undef PG8_SB
#undef PG8_STAGE
#undef PG8_LDA
#undef PG8_LDB
#undef PG8_MMA
#undef PG8_WAIT_V
#undef PG8_WAIT_L
#undef PG8_BAR
#undef PG8_SCHED
}
}
#define LAS __attribute__((address_space(3)))
typedef unsigned short bf16_t;
typedef float f32x4 __attribute__((ext_vector_type(4)));
typedef short bf16x8 __attribute__((ext_vector_type(8)));
typedef unsigned u32x4 __attribute__((ext_vector_type(4)));
typedef unsigned u32x2 __attribute__((ext_vector_type(2)));

constexpr int DM = 1024, TP = 16384, TS = 512, TT = TP + TS, SEQ = 2048, NB = 8, NSB = 128;
constexpr int NPROJ = 2304, INDIM = 2312, DFF = 2816;
constexpr float EPS = 1e-6f;
constexpr int RT_H0 = 0, RT_MN = 66, RT_WIN = 74, RT_WXKV = 83, RT_END = 91;
constexpr size_t WS_R = 1u << 20;
constexpr size_t WS_H0 = WS_R;
constexpr size_t WS_MN = WS_R + (size_t)RT_MN * 256 * 2048;
constexpr size_t WS_WIN = WS_R + (size_t)RT_WIN * 256 * 2048;
constexpr size_t WS_WXKV = WS_R + (size_t)RT_WXKV * 256 * 2048;
constexpr size_t WS_WOUT = WS_R + (size_t)RT_END * 256 * 2048;
constexpr size_t WS_WXQ = WS_WOUT + 2097152;
constexpr size_t WS_WXO = WS_WXQ + 2097152;
constexpr size_t WS_WGU = WS_WXO + 2097152;
constexpr size_t WS_WDN = WS_WGU + (size_t)2 * DFF * 1024 * 2;
constexpr size_t WS_DTRAW = WS_WDN + (size_t)1024 * DFF * 2;
constexpr size_t WS_SPLIT = WS_DTRAW + (size_t)TT * 8 * 4;
constexpr size_t WS_ATOT = WS_SPLIT + (size_t)16 * 512 * 1024 * 4;
constexpr size_t WS_MIXIN = WS_ATOT + 8192;
constexpr size_t WS_CB16 = WS_MIXIN + (size_t)TT * 1024 * 2;
constexpr size_t WS_Q2 = WS_CB16 + (size_t)TT * 1024 * 2;
constexpr size_t WS_OX = WS_Q2 + (size_t)TT * 1024 * 2;
constexpr size_t WS_PROJ = WS_OX + (size_t)TT * 1024 * 2;
constexpr size_t WS_KVT = WS_PROJ + (size_t)TT * NPROJ * 2;
constexpr size_t WS_MK = WS_KVT + (size_t)256 * TT * 2;
constexpr size_t WS_MVT = WS_MK + (size_t)2048 * 1024 * 2;
constexpr size_t WS_MV = WS_MVT + (size_t)2048 * 1024 * 2;
constexpr size_t WS_CS = WS_MV + (size_t)2048 * 1024 * 2;
constexpr size_t WS_X1 = WS_CS;
constexpr size_t WS_END1 = WS_X1 + (size_t)TT * 1024 * 2 > WS_CS + (size_t)8 * 16 * 8 * 8192 * 4 ? WS_X1 + (size_t)TT * 1024 * 2 : WS_CS + (size_t)8 * 16 * 8 * 8192 * 4;
constexpr size_t WS_ACT = WS_PROJ;
constexpr size_t WS_END2 = WS_ACT + (size_t)TT * DFF * 2;
constexpr size_t WS_END = WS_END1 > WS_END2 ? WS_END1 : WS_END2;
constexpr size_t O_Y = 0, O_PSSM = 17301504, O_PCONV = 17825792, O_PWK = 17850368, O_PWV = 17981440, O_PMK = 18112512, O_PMV = 20209664,
                 O_SSSM = 22306816, O_SCONV = 30695424, O_SWK = 31088640, O_SWV = 33185792;
constexpr int LDS_BYTES = 147456;

struct Params {
    const float* in[32]; float* out; unsigned char* ws; int ph_lo, ph_hi;
};
typedef const __attribute__((address_space(4))) Params* CP;

__device__ __forceinline__ float bf2f(bf16_t h) { return __uint_as_float(((unsigned)h) << 16); }
__device__ __forceinline__ unsigned pk2(float lo, float hi) { return pg8::cvt_pk_bf16(lo, hi); }
__device__ __forceinline__ bf16_t f2bf(float f) { return (bf16_t)(pk2(f, 0.f) & 0xffffu); }
__device__ __forceinline__ float wave_sum(float v) {
#pragma unroll
    for (int o = 1; o < 64; o <<= 1) v += __shfl_xor(v, o);
    return v;
}
__device__ __forceinline__ float wave_max(float v) {
#pragma unroll
    for (int o = 1; o < 64; o <<= 1) v = fmaxf(v, __shfl_xor(v, o));
    return v;
}
__device__ __forceinline__ float silu_f(float x) { return x / (1.f + __expf(-x)); }
__device__ __forceinline__ float softplus_f(float x) { return x > 20.f ? x : log1pf(__expf(x)); }
#define LDSW() asm volatile("s_waitcnt lgkmcnt(0)" ::: "memory")

template <int NT>
__device__ __forceinline__ void mma_lds(f32x4 (&acc)[NT], const LAS bf16_t* A, int lda, const LAS bf16_t* B, int ldb, int K, int lane) {
    const int fr = lane & 15, fq = lane >> 4;
    for (int k0 = 0; k0 < K; k0 += 32) {
        const bf16x8 a = *(const LAS bf16x8*)(A + fr * lda + k0 + 8 * fq);
#pragma unroll
        for (int n = 0; n < NT; ++n) {
            const bf16x8 b = *(const LAS bf16x8*)(B + (16 * n + fr) * ldb + k0 + 8 * fq);
            acc[n] = __builtin_amdgcn_mfma_f32_16x16x32_bf16(b, a, acc[n], 0, 0, 0);
        }
    }
}
template <int NT, int KS, int ks0, int nks>
__device__ __forceinline__ void mma_areg(f32x4 (&acc)[NT], const bf16x8 (&a)[KS], const LAS bf16_t* B, int ldb, int lane) {
    const int fr = lane & 15, fq = lane >> 4;
#pragma unroll
    for (int ks = 0; ks < nks; ++ks) {
#pragma unroll
        for (int n = 0; n < NT; ++n) {
            const bf16x8 b = *(const LAS bf16x8*)(B + (16 * n + fr) * ldb + ks * 32 + 8 * fq);
            acc[n] = __builtin_amdgcn_mfma_f32_16x16x32_bf16(b, a[ks0 + ks], acc[n], 0, 0, 0);
        }
        __builtin_amdgcn_sched_barrier(0);
    }
}

struct Order {
    int n, G, c, mode, nN;
    __device__ __forceinline__ bool next(int i, pg8::Unit& u) const {
        const long L0 = (long)i * G + c; if (L0 >= n) return false;
        u.kofs = 0; u.nt = 0; u.q = 0;
        if (mode == 2) { const int L = (int)L0; if (L < 256) { const int v = (L % 8) * 32 + L / 8; u.pm = v / 4; u.pn = v % 4; }
            else { const int l = L - 256, q = l & 3, hi = ((nN + 7) / 8) * 2, lo = (nN - 2 * hi) / 2; u.pm = 64 + (l >> 4); u.pn = (l >> 2) & 3; u.q = q; u.nt = q < 2 ? hi : lo; u.kofs = 64 * (q < 2 ? q * hi : 2 * hi + (q - 2) * lo); } return true; }
        if (mode == 3) { const int L = (int)L0; if (L < 256) { const int v = (L % 8) * 32 + L / 8; u.pm = v / 4; u.pn = v % 4; }
            else { const int l = L - 256, q = l & 1; u.pm = 64 + (l >> 3); u.pn = (l >> 1) & 3; u.q = q; u.nt = nN / 2; u.kofs = 64 * q * (nN / 2); } return true; }
        int L = (int)L0; { const int q = n / 8, r = n % 8, xcd = L % 8, off = L / 8; L = (xcd < r ? xcd * (q + 1) : r * (q + 1) + (xcd - r) * q) + off; }
        if (mode == 0) {
            if (L < 594) { u.pm = L / 9; u.pn = RT_WIN + L % 9; }
            else if (L < 658) { const int l = L - 594; u.pm = RT_MN + l / 8; u.pn = RT_WXKV + l % 8; }
            else if (L < 690) { const int l = L - 658; u.pm = RT_WXKV + 4 + l / 8; u.pn = RT_MN + l % 8; }
            else { u.pm = RT_WIN + 8; u.pn = L - 690; }
        } else { u.pm = L / nN; u.pn = L % nN; }
        return true;
    }
    __device__ __forceinline__ void a_ready(const pg8::Unit&) const {}
    __device__ __forceinline__ void done(const pg8::Unit&) const {}
};
struct EpiP1 {
    static constexpr bool PERM = false, AFTER_DRAIN = false;
    bf16_t* proj; bf16_t* mk; bf16_t* mv; bf16_t* mvt; bf16_t* kvt;
    __device__ __forceinline__ void operator()(const f32x4 (&acc)[2][2][4][2], const pg8::Unit& u, int wr, int wc, int fr, int fq) const {
        bf16_t* base; int ld;
        if (u.pm < RT_MN) { base = proj + (size_t)(u.pm * 256) * NPROJ + (u.pn - RT_WIN) * 256; ld = NPROJ; }
        else if (u.pm < RT_WIN) { const int ct = u.pn - RT_WXKV; base = (ct < 4 ? mk + ct * 256 : mv + (ct - 4) * 256) + (size_t)((u.pm - RT_MN) * 256) * 1024; ld = 1024; }
        else if (u.pm == RT_WIN + 8) { base = kvt + u.pn * 256; ld = TT; }
        else { base = mvt + (size_t)((u.pm - RT_WXKV - 4) * 256) * 2048 + (u.pn - RT_MN) * 256; ld = 2048; }
#pragma unroll
        for (int ai = 0; ai < 2; ++ai)
#pragma unroll
            for (int m = 0; m < 4; ++m) {
                bf16_t* rowp = base + (size_t)(128 * ai + 64 * wr + 16 * m + fr) * ld + 32 * wc + 4 * fq;
#pragma unroll
                for (int bj = 0; bj < 2; ++bj)
#pragma unroll
                    for (int n = 0; n < 2; ++n) { const f32x4 v = acc[ai][bj][m][n]; u32x2 w; w.x = pk2(v[0], v[1]); w.y = pk2(v[2], v[3]); *(u32x2*)(rowp + 128 * bj + 16 * n) = w; }
            }
    }
};
struct EpiBf {
    static constexpr bool PERM = false, AFTER_DRAIN = false;
    bf16_t* O; int ldc; float scale; float* part;
    __device__ __forceinline__ void operator()(const f32x4 (&acc)[2][2][4][2], const pg8::Unit& u, int wr, int wc, int fr, int fq) const {
        if (u.nt) {
#pragma unroll
            for (int ai = 0; ai < 2; ++ai)
#pragma unroll
                for (int m = 0; m < 4; ++m) { float* rowp = part + (size_t)u.q * 512 * 1024 + (size_t)((u.pm - 64) * 256 + 128 * ai + 64 * wr + 16 * m + fr) * 1024 + u.pn * 256 + 32 * wc + 4 * fq;
#pragma unroll
                    for (int bj = 0; bj < 2; ++bj)
#pragma unroll
                        for (int n = 0; n < 2; ++n) *(f32x4*)(rowp + 128 * bj + 16 * n) = acc[ai][bj][m][n]; }
            return;
        }
#pragma unroll
        for (int ai = 0; ai < 2; ++ai)
#pragma unroll
            for (int m = 0; m < 4; ++m) {
                bf16_t* rowp = O + (size_t)(u.pm * 256 + 128 * ai + 64 * wr + 16 * m + fr) * ldc + u.pn * 256 + 32 * wc + 4 * fq;
#pragma unroll
                for (int bj = 0; bj < 2; ++bj)
#pragma unroll
                    for (int n = 0; n < 2; ++n) { const f32x4 v = acc[ai][bj][m][n] * scale; u32x2 w; w.x = pk2(v[0], v[1]); w.y = pk2(v[2], v[3]); *(u32x2*)(rowp + 128 * bj + 16 * n) = w; }
            }
    }
};
struct EpiGU {
    static constexpr bool PERM = false, AFTER_DRAIN = false;
    bf16_t* O;
    __device__ __forceinline__ void operator()(const f32x4 (&acc)[2][2][4][2], const pg8::Unit& u, int wr, int wc, int fr, int fq) const {
#pragma unroll
        for (int ai = 0; ai < 2; ++ai)
#pragma unroll
            for (int m = 0; m < 4; ++m) {
                bf16_t* rowp = O + (size_t)(u.pm * 256 + 128 * ai + 64 * wr + 16 * m + fr) * DFF + u.pn * 128 + 16 * wc + 4 * fq;
#pragma unroll
                for (int bj = 0; bj < 2; ++bj) { const f32x4 g = acc[ai][bj][m][0], up = acc[ai][bj][m][1];
                    u32x2 w; w.x = pk2(silu_f(g[0]) * up[0], silu_f(g[1]) * up[1]); w.y = pk2(silu_f(g[2]) * up[2], silu_f(g[3]) * up[3]); *(u32x2*)(rowp + 64 * bj) = w; }
            }
    }
};

struct TrSrc { const float* lo; const float* hi; int ld; };
__device__ __forceinline__ void tr_item(const TrSrc s, int k0, bf16_t* dst, int K, LAS float* scr, int lane) {
    const float* p = (lane & 16) ? s.hi + (lane & 15) : s.lo + (lane & 15);
    float tv[32];
#pragma unroll
    for (int i = 0; i < 32; ++i) { const int kk = 2 * i + (lane >> 5); tv[i] = __builtin_nontemporal_load(p + (size_t)(k0 + kk) * s.ld); }
#pragma unroll
    for (int i = 0; i < 32; ++i) { const int kk = 2 * i + (lane >> 5); scr[kk * 33 + (lane & 31)] = tv[i]; }
    LDSW();
    const int c = lane & 7;
#pragma unroll
    for (int j = 0; j < 4; ++j) { const int n = (lane >> 3) + 8 * j; const LAS float* q = scr + (8 * c) * 33 + n;
        u32x4 o; o.x = pk2(q[0], q[33]); o.y = pk2(q[2 * 33], q[3 * 33]); o.z = pk2(q[4 * 33], q[5 * 33]); o.w = pk2(q[6 * 33], q[7 * 33]);
        *(u32x4*)(dst + (size_t)n * K + 8 * c) = o; }
    LDSW();
}
__device__ __forceinline__ void rms_apply(f32x4 (&v)[4], const float* g, int lane) {
    float ss = 0.f;
#pragma unroll
    for (int j = 0; j < 4; ++j) ss += (v[j][0] * v[j][0] + v[j][1] * v[j][1]) + (v[j][2] * v[j][2] + v[j][3] * v[j][3]);
    const float r = rsqrtf(wave_sum(ss) * (1.f / 1024.f) + EPS);
#pragma unroll
    for (int j = 0; j < 4; ++j) { const f32x4 gv = *(const f32x4*)(g + 4 * lane + 256 * j); v[j] = v[j] * r * gv; }
}
__device__ __forceinline__ void store_row_bf16(bf16_t* o, const f32x4 (&v)[4], int lane) {
#pragma unroll
    for (int j = 0; j < 4; ++j) { u32x2 w; w.x = pk2(v[j][0], v[j][1]); w.y = pk2(v[j][2], v[j][3]); *(u32x2*)(o + 4 * lane + 256 * j) = w; }
}
__device__ __forceinline__ void load_row_f32(f32x4 (&v)[4], const float* x, int lane) {
#pragma unroll
    for (int j = 0; j < 4; ++j) v[j] = __builtin_nontemporal_load((const f32x4*)(x + 4 * lane + 256 * j));
}

__device__ __forceinline__ void tr_items(CP P, LAS unsigned char* lds, int part, int gw, int NGW, int wave, int lane) {
    unsigned char* ws = P->ws;
    LAS float* scr = (LAS float*)(lds + wave * 16384);
    constexpr int I_IN = 72 * 16, I_SQ = 512, I_GU = 176 * 16, I_DN = 32 * 44;
    const int nitems = part == 0 ? I_IN + 3 * I_SQ : 2 * I_SQ + I_GU + I_DN;
    for (int it = gw; it < nitems; it += NGW) {
        int r = it; TrSrc s; bf16_t* dst; int K = 1024, k0; int which = -1;
        if (part == 0) { if (r >= I_IN) { r -= I_IN; const int w3 = r / I_SQ; r %= I_SQ; which = w3 == 0 ? 0 : w3 + 2; } }
        else { if (r < 2 * I_SQ) { which = 1 + r / I_SQ; r %= I_SQ; } else r -= 2 * I_SQ; }
        if (part == 0 && which < 0) { const int nb = r / 16, kb = r % 16, n0 = nb * 32, sc = n0 + (n0 >= 1536 ? 8 : 0);
            s.lo = P->in[10] + sc; s.hi = s.lo + 16; s.ld = INDIM; k0 = kb * 64; dst = (bf16_t*)(ws + WS_WIN) + (size_t)n0 * 1024 + k0; }
        else if (which >= 0) { const int nb = r / 16, kb = r % 16;
            const float* W = which == 0 ? P->in[18] : which == 1 ? P->in[21] : which == 2 ? P->in[25] : which == 3 ? P->in[23] : P->in[24];
            bf16_t* D = which == 0 ? (bf16_t*)(ws + WS_WOUT) : which == 1 ? (bf16_t*)(ws + WS_WXQ) : which == 2 ? (bf16_t*)(ws + WS_WXO) : which == 3 ? (bf16_t*)(ws + WS_WXKV) : (bf16_t*)(ws + WS_WXKV) + (size_t)1024 * 1024;
            s.lo = W + nb * 32; s.hi = s.lo + 16; s.ld = 1024; k0 = kb * 64; dst = D + (size_t)nb * 32 * 1024 + k0; }
        else if (r < I_GU) { const int nb = r / 16, kb = r % 16;
            s.lo = P->in[28] + nb * 16; s.hi = P->in[29] + nb * 16; s.ld = DFF; k0 = kb * 64; dst = (bf16_t*)(ws + WS_WGU) + (size_t)nb * 32 * 1024 + k0; }
        else { r -= I_GU; const int nb = r / 44, kb = r % 44; K = DFF;
            s.lo = P->in[30] + nb * 32; s.hi = s.lo + 16; s.ld = 1024; k0 = kb * 64; dst = (bf16_t*)(ws + WS_WDN) + (size_t)nb * 32 * DFF + k0; }
        tr_item(s, k0, dst, K, scr, lane);
    }
}
__device__ __forceinline__ void phase_prologue(CP P, LAS unsigned char* lds, int gw, int NGW, int wave, int lane) {
    unsigned char* ws = P->ws;
    tr_items(P, lds, 0, gw, NGW, wave, lane);
    __syncthreads();
    LAS float* wT = (LAS float*)lds;
    { const int tid = wave * 64 + lane;
#pragma unroll
      for (int it = 0; it < 4; ++it) { const int idx = tid + 512 * it, c = idx >> 1, hf = idx & 1; const f32x4 w = *(const f32x4*)(P->in[10] + (size_t)c * INDIM + 1536 + 4 * hf);
          wT[(4 * hf + 0) * 1024 + c] = w[0]; wT[(4 * hf + 1) * 1024 + c] = w[1]; wT[(4 * hf + 2) * 1024 + c] = w[2]; wT[(4 * hf + 3) * 1024 + c] = w[3]; } }
    __syncthreads();
    {
        f32x4 nx[4];
        if (gw < TT) load_row_f32(nx, gw < TP ? P->in[0] + (size_t)gw * 1024 : P->in[1] + (size_t)(gw - TP) * 1024, lane);
        for (int m = gw; m < TT; m += NGW) {
            f32x4 v[4];
#pragma unroll
            for (int j = 0; j < 4; ++j) v[j] = nx[j];
            const int m2 = m + NGW;
            if (m2 < TT) load_row_f32(nx, m2 < TP ? P->in[0] + (size_t)m2 * 1024 : P->in[1] + (size_t)(m2 - TP) * 1024, lane);
            rms_apply(v, P->in[9], lane);
            store_row_bf16((bf16_t*)(ws + WS_H0) + (size_t)m * 1024, v, lane);
            float d[8];
#pragma unroll
            for (int e = 0; e < 8; ++e) { float a = 0.f;
#pragma unroll
                for (int j = 0; j < 4; ++j) { const f32x4 w = *(const LAS f32x4*)(wT + e * 1024 + 4 * lane + 256 * j); a += (v[j][0] * w[0] + v[j][1] * w[1]) + (v[j][2] * w[2] + v[j][3] * w[3]); }
                d[e] = wave_sum(a); }
            if (lane == 0) { float* o = (float*)(ws + WS_DTRAW) + (size_t)m * 8; *(f32x4*)o = (f32x4){d[0], d[1], d[2], d[3]}; *(f32x4*)(o + 4) = (f32x4){d[4], d[5], d[6], d[7]}; }
        }
    }
    __syncthreads();
    for (int m = gw; m < 2048; m += NGW) {
        f32x4 v[4]; load_row_f32(v, P->in[8] + (size_t)m * 1024, lane); rms_apply(v, P->in[22], lane);
        store_row_bf16((bf16_t*)(ws + WS_MN) + (size_t)m * 1024, v, lane);
    }
}

__device__ __forceinline__ void phase_resid(CP P, int stage, int gw, int NGW, int lane) {
    unsigned char* ws = P->ws; const bf16_t* C = (const bf16_t*)(ws + WS_CB16); bf16_t* XB = (bf16_t*)(ws + WS_X1);
    const float* g1 = stage == 0 ? P->in[19] : stage == 1 ? P->in[26] : P->in[31];
    const float* g2 = stage == 0 ? P->in[20] : P->in[27];
    for (int m = gw; m < TT; m += NGW) {
        f32x4 c[4], x[4];
        if (m >= TP) { const float* pp_ = (const float*)(ws + WS_SPLIT) + (size_t)(stage == 0 ? 0 : stage == 1 ? 8 : 12) * 512 * 1024 + (size_t)(m - TP) * 1024; f32x4 c1[4], c2[4], c3[4];
            load_row_f32(c, pp_, lane); load_row_f32(c1, pp_ + 512 * 1024, lane);
            if (stage == 2) { load_row_f32(c2, pp_ + 2 * 512 * 1024, lane); load_row_f32(c3, pp_ + 3 * 512 * 1024, lane); }
#pragma unroll
            for (int j = 0; j < 4; ++j) c[j] = stage == 2 ? (c[j] + c1[j]) + (c2[j] + c3[j]) : c[j] + c1[j]; }
        else {
#pragma unroll
        for (int j = 0; j < 4; ++j) { const u32x2 w = __builtin_nontemporal_load((const u32x2*)(C + (size_t)m * 1024 + 4 * lane + 256 * j));
            c[j] = (f32x4){__uint_as_float(w.x << 16), __uint_as_float(w.x & 0xffff0000u), __uint_as_float(w.y << 16), __uint_as_float(w.y & 0xffff0000u)}; }
        }
        if (stage == 0) load_row_f32(x, m < TP ? P->in[0] + (size_t)m * 1024 : P->in[1] + (size_t)(m - TP) * 1024, lane);
        else {
#pragma unroll
            for (int j = 0; j < 4; ++j) { const u32x2 w = *(const u32x2*)(XB + (size_t)m * 1024 + 4 * lane + 256 * j);
                x[j] = (f32x4){__uint_as_float(w.x << 16), __uint_as_float(w.x & 0xffff0000u), __uint_as_float(w.y << 16), __uint_as_float(w.y & 0xffff0000u)}; }
        }
        rms_apply(c, g1, lane);
#pragma unroll
        for (int j = 0; j < 4; ++j) x[j] = x[j] + c[j];
        if (stage == 2) {
#pragma unroll
            for (int j = 0; j < 4; ++j) *(f32x4*)(P->out + (size_t)m * 1024 + 4 * lane + 256 * j) = x[j];
        } else {
#pragma unroll
            for (int j = 0; j < 4; ++j) { u32x2 w; w.x = pk2(x[j][0], x[j][1]); w.y = pk2(x[j][2], x[j][3]); *(u32x2*)(XB + (size_t)m * 1024 + 4 * lane + 256 * j) = w;
                x[j] = (f32x4){__uint_as_float(w.x << 16), __uint_as_float(w.x & 0xffff0000u), __uint_as_float(w.y << 16), __uint_as_float(w.y & 0xffff0000u)}; }
            rms_apply(x, g2, lane); store_row_bf16((bf16_t*)(ws + WS_H0) + (size_t)m * 1024, x, lane);
        }
    }
}

__device__ __forceinline__ void conv8(const bf16_t* col, int t0, bool zero_hist, const float (&w)[4], float bias, float (&out)[8], float (&raw)[11]) {
#pragma unroll
    for (int i = 0; i < 11; ++i) { const int r = t0 - 3 + i; raw[i] = (r < 0 && zero_hist) ? 0.f : bf2f(col[(long)r * NPROJ]); }
#pragma unroll
    for (int j = 0; j < 8; ++j) out[j] = silu_f(bias + w[0] * raw[j] + w[1] * raw[j + 1] + w[2] * raw[j + 2] + w[3] * raw[j + 3]);
}
__device__ __forceinline__ void conv8x2(const bf16_t* col, int t0, bool zero_hist, const float* cw, const float* cb, int ch, float (&o0)[8], float (&o1)[8]) {
    float r0[11], r1[11];
#pragma unroll
    for (int i = 0; i < 11; ++i) { const int r = t0 - 3 + i; unsigned w = 0u; if (!(r < 0 && zero_hist)) w = *(const unsigned*)(col + (long)r * NPROJ); r0[i] = __uint_as_float(w << 16); r1[i] = __uint_as_float(w & 0xffff0000u); }
    const float b0 = cb[ch], b1 = cb[ch + 1];
    float w0[4], w1[4];
#pragma unroll
    for (int j = 0; j < 4; ++j) { w0[j] = cw[j * 1024 + ch]; w1[j] = cw[j * 1024 + ch + 1]; }
#pragma unroll
    for (int j = 0; j < 8; ++j) { o0[j] = silu_f(b0 + w0[0] * r0[j] + w0[1] * r0[j + 1] + w0[2] * r0[j + 2] + w0[3] * r0[j + 3]);
                                  o1[j] = silu_f(b1 + w1[0] * r1[j] + w1[1] * r1[j + 1] + w1[2] * r1[j + 2] + w1[3] * r1[j + 3]); }
}
__device__ __forceinline__ void dt_acum(CP P, int row0, int g, LAS float* dtv, LAS float* acum, int wave, int lane) {
    if (wave < 4) {
        const int h = g * 4 + wave; const float* dr = (const float*)(P->ws + WS_DTRAW);
        const float bias = P->in[13][h], a = -__expf(P->in[14][h]);
        const float d0 = softplus_f(dr[(size_t)(row0 + 2 * lane) * 8 + h] + bias), d1 = softplus_f(dr[(size_t)(row0 + 2 * lane + 1) * 8 + h] + bias);
        const float a0 = a * d0, a1 = a * d1; float s = a0 + a1;
#pragma unroll
        for (int o = 1; o < 64; o <<= 1) { const float t = __shfl_up(s, o); if (lane >= o) s += t; }
        dtv[(2 * lane) * 4 + wave] = d0; dtv[(2 * lane + 1) * 4 + wave] = d1;
        acum[(2 * lane) * 4 + wave] = s - a1; acum[(2 * lane + 1) * 4 + wave] = s;
    }
}

constexpr int PT = 136;
__device__ __forceinline__ void ssd_pass_a(CP P, LAS unsigned char* lds, int unit, int tid, int wave, int lane) {
    const int b = unit >> 5, c = (unit >> 1) & 15, g = unit & 1, row0 = b * SEQ + c * 128;
    LAS bf16_t* BT = (LAS bf16_t*)lds;
    LAS bf16_t* XW = (LAS bf16_t*)(lds + 128 * PT * 2);
    LAS float* dtv = (LAS float*)(lds + 384 * PT * 2); LAS float* acum = dtv + 512;
    const bf16_t* proj = (const bf16_t*)(P->ws + WS_PROJ);
    dt_acum(P, row0, g, dtv, acum, wave, lane);
    __syncthreads();
#pragma unroll 3
    for (int kk_ = 0; kk_ < 6; ++kk_) {
        const int it = tid + 512 * kk_;
        const int pr = it % 192, tb = it / 192, t0 = tb * 8, chl = 2 * pr;
        const int ch = chl < 256 ? g * 256 + chl : 512 + g * 128 + (chl - 256);
        float o0[8], o1[8]; conv8x2(proj + (size_t)row0 * NPROJ + 512 + ch, t0, c == 0, P->in[11], P->in[12], ch, o0, o1);
        if (chl < 256) { const int hh = chl >> 6; const float aend = acum[127 * 4 + hh];
#pragma unroll
            for (int j = 0; j < 8; ++j) { const float wg = dtv[(t0 + j) * 4 + hh] * __expf(aend - acum[(t0 + j) * 4 + hh]); o0[j] *= wg; o1[j] *= wg; } }
        u32x4 pk0, pk1; pk0.x = pk2(o0[0], o0[1]); pk0.y = pk2(o0[2], o0[3]); pk0.z = pk2(o0[4], o0[5]); pk0.w = pk2(o0[6], o0[7]);
        pk1.x = pk2(o1[0], o1[1]); pk1.y = pk2(o1[2], o1[3]); pk1.z = pk2(o1[4], o1[5]); pk1.w = pk2(o1[6], o1[7]);
        LAS bf16_t* d = chl < 256 ? XW + chl * PT + t0 : BT + (chl - 256) * PT + t0;
        *(LAS u32x4*)d = pk0; *(LAS u32x4*)(d + PT) = pk1;
    }
    __syncthreads();
    float* cs = (float*)(P->ws + WS_CS) + (size_t)((b * 16 + c) * 8 + g * 4) * 8192;
#pragma unroll
    for (int mt = 0; mt < 2; ++mt) {
        f32x4 acc[8];
#pragma unroll
        for (int n = 0; n < 8; ++n) acc[n] = (f32x4){0.f, 0.f, 0.f, 0.f};
        const int r0 = 32 * wave + 16 * mt;
        mma_lds<8>(acc, XW + r0 * PT, PT, BT, PT, 128, lane);
        const int fr = lane & 15, fq = lane >> 4;
#pragma unroll
        for (int n = 0; n < 8; ++n) *(f32x4*)(cs + (size_t)(r0 + fr) * 128 + 16 * n + 4 * fq) = acc[n];
    }
    if (tid < 4) ((float*)(P->ws + WS_ATOT))[(b * 16 + c) * 8 + g * 4 + tid] = acum[127 * 4 + tid];
    __syncthreads();
}

__device__ __forceinline__ void ssd_state_scan(CP P, int bid, int G, int tid) {
    for (int base_ = bid * 512; base_ < 8 * 8 * 2048; base_ += G * 512) {
        const int i = base_ + tid, bh = i >> 11, e4 = i & 2047, b = bh >> 3, h = bh & 7;
        float* cs = (float*)(P->ws + WS_CS) + (size_t)(b * 16 * 8 + h) * 8192 + 4 * e4;
        const float* at = (const float*)(P->ws + WS_ATOT) + b * 16 * 8 + h;
        f32x4 v[16]; float dec[16];
#pragma unroll
        for (int c = 0; c < 16; ++c) { v[c] = *(const f32x4*)(cs + (size_t)c * 8 * 8192); dec[c] = __expf(at[c * 8]); }
        f32x4 st = (f32x4){0.f, 0.f, 0.f, 0.f};
#pragma unroll
        for (int c = 0; c < 16; ++c) { *(f32x4*)(cs + (size_t)c * 8 * 8192) = st; st = st * dec[c] + v[c]; }
        *(f32x4*)(P->out + O_PSSM + (size_t)(b * 8 + h) * 8192 + 4 * e4) = st;
    }
}

__device__ __forceinline__ void ssd_pass_b(CP P, LAS unsigned char* lds, int unit, int tid, int wave, int lane) {
    const int b = unit >> 5, c = (unit >> 1) & 15, g = unit & 1, row0 = b * SEQ + c * 128;
    const int fr = lane & 15, fq = lane >> 4;
    LAS bf16_t* Cs = (LAS bf16_t*)lds;
    LAS bf16_t* Bs = (LAS bf16_t*)(lds + 128 * PT * 2);
    LAS bf16_t* XT = (LAS bf16_t*)(lds + 256 * PT * 2);
    LAS bf16_t* SI = (LAS bf16_t*)(lds + 320 * PT * 2);
    LAS float* dtv = (LAS float*)(lds + 384 * PT * 2); LAS float* acum = dtv + 512;
    const bf16_t* proj = (const bf16_t*)(P->ws + WS_PROJ);
    dt_acum(P, row0, g, dtv, acum, wave, lane);
#pragma unroll 4
    for (int kk_ = 0; kk_ < 4; ++kk_) {
        const int it = tid + 512 * kk_;
        const int chl = 2 * (it & 127), tb = it >> 7, t0 = tb * 8;
        const int ch = chl < 128 ? 512 + g * 128 + chl : 768 + g * 128 + (chl - 128);
        float o0[8], o1[8]; conv8x2(proj + (size_t)row0 * NPROJ + 512 + ch, t0, c == 0, P->in[11], P->in[12], ch, o0, o1);
        LAS bf16_t* d = chl < 128 ? Bs + chl : Cs + (chl - 128);
#pragma unroll
        for (int j = 0; j < 8; ++j) *(LAS unsigned*)(d + (t0 + j) * PT) = pk2(o0[j], o1[j]);
    }
    if (c == 15) {
        const int ch = tid < 256 ? g * 256 + tid : (tid < 384 ? 512 + g * 128 + (tid - 256) : 768 + g * 128 + (tid - 384));
#pragma unroll
        for (int i = 0; i < 3; ++i) P->out[O_PCONV + (size_t)(b * 3 + i) * 1024 + ch] = bf2f(proj[(size_t)(row0 + 125 + i) * NPROJ + 512 + ch]);
    }
    __syncthreads();
    f32x4 cb[8];
#pragma unroll
    for (int n = 0; n < 8; ++n) cb[n] = (f32x4){0.f, 0.f, 0.f, 0.f};
    mma_lds<8>(cb, Cs + 16 * wave * PT, PT, Bs, PT, 128, lane);
    __syncthreads();
    LAS bf16_t* Ls = Bs;
    const int t = 16 * wave + fr;
    float ss = 0.f;
    const bf16_t* zr = proj + (size_t)(row0 + t) * NPROJ + g * 256;
    bf16_t* orow = (bf16_t*)(P->ws + WS_MIXIN) + (size_t)(row0 + t) * 1024 + g * 256;
#pragma unroll 1
    for (int hh = 0; hh < 4; ++hh) {
        const int h = g * 4 + hh;
        u32x2 zw4[4];
#pragma unroll
        for (int n = 0; n < 4; ++n) zw4[n] = *(const u32x2*)(zr + hh * 64 + 16 * n + 4 * fq);
        {
            const int p = 2 * (tid & 31), tb = tid >> 5, t0 = tb * 8, ch = h * 64 + p;
            float o0[8], o1[8]; conv8x2(proj + (size_t)row0 * NPROJ + 512 + ch, t0, c == 0, P->in[11], P->in[12], ch, o0, o1);
            u32x4 pk0, pk1; pk0.x = pk2(o0[0], o0[1]); pk0.y = pk2(o0[2], o0[3]); pk0.z = pk2(o0[4], o0[5]); pk0.w = pk2(o0[6], o0[7]);
            pk1.x = pk2(o1[0], o1[1]); pk1.y = pk2(o1[2], o1[3]); pk1.z = pk2(o1[4], o1[5]); pk1.w = pk2(o1[6], o1[7]);
            *(LAS u32x4*)(XT + p * PT + t0) = pk0; *(LAS u32x4*)(XT + (p + 1) * PT + t0) = pk1;
        }
        {
            const int p = tid >> 3, n0 = (tid & 7) * 16;
            const float* src = (const float*)(P->ws + WS_CS) + (size_t)((b * 16 + c) * 8 + h) * 8192 + p * 128 + n0;
#pragma unroll
            for (int q = 0; q < 4; ++q) { const f32x4 sv = *(const f32x4*)(src + 4 * q); u32x2 w2; w2.x = pk2(sv[0], sv[1]); w2.y = pk2(sv[2], sv[3]); *(LAS u32x2*)(SI + p * PT + n0 + 4 * q) = w2; }
        }
        {
            const float at_ = acum[t * 4 + hh];
#pragma unroll
            for (int n = 0; n < 8; ++n) {
                float l[4];
#pragma unroll
                for (int e = 0; e < 4; ++e) { const int s_ = 16 * n + 4 * fq + e; l[e] = (s_ <= t) ? cb[n][e] * __expf(at_ - acum[s_ * 4 + hh]) * dtv[s_ * 4 + hh] : 0.f; }
                u32x2 w2; w2.x = pk2(l[0], l[1]); w2.y = pk2(l[2], l[3]); *(LAS u32x2*)(Ls + t * PT + 16 * n + 4 * fq) = w2;
            }
        }
        __syncthreads();
        {
            f32x4 yd[4], yo[4];
#pragma unroll
            for (int n = 0; n < 4; ++n) { yd[n] = (f32x4){0.f, 0.f, 0.f, 0.f}; yo[n] = (f32x4){0.f, 0.f, 0.f, 0.f}; }
            mma_lds<4>(yd, Ls + 16 * wave * PT, PT, XT, PT, 128, lane);
            mma_lds<4>(yo, Cs + 16 * wave * PT, PT, SI, PT, 128, lane);
            const float ea = __expf(acum[t * 4 + hh]), dsk = P->in[15][h];
#pragma unroll
            for (int n = 0; n < 4; ++n) {
                const u32x2 zw = zw4[n];
                const float z[4] = {__uint_as_float(zw.x << 16), __uint_as_float(zw.x & 0xffff0000u), __uint_as_float(zw.y << 16), __uint_as_float(zw.y & 0xffff0000u)};
                float u[4];
#pragma unroll
                for (int e = 0; e < 4; ++e) { u[e] = (yd[n][e] + ea * yo[n][e] + dsk * bf2f(XT[(16 * n + 4 * fq + e) * PT + t])) * silu_f(z[e]); ss += u[e] * u[e]; }
                u32x2 w2; w2.x = pk2(u[0], u[1]); w2.y = pk2(u[2], u[3]); *(u32x2*)(orow + hh * 64 + 16 * n + 4 * fq) = w2;
            }
        }
        __syncthreads();
    }
    {
        ss += __shfl_xor(ss, 16); ss += __shfl_xor(ss, 32);
        const float r = rsqrtf(ss * (1.f / 256.f) + EPS);
#pragma unroll
        for (int hh = 0; hh < 4; ++hh)
#pragma unroll
            for (int n = 0; n < 4; ++n) { const int col = hh * 64 + 16 * n + 4 * fq; const f32x4 gv = *(const f32x4*)(P->in[16] + g * 256 + col);
                const u32x2 uw = *(const u32x2*)(orow + col);
                const float u0 = __uint_as_float(uw.x << 16) * r * gv[0], u1 = __uint_as_float(uw.x & 0xffff0000u) * r * gv[1], u2 = __uint_as_float(uw.y << 16) * r * gv[2], u3 = __uint_as_float(uw.y & 0xffff0000u) * r * gv[3];
                u32x2 w2; w2.x = pk2(u0, u1); w2.y = pk2(u2, u3); *(u32x2*)(orow + col) = w2; }
    }
    __syncthreads();
}

constexpr int PK = 72, PV = 264;
__device__ __forceinline__ void swa_prompt(CP P, LAS unsigned char* lds, int unit, int tid, int wave, int lane) {
    const int b = unit >> 5, nb = (unit >> 1) & 15, kvh = unit & 1, row0 = b * SEQ + nb * 128;
    const int fr = lane & 15, fq = lane >> 4;
    LAS bf16_t* Ks = (LAS bf16_t*)lds;
    LAS bf16_t* VT = (LAS bf16_t*)(lds + 256 * PK * 2);
    const bf16_t* proj = (const bf16_t*)(P->ws + WS_PROJ); const bf16_t* kvt = (const bf16_t*)(P->ws + WS_KVT);
#pragma unroll
    for (int kk_ = 0; kk_ < 4; ++kk_) {
        const int ci = tid + 512 * kk_;
        { const int row = ci >> 3, c8 = ci & 7; u32x4 v = (u32x4){0u, 0u, 0u, 0u};
          if (!(nb == 0 && row < 128)) v = *(const u32x4*)(proj + (size_t)(row0 - 128 + row) * NPROJ + 2048 + kvh * 64 + c8 * 8);
          *(LAS u32x4*)(Ks + row * PK + c8 * 8) = v; }
        { const int d = ci >> 5, c = ci & 31; u32x4 v = (u32x4){0u, 0u, 0u, 0u};
          if (!(nb == 0 && c < 16)) v = *(const u32x4*)(kvt + (size_t)(128 + kvh * 64 + d) * TT + row0 - 128 + c * 8);
          *(LAS u32x4*)(VT + d * PV + c * 8) = v; }
    }
    __syncthreads();
    const int r = wave >> 1, head = kvh * 4 + r; const float sink = P->in[17][head];
    bf16x8 qn[2];
#pragma unroll
    for (int ks = 0; ks < 2; ++ks) qn[ks] = *(const bf16x8*)(proj + (size_t)(row0 + (wave & 1) * 64 + fr) * NPROJ + 1536 + head * 64 + ks * 32 + 8 * fq);
    for (int st = 0; st < 4; ++st) {
        const int q0 = (wave & 1) * 64 + 16 * st, qi = q0 + fr;
        bf16x8 qf[2];
#pragma unroll
        for (int ks = 0; ks < 2; ++ks) qf[ks] = qn[ks];
        if (st < 3) {
#pragma unroll
            for (int ks = 0; ks < 2; ++ks) qn[ks] = *(const bf16x8*)(proj + (size_t)(row0 + qi + 16) * NPROJ + 1536 + head * 64 + ks * 32 + 8 * fq);
        }
        f32x4 s[16];
#pragma unroll
        for (int n = 0; n < 16; ++n) s[n] = (f32x4){0.f, 0.f, 0.f, 0.f};
        mma_areg<16, 2, 0, 2>(s, qf, Ks, PK, lane);
        float mx = sink;
#pragma unroll
        for (int n = 0; n < 16; ++n)
#pragma unroll
            for (int e = 0; e < 4; ++e) { const int kj = 16 * n + 4 * fq + e; const bool ok = (kj > qi) && (kj <= qi + 128) && (nb > 0 || kj >= 128);
                const float v = ok ? s[n][e] * 0.125f : -INFINITY; s[n][e] = v; mx = fmaxf(mx, v); }
        mx = fmaxf(mx, __shfl_xor(mx, 16)); mx = fmaxf(mx, __shfl_xor(mx, 32));
        float sum = 0.f;
#pragma unroll
        for (int n = 0; n < 16; ++n)
#pragma unroll
            for (int e = 0; e < 4; ++e) { const float ev = __expf(s[n][e] - mx); s[n][e] = ev; sum += ev; }
        sum += __shfl_xor(sum, 16); sum += __shfl_xor(sum, 32);
        const float inv = 1.f / (sum + __expf(sink - mx));
        bf16x8 pf[8];
#pragma unroll
        for (int ks = 0; ks < 8; ++ks) { u32x4 w; w.x = pk2(s[2 * ks][0] * inv, s[2 * ks][1] * inv); w.y = pk2(s[2 * ks][2] * inv, s[2 * ks][3] * inv);
            w.z = pk2(s[2 * ks + 1][0] * inv, s[2 * ks + 1][1] * inv); w.w = pk2(s[2 * ks + 1][2] * inv, s[2 * ks + 1][3] * inv); pf[ks] = __builtin_bit_cast(bf16x8, w); }
        f32x4 o[4];
#pragma unroll
        for (int n = 0; n < 4; ++n) o[n] = (f32x4){0.f, 0.f, 0.f, 0.f};
#pragma unroll
        for (int ks = 0; ks < 8; ++ks) {
#pragma unroll
            for (int n = 0; n < 4; ++n) {
                const LAS bf16_t* vp = VT + (16 * n + fr) * PV + 32 * ks + 4 * fq;
                const u32x2 a0 = *(const LAS u32x2*)vp, a1 = *(const LAS u32x2*)(vp + 16);
                o[n] = __builtin_amdgcn_mfma_f32_16x16x32_bf16(__builtin_bit_cast(bf16x8, (u32x4){a0.x, a0.y, a1.x, a1.y}), pf[ks], o[n], 0, 0, 0);
            }
            __builtin_amdgcn_sched_barrier(0);
        }
        asm volatile("s_nop 7\n\ts_nop 7\n\ts_nop 7" ::: "memory");
        bf16_t* op = (bf16_t*)(P->ws + WS_MIXIN) + (size_t)(row0 + qi) * 1024 + 512 + head * 64 + 4 * fq;
#pragma unroll
        for (int n = 0; n < 4; ++n) { u32x2 w2; w2.x = pk2(o[n][0], o[n][1]); w2.y = pk2(o[n][2], o[n][3]); *(u32x2*)(op + 16 * n) = w2; }
        LDSW();
    }
    __syncthreads();
}

__device__ __forceinline__ void ssd_sample(CP P, LAS unsigned char* lds, int unit, int tid, int wave, int lane) {
    const int b = unit >> 1, g = unit & 1, row0 = TP + b * 4;
    LAS float* xs = (LAS float*)lds;
    LAS float* Bsm = xs + 1024;
    LAS float* Csm = Bsm + 512;
    LAS float* ys = Csm + 512;
    LAS float* dts = ys + 1024;
    const bf16_t* proj = (const bf16_t*)(P->ws + WS_PROJ);
    {
        const int ch = tid < 256 ? g * 256 + tid : (tid < 384 ? 512 + g * 128 + (tid - 256) : 768 + g * 128 + (tid - 384));
        float up[7];
#pragma unroll
        for (int i = 0; i < 3; ++i) up[i] = P->in[3][(size_t)(b * 3 + i) * 1024 + ch];
#pragma unroll
        for (int i = 0; i < 4; ++i) up[3 + i] = bf2f(proj[(size_t)(row0 + i) * NPROJ + 512 + ch]);
        float w[4];
#pragma unroll
        for (int j = 0; j < 4; ++j) w[j] = P->in[11][j * 1024 + ch];
        const float bias = P->in[12][ch];
        LAS float* dst = tid < 256 ? xs + tid : (tid < 384 ? Bsm + (tid - 256) : Csm + (tid - 384)); const int pitch = tid < 256 ? 256 : 128;
#pragma unroll
        for (int i = 0; i < 4; ++i) dst[i * pitch] = silu_f(bias + w[0] * up[i] + w[1] * up[i + 1] + w[2] * up[i + 2] + w[3] * up[i + 3]);
#pragma unroll
        for (int i = 0; i < 3; ++i) P->out[O_SCONV + (size_t)(b * 3 + i) * 1024 + ch] = up[4 + i];
        if (tid < 16) { const int tt = tid >> 2, hh = tid & 3, h = g * 4 + hh; dts[tid] = softplus_f(((const float*)(P->ws + WS_DTRAW))[(size_t)(row0 + tt) * 8 + h] + P->in[13][h]); }
    }
    __syncthreads();
    const int p = tid >> 3, n0 = (tid & 7) * 16;
    f32x4 stv[4][4];
#pragma unroll
    for (int hh = 0; hh < 4; ++hh)
#pragma unroll
        for (int q = 0; q < 4; ++q) stv[hh][q] = __builtin_nontemporal_load((const f32x4*)(P->in[2] + (size_t)((b * 8 + g * 4 + hh) * 64 + p) * 128 + n0 + 4 * q));
#pragma unroll
    for (int hh = 0; hh < 4; ++hh) {
        const int h = g * 4 + hh; const float a = -__expf(P->in[14][h]), dsk = P->in[15][h];
        float st[16];
#pragma unroll
        for (int q = 0; q < 4; ++q) { const f32x4 v = stv[hh][q]; st[4 * q] = v[0]; st[4 * q + 1] = v[1]; st[4 * q + 2] = v[2]; st[4 * q + 3] = v[3]; }
#pragma unroll
        for (int tt = 0; tt < 4; ++tt) {
            const float dt = dts[tt * 4 + hh], dA = __expf(a * dt), xv = xs[tt * 256 + hh * 64 + p], dx = dt * xv; float yv = 0.f;
#pragma unroll
            for (int q = 0; q < 16; ++q) { st[q] = dA * st[q] + dx * Bsm[tt * 128 + n0 + q]; yv += st[q] * Csm[tt * 128 + n0 + q]; }
            yv += __shfl_xor(yv, 1); yv += __shfl_xor(yv, 2); yv += __shfl_xor(yv, 4);
            if ((tid & 7) == 0) ys[tt * 256 + hh * 64 + p] = yv + dsk * xv;
        }
        float* op = P->out + O_SSSM + (size_t)((b * 8 + h) * 64 + p) * 128 + n0;
#pragma unroll
        for (int q = 0; q < 4; ++q) *(f32x4*)(op + 4 * q) = (f32x4){st[4 * q], st[4 * q + 1], st[4 * q + 2], st[4 * q + 3]};
    }
    __syncthreads();
    if (wave < 4) {
        const int tt = wave; const bf16_t* zr = proj + (size_t)(row0 + tt) * NPROJ + g * 256 + 4 * lane;
        const u32x2 zw = *(const u32x2*)zr; const float z[4] = {__uint_as_float(zw.x << 16), __uint_as_float(zw.x & 0xffff0000u), __uint_as_float(zw.y << 16), __uint_as_float(zw.y & 0xffff0000u)};
        float u[4], ss = 0.f;
#pragma unroll
        for (int e = 0; e < 4; ++e) { u[e] = ys[tt * 256 + 4 * lane + e] * silu_f(z[e]); ss += u[e] * u[e]; }
        const float r = rsqrtf(wave_sum(ss) * (1.f / 256.f) + EPS); const f32x4 gv = *(const f32x4*)(P->in[16] + g * 256 + 4 * lane);
        u32x2 w2; w2.x = pk2(u[0] * r * gv[0], u[1] * r * gv[1]); w2.y = pk2(u[2] * r * gv[2], u[3] * r * gv[3]);
        *(u32x2*)((bf16_t*)(P->ws + WS_MIXIN) + (size_t)(row0 + tt) * 1024 + g * 256 + 4 * lane) = w2;
    }
    __syncthreads();
}

__device__ __forceinline__ void swa_sample(CP P, LAS unsigned char* lds, int unit, int tid, int wave, int lane) {
    const int b = unit >> 1, kvh = unit & 1, row0 = TP + b * 4;
    LAS float* Kf = (LAS float*)lds;
    LAS float* Vf = Kf + 132 * 65;
    LAS float* qf = Vf + 132 * 64;
    LAS float* sc = qf + 16 * 65;
    const bf16_t* proj = (const bf16_t*)(P->ws + WS_PROJ);
    {
        f32x4 kq[5], vq[5];
#pragma unroll
        for (int it = 0; it < 5; ++it) {
            const int i4 = tid + 512 * it, kk = i4 >> 4, d4 = (i4 & 15) * 4; kq[it] = (f32x4){0.f, 0.f, 0.f, 0.f}; vq[it] = kq[it];
            if (i4 < 132 * 16) {
                if (kk < 128) { const size_t o = (size_t)((b * 128 + kk) * 2 + kvh) * 64 + d4; kq[it] = *(const f32x4*)(P->in[4] + o); vq[it] = *(const f32x4*)(P->in[5] + o); }
                else { const bf16_t* pr = proj + (size_t)(row0 + kk - 128) * NPROJ + kvh * 64 + d4; const u32x2 a = *(const u32x2*)(pr + 2048), c = *(const u32x2*)(pr + 2176);
                    kq[it] = (f32x4){__uint_as_float(a.x << 16), __uint_as_float(a.x & 0xffff0000u), __uint_as_float(a.y << 16), __uint_as_float(a.y & 0xffff0000u)};
                    vq[it] = (f32x4){__uint_as_float(c.x << 16), __uint_as_float(c.x & 0xffff0000u), __uint_as_float(c.y << 16), __uint_as_float(c.y & 0xffff0000u)}; }
            }
        }
#pragma unroll
        for (int it = 0; it < 5; ++it) {
            const int i4 = tid + 512 * it, kk = i4 >> 4, d4 = (i4 & 15) * 4;
            if (i4 < 132 * 16) { Kf[kk * 65 + d4] = kq[it][0]; Kf[kk * 65 + d4 + 1] = kq[it][1]; Kf[kk * 65 + d4 + 2] = kq[it][2]; Kf[kk * 65 + d4 + 3] = kq[it][3]; *(LAS f32x4*)(Vf + kk * 64 + d4) = vq[it]; }
        }
    }
    for (int kk_ = 0; kk_ < 2; ++kk_) { const int i = tid + 512 * kk_; const int r16 = i >> 6, d = i & 63, tt = r16 >> 2, r = r16 & 3;
        qf[r16 * 65 + d] = bf2f(proj[(size_t)(row0 + tt) * NPROJ + 1536 + (kvh * 4 + r) * 64 + d]); }
    __syncthreads();
    { const int r16 = tid & 15, kg = tid >> 4, tt = r16 >> 2;
      for (int j_ = 0; j_ < 5; ++j_) {
          const int kk = kg + 32 * j_; if (kk >= 132) continue;
          float s = 0.f;
#pragma unroll 16
          for (int d = 0; d < 64; ++d) s += qf[r16 * 65 + d] * Kf[kk * 65 + d];
          const bool ok = kk < 128 ? (kk >= tt + 1) : (kk - 128 <= tt);
          sc[r16 * 136 + kk] = ok ? s * 0.125f : -INFINITY;
      } }
    __syncthreads();
#pragma unroll
    for (int rr = 0; rr < 2; ++rr) {
        const int r16 = 2 * wave + rr; const float sink = P->in[17][kvh * 4 + (r16 & 3)];
        float v[3]; float mx = sink;
#pragma unroll
        for (int j = 0; j < 3; ++j) { const int kk = lane + 64 * j; v[j] = kk < 132 ? sc[r16 * 136 + kk] : -INFINITY; mx = fmaxf(mx, v[j]); }
        mx = wave_max(mx); float sum = 0.f;
#pragma unroll
        for (int j = 0; j < 3; ++j) { v[j] = __expf(v[j] - mx); sum += v[j]; }
        const float inv = 1.f / (wave_sum(sum) + __expf(sink - mx));
#pragma unroll
        for (int j = 0; j < 3; ++j) { const int kk = lane + 64 * j; if (kk < 132) sc[r16 * 136 + kk] = v[j] * inv; }
    }
    __syncthreads();
    { const int r16 = tid >> 5, d2 = (tid & 31) * 2, tt = r16 >> 2, r = r16 & 3; float o0 = 0.f, o1 = 0.f;
      for (int kk = 0; kk < 132; ++kk) { const float p = sc[r16 * 136 + kk]; o0 += p * Vf[kk * 64 + d2]; o1 += p * Vf[kk * 64 + d2 + 1]; }
      *(unsigned*)((bf16_t*)(P->ws + WS_MIXIN) + (size_t)(row0 + tt) * 1024 + 512 + (kvh * 4 + r) * 64 + d2) = pk2(o0, o1); }
    __syncthreads();
}

__device__ __forceinline__ void xattn_prompt(CP P, LAS unsigned char* lds, int unit, int tid, int wave, int lane) {
    const int b = unit >> 6, h = (unit >> 4) & 3, qb = unit & 15;
    const int fr = lane & 15, fq = lane >> 4;
    LAS bf16_t* KV = (LAS bf16_t*)lds;
    LAS bf16_t* Ps = (LAS bf16_t*)(lds + 256 * PK * 2) + wave * 16 * PV;
    const bf16_t* q2 = (const bf16_t*)(P->ws + WS_Q2); const bf16_t* mk = (const bf16_t*)(P->ws + WS_MK); const bf16_t* mvt = (const bf16_t*)(P->ws + WS_MVT);
    const int row = b * SEQ + qb * 128 + 16 * wave + fr;
    f32x4 s[16];
#pragma unroll
    for (int n = 0; n < 16; ++n) s[n] = (f32x4){0.f, 0.f, 0.f, 0.f};
    u32x4 tmp[4];
#define XLOADK(dcv) { _Pragma("unroll") for (int it = 0; it < 4; ++it) { const int ci = tid + 512 * it, m = ci >> 3, c8 = ci & 7; tmp[it] = *(const u32x4*)(mk + (size_t)(b * 256 + m) * 1024 + h * 256 + (dcv) * 64 + c8 * 8); } }
#define XLOADV(dcv) { _Pragma("unroll") for (int it = 0; it < 4; ++it) { const int ci = tid + 512 * it, d = ci >> 5, c = ci & 31; tmp[it] = *(const u32x4*)(mvt + (size_t)(h * 256 + (dcv) * 64 + d) * 2048 + b * 256 + c * 8); } }
    XLOADK(0)
    for (int dc = 0; dc < 4; ++dc) {
        bf16x8 qf[2];
#pragma unroll
        for (int ks = 0; ks < 2; ++ks) qf[ks] = *(const bf16x8*)(q2 + (size_t)row * 1024 + h * 256 + dc * 64 + ks * 32 + 8 * fq);
        __syncthreads();
#pragma unroll
        for (int it = 0; it < 4; ++it) { const int ci = tid + 512 * it, m = ci >> 3, c8 = ci & 7; *(LAS u32x4*)(KV + m * PK + c8 * 8) = tmp[it]; }
        if (dc < 3) XLOADK(dc + 1) else XLOADV(0)
        __syncthreads();
        mma_areg<16, 2, 0, 2>(s, qf, KV, PK, lane);
    }
    float mx = -INFINITY;
#pragma unroll
    for (int n = 0; n < 16; ++n)
#pragma unroll
        for (int e = 0; e < 4; ++e) { s[n][e] *= 0.0625f; mx = fmaxf(mx, s[n][e]); }
    mx = fmaxf(mx, __shfl_xor(mx, 16)); mx = fmaxf(mx, __shfl_xor(mx, 32));
    float sum = 0.f;
#pragma unroll
    for (int n = 0; n < 16; ++n)
#pragma unroll
        for (int e = 0; e < 4; ++e) { const float ev = __expf(s[n][e] - mx); s[n][e] = ev; sum += ev; }
    sum += __shfl_xor(sum, 16); sum += __shfl_xor(sum, 32);
    const float inv = 1.f / sum;
    bf16x8 pf[8];
#pragma unroll
    for (int ks = 0; ks < 8; ++ks) { u32x4 w; w.x = pk2(s[2 * ks][0] * inv, s[2 * ks][1] * inv); w.y = pk2(s[2 * ks][2] * inv, s[2 * ks][3] * inv);
        w.z = pk2(s[2 * ks + 1][0] * inv, s[2 * ks + 1][1] * inv); w.w = pk2(s[2 * ks + 1][2] * inv, s[2 * ks + 1][3] * inv); pf[ks] = __builtin_bit_cast(bf16x8, w); }
    for (int dc = 0; dc < 4; ++dc) {
        __syncthreads();
#pragma unroll
        for (int it = 0; it < 4; ++it) { const int ci = tid + 512 * it, d = ci >> 5, c = ci & 31; *(LAS u32x4*)(KV + d * PV + c * 8) = tmp[it]; }
        if (dc < 3) XLOADV(dc + 1)
        __syncthreads();
        f32x4 o[4];
#pragma unroll
        for (int n = 0; n < 4; ++n) o[n] = (f32x4){0.f, 0.f, 0.f, 0.f};
#pragma unroll
        for (int ks = 0; ks < 8; ++ks) {
#pragma unroll
            for (int n = 0; n < 4; ++n) {
                const LAS bf16_t* vp = KV + (16 * n + fr) * PV + 32 * ks + 4 * fq;
                const u32x2 a0 = *(const LAS u32x2*)vp, a1 = *(const LAS u32x2*)(vp + 16);
                const u32x4 av = (u32x4){a0.x, a0.y, a1.x, a1.y};
                o[n] = __builtin_amdgcn_mfma_f32_16x16x32_bf16(__builtin_bit_cast(bf16x8, av), pf[ks], o[n], 0, 0, 0);
            }
            __builtin_amdgcn_sched_barrier(0);
        }
        bf16_t* op = (bf16_t*)(P->ws + WS_OX) + (size_t)row * 1024 + h * 256 + dc * 64 + 4 * fq;
#pragma unroll
        for (int n = 0; n < 4; ++n) { u32x2 w2; w2.x = pk2(o[n][0], o[n][1]); w2.y = pk2(o[n][2], o[n][3]); *(u32x2*)(op + 16 * n) = w2; }
    }
#undef XLOADK
#undef XLOADV
    __syncthreads();
}

__device__ __forceinline__ void xattn_prompt2(CP P, LAS unsigned char* lds, int unit, int tid, int wave, int lane) {
    const int b = unit >> 5, h = (unit >> 3) & 3, qb = unit & 7;
    const int fr = lane & 15, fq = lane >> 4;
    LAS bf16_t* KV = (LAS bf16_t*)lds;
    const bf16_t* q2 = (const bf16_t*)(P->ws + WS_Q2); const bf16_t* mk = (const bf16_t*)(P->ws + WS_MK); const bf16_t* mvt = (const bf16_t*)(P->ws + WS_MVT);
    const int row = b * SEQ + qb * 256 + 32 * wave + fr;
    f32x4 s[2][16];
#pragma unroll
    for (int mt = 0; mt < 2; ++mt)
#pragma unroll
        for (int n = 0; n < 16; ++n) s[mt][n] = (f32x4){0.f, 0.f, 0.f, 0.f};
    u32x4 tmp[4];
#define XLOADK(dcv) { _Pragma("unroll") for (int it = 0; it < 4; ++it) { const int ci = tid + 512 * it, m = ci >> 3, c8 = ci & 7; tmp[it] = *(const u32x4*)(mk + (size_t)(b * 256 + m) * 1024 + h * 256 + (dcv) * 64 + c8 * 8); } }
#define XLOADV(dcv) { _Pragma("unroll") for (int it = 0; it < 4; ++it) { const int ci = tid + 512 * it, d = ci >> 5, c = ci & 31; tmp[it] = *(const u32x4*)(mvt + (size_t)(h * 256 + (dcv) * 64 + d) * 2048 + b * 256 + c * 8); } }
    XLOADK(0)
    for (int dc = 0; dc < 4; ++dc) {
        bf16x8 qf[2][2];
#pragma unroll
        for (int mt = 0; mt < 2; ++mt)
#pragma unroll
            for (int ks = 0; ks < 2; ++ks) qf[mt][ks] = *(const bf16x8*)(q2 + (size_t)(row + 16 * mt) * 1024 + h * 256 + dc * 64 + ks * 32 + 8 * fq);
        __syncthreads();
#pragma unroll
        for (int it = 0; it < 4; ++it) { const int ci = tid + 512 * it, m = ci >> 3, c8 = ci & 7; *(LAS u32x4*)(KV + m * PK + c8 * 8) = tmp[it]; }
        if (dc < 3) XLOADK(dc + 1)
        __syncthreads();
#pragma unroll
        for (int ks = 0; ks < 2; ++ks) {
#pragma unroll
            for (int n = 0; n < 16; ++n) {
                const bf16x8 bfr = *(const LAS bf16x8*)(KV + (16 * n + fr) * PK + ks * 32 + 8 * fq);
                s[0][n] = __builtin_amdgcn_mfma_f32_16x16x32_bf16(bfr, qf[0][ks], s[0][n], 0, 0, 0);
                s[1][n] = __builtin_amdgcn_mfma_f32_16x16x32_bf16(bfr, qf[1][ks], s[1][n], 0, 0, 0);
                if ((n & 3) == 3) __builtin_amdgcn_sched_barrier(0);
            }
        }
    }
    bf16x8 pf[2][8];
#pragma unroll
    for (int mt = 0; mt < 2; ++mt) {
        float mx = -INFINITY;
#pragma unroll
        for (int n = 0; n < 16; ++n)
#pragma unroll
            for (int e = 0; e < 4; ++e) { s[mt][n][e] *= 0.0625f; mx = fmaxf(mx, s[mt][n][e]); }
        mx = fmaxf(mx, __shfl_xor(mx, 16)); mx = fmaxf(mx, __shfl_xor(mx, 32));
        float sum = 0.f;
#pragma unroll
        for (int n = 0; n < 16; ++n)
#pragma unroll
            for (int e = 0; e < 4; ++e) { const float ev = __expf(s[mt][n][e] - mx); s[mt][n][e] = ev; sum += ev; }
        sum += __shfl_xor(sum, 16); sum += __shfl_xor(sum, 32);
        const float inv = 1.f / sum;
#pragma unroll
        for (int ks = 0; ks < 8; ++ks) { u32x4 w; w.x = pk2(s[mt][2 * ks][0] * inv, s[mt][2 * ks][1] * inv); w.y = pk2(s[mt][2 * ks][2] * inv, s[mt][2 * ks][3] * inv);
            w.z = pk2(s[mt][2 * ks + 1][0] * inv, s[mt][2 * ks + 1][1] * inv); w.w = pk2(s[mt][2 * ks + 1][2] * inv, s[mt][2 * ks + 1][3] * inv); pf[mt][ks] = __builtin_bit_cast(bf16x8, w); }
    }
    XLOADV(0)
    for (int dc = 0; dc < 4; ++dc) {
        __syncthreads();
#pragma unroll
        for (int it = 0; it < 4; ++it) { const int ci = tid + 512 * it, d = ci >> 5, c = ci & 31; *(LAS u32x4*)(KV + d * PV + c * 8) = tmp[it]; }
        if (dc < 3) XLOADV(dc + 1)
        __syncthreads();
        f32x4 o[2][4];
#pragma unroll
        for (int mt = 0; mt < 2; ++mt)
#pragma unroll
            for (int n = 0; n < 4; ++n) o[mt][n] = (f32x4){0.f, 0.f, 0.f, 0.f};
#pragma unroll
        for (int ks = 0; ks < 8; ++ks) {
#pragma unroll
            for (int n = 0; n < 4; ++n) {
                const LAS bf16_t* vp = KV + (16 * n + fr) * PV + 32 * ks + 4 * fq;
                const u32x2 a0 = *(const LAS u32x2*)vp, a1 = *(const LAS u32x2*)(vp + 16);
                const bf16x8 av = __builtin_bit_cast(bf16x8, (u32x4){a0.x, a0.y, a1.x, a1.y});
                o[0][n] = __builtin_amdgcn_mfma_f32_16x16x32_bf16(av, pf[0][ks], o[0][n], 0, 0, 0);
                o[1][n] = __builtin_amdgcn_mfma_f32_16x16x32_bf16(av, pf[1][ks], o[1][n], 0, 0, 0);
            }
            __builtin_amdgcn_sched_barrier(0);
        }
        asm volatile("s_nop 7\n\ts_nop 7\n\ts_nop 7" ::: "memory");
#pragma unroll
        for (int mt = 0; mt < 2; ++mt) {
            bf16_t* op = (bf16_t*)(P->ws + WS_OX) + (size_t)(row + 16 * mt) * 1024 + h * 256 + dc * 64 + 4 * fq;
#pragma unroll
            for (int n = 0; n < 4; ++n) { u32x2 w2; w2.x = pk2(o[mt][n][0], o[mt][n][1]); w2.y = pk2(o[mt][n][2], o[mt][n][3]); *(u32x2*)(op + 16 * n) = w2; }
        }
    }
#undef XLOADK
#undef XLOADV
    __syncthreads();
}

__device__ __forceinline__ void xattn_sample(CP P, LAS unsigned char* lds, int unit, int tid, int wave, int lane) {
    const int b = unit >> 2, h = unit & 3, row0 = TP + b * 4;
    LAS float* sc = (LAS float*)lds;
    LAS float* red = sc + 1024;
    const bf16_t* q2 = (const bf16_t*)(P->ws + WS_Q2);
    const float* kb = P->in[6] + ((size_t)(b * 256) * 4 + h) * 256;
    const float* vb = P->in[7] + ((size_t)(b * 256) * 4 + h) * 256 + 4 * lane;
    {
        const int fr = lane & 15, fq = lane >> 4;
        bf16x8 qf[8];
#pragma unroll
        for (int ks = 0; ks < 8; ++ks) { u32x4 z = (u32x4){0u, 0u, 0u, 0u}; if (fr < 4) z = *(const u32x4*)(q2 + (size_t)(row0 + fr) * 1024 + h * 256 + ks * 32 + 8 * fq); qf[ks] = __builtin_bit_cast(bf16x8, z); }
#pragma unroll
        for (int mt = 0; mt < 2; ++mt) {
            const int m0 = 32 * wave + 16 * mt; const float* kr = kb + (size_t)(m0 + fr) * 1024 + 8 * fq;
            f32x4 kv[16];
#pragma unroll
            for (int ks = 0; ks < 8; ++ks) { kv[2 * ks] = __builtin_nontemporal_load((const f32x4*)(kr + ks * 32)); kv[2 * ks + 1] = __builtin_nontemporal_load((const f32x4*)(kr + ks * 32 + 4)); }
            f32x4 acc = (f32x4){0.f, 0.f, 0.f, 0.f};
#pragma unroll
            for (int ks = 0; ks < 8; ++ks) { u32x4 a; a.x = pk2(kv[2 * ks][0], kv[2 * ks][1]); a.y = pk2(kv[2 * ks][2], kv[2 * ks][3]); a.z = pk2(kv[2 * ks + 1][0], kv[2 * ks + 1][1]); a.w = pk2(kv[2 * ks + 1][2], kv[2 * ks + 1][3]);
                acc = __builtin_amdgcn_mfma_f32_16x16x32_bf16(__builtin_bit_cast(bf16x8, a), qf[ks], acc, 0, 0, 0); }
            if (fr < 4) *(LAS f32x4*)(sc + fr * 256 + m0 + 4 * fq) = acc * 0.0625f;
        }
    }
    __syncthreads();
    if (wave < 4) {
        float v[4]; float mx = -INFINITY;
#pragma unroll
        for (int j = 0; j < 4; ++j) { v[j] = sc[wave * 256 + lane + 64 * j]; mx = fmaxf(mx, v[j]); }
        mx = wave_max(mx); float sum = 0.f;
#pragma unroll
        for (int j = 0; j < 4; ++j) { v[j] = __expf(v[j] - mx); sum += v[j]; }
        const float inv = 1.f / wave_sum(sum);
#pragma unroll
        for (int j = 0; j < 4; ++j) sc[wave * 256 + lane + 64 * j] = v[j] * inv;
    }
    __syncthreads();
    f32x4 acc[4];
#pragma unroll
    for (int tt = 0; tt < 4; ++tt) acc[tt] = (f32x4){0.f, 0.f, 0.f, 0.f};
#pragma unroll 8
    for (int i = 0; i < 32; ++i) {
        const int m = 32 * wave + i; const f32x4 v = __builtin_nontemporal_load((const f32x4*)(vb + (size_t)m * 1024));
#pragma unroll
        for (int tt = 0; tt < 4; ++tt) acc[tt] += v * sc[tt * 256 + m];
    }
#pragma unroll
    for (int tt = 0; tt < 4; ++tt) *(LAS f32x4*)(red + (wave * 4 + tt) * 256 + 4 * lane) = acc[tt];
    __syncthreads();
    for (int kk_ = 0; kk_ < 2; ++kk_) { const int i = tid + 512 * kk_; float s = 0.f;
#pragma unroll
        for (int w = 0; w < 8; ++w) s += red[w * 1024 + i];
        const int tt = i >> 8, d = i & 255; ((bf16_t*)(P->ws + WS_OX))[(size_t)(row0 + tt) * 1024 + h * 256 + d] = f2bf(s); }
    __syncthreads();
}

__device__ __forceinline__ void skinny_gemm(const bf16_t* A, const bf16_t* Wt, bf16_t* C, int K, int bid, int G, int wave, int lane) {
    const int fr = lane & 15, fq = lane >> 4;
    for (int t = bid; t < 256; t += G) {
        const int r0 = TP + 32 * (t & 15) + 16 * (wave & 1), c0 = 64 * (t >> 4) + 16 * (wave >> 1);
        const bf16_t* ap = A + (size_t)(r0 + fr) * K + 8 * fq; const bf16_t* bp = Wt + (size_t)(c0 + fr) * K + 8 * fq;
        f32x4 acc = (f32x4){0.f, 0.f, 0.f, 0.f};
        for (int kb = 0; kb < K; kb += 512) {
            bf16x8 av[16], bv[16];
#pragma unroll
            for (int j = 0; j < 16; ++j) { av[j] = *(const bf16x8*)(ap + kb + 32 * j); bv[j] = *(const bf16x8*)(bp + kb + 32 * j); }
#pragma unroll
            for (int j = 0; j < 16; ++j) acc = __builtin_amdgcn_mfma_f32_16x16x32_bf16(bv[j], av[j], acc, 0, 0, 0);
        }
        __builtin_amdgcn_sched_barrier(0);
        asm volatile("s_nop 7\n\ts_nop 7\n\ts_nop 7" ::: "memory");
        u32x2 w; w.x = pk2(acc[0], acc[1]); w.y = pk2(acc[2], acc[3]);
        *(u32x2*)(C + (size_t)(r0 + fr) * 1024 + c0 + 4 * fq) = w;
    }
}

__device__ __forceinline__ void copy_caches(CP P, int part, int t0_, int NT_) {
    unsigned char* ws = P->ws; const bf16_t* proj = (const bf16_t*)(ws + WS_PROJ);
    if (part == 0) {
        for (int base_ = 0; base_ < 2048 * 1024 / 4; base_ += 4 * NT_) {
            u32x2 a[4], c[4];
#pragma unroll
            for (int k = 0; k < 4; ++k) { const int i = base_ + k * NT_ + t0_; a[k] = (u32x2){0u, 0u}; c[k] = a[k]; if (i < 2048 * 1024 / 4) { a[k] = ((const u32x2*)(ws + WS_MK))[i]; c[k] = ((const u32x2*)(ws + WS_MV))[i]; } }
#pragma unroll
            for (int k = 0; k < 4; ++k) { const int i = base_ + k * NT_ + t0_; if (i < 2048 * 1024 / 4) {
                ((f32x4*)(P->out + O_PMK))[i] = (f32x4){__uint_as_float(a[k].x << 16), __uint_as_float(a[k].x & 0xffff0000u), __uint_as_float(a[k].y << 16), __uint_as_float(a[k].y & 0xffff0000u)};
                ((f32x4*)(P->out + O_PMV))[i] = (f32x4){__uint_as_float(c[k].x << 16), __uint_as_float(c[k].x & 0xffff0000u), __uint_as_float(c[k].y << 16), __uint_as_float(c[k].y & 0xffff0000u)}; } }
        }
        for (int base_ = 0; base_ < 8 * 128 * 128; base_ += NT_) { const int i = base_ + t0_; if (i >= 8 * 128 * 128) continue; const int b = i >> 14, r = (i >> 7) & 127, cidx = i & 127;
            const bf16_t* pr = proj + (size_t)(b * SEQ + 1920 + r) * NPROJ + cidx; P->out[O_PWK + i] = bf2f(pr[2048]); P->out[O_PWV + i] = bf2f(pr[2176]); }
        for (int base_ = 0; base_ < 128 * 4 * 128; base_ += NT_) { const int j = base_ + t0_; if (j >= 128 * 4 * 128) continue; const int b = j >> 9, t = (j >> 7) & 3, cidx = j & 127;
            const bf16_t* pr = proj + (size_t)(TP + b * 4 + t) * NPROJ + cidx; const size_t o = (size_t)(b * 128 + 124 + t) * 128 + cidx; P->out[O_SWK + o] = bf2f(pr[2048]); P->out[O_SWV + o] = bf2f(pr[2176]); }
    } else {
        for (int base_ = 0; base_ < 128 * 124 * 32; base_ += 4 * NT_) {
            f32x4 kv[4], vv[4];
#pragma unroll
            for (int k = 0; k < 4; ++k) { const int j = base_ + k * NT_ + t0_; kv[k] = (f32x4){0.f, 0.f, 0.f, 0.f}; vv[k] = kv[k];
                if (j < 128 * 124 * 32) { const int b = j / (124 * 32), rem = j - b * (124 * 32); const size_t i = (size_t)b * 16384 + 4 * rem; kv[k] = __builtin_nontemporal_load((const f32x4*)(P->in[4] + i + 512)); vv[k] = __builtin_nontemporal_load((const f32x4*)(P->in[5] + i + 512)); } }
#pragma unroll
            for (int k = 0; k < 4; ++k) { const int j = base_ + k * NT_ + t0_;
                if (j < 128 * 124 * 32) { const int b = j / (124 * 32), rem = j - b * (124 * 32); const size_t i = (size_t)b * 16384 + 4 * rem; *(f32x4*)(P->out + O_SWK + i) = kv[k]; *(f32x4*)(P->out + O_SWV + i) = vv[k]; } }
        }
    }
}

#define XB_TMO      128
#define XB_XCNT(j)  (256  + 64 * (j))
#define XB_XSUB(j)  (1280 + 64 * (j))
#define XB_XGEN(j)  (2304 + 64 * (j))
#define XB_TOP      3328
#define XB_TOPGEN   3392
#define XCD_BAR_WORDS 3456
#define XB_SPIN_CAP (1u << 18)

__device__ __forceinline__ unsigned xb_ld(unsigned* p)              { return __hip_atomic_load(p, __ATOMIC_RELAXED, __HIP_MEMORY_SCOPE_AGENT); }
__device__ __forceinline__ unsigned xb_add(unsigned* p, unsigned v) { return __hip_atomic_fetch_add(p, v, __ATOMIC_RELAXED, __HIP_MEMORY_SCOPE_AGENT); }
__device__ __forceinline__ unsigned xb_xcc_id() { return (unsigned)__builtin_amdgcn_s_getreg((3 << 11) | 20) & 0xFu; }
#define XB_SPIN(cond, bar) do { unsigned _sp = 0; while (cond) { __builtin_amdgcn_s_sleep(1); \
    if ((++_sp & 255u) == 0u) { if (xb_ld(&(bar)[XB_TMO])) break; if (_sp > XB_SPIN_CAP) { atomicAdd(&(bar)[XB_TMO], 1u); break; } } } } while (0)

struct XcdBarrier {
    unsigned* bar; unsigned x;
    volatile LAS unsigned* st;
};

__device__ __forceinline__ XcdBarrier xcd_barrier_post(unsigned* bar, volatile LAS unsigned* st) {
    XcdBarrier b; b.bar = bar; b.x = xb_xcc_id(); b.st = st;
    if (threadIdx.x == 0) (void)xb_add(&bar[XB_XCNT(b.x)], 1u);
    return b;
}
__device__ __forceinline__ void xcd_barrier_complete(unsigned* bar, unsigned x, unsigned& nloc, unsigned& nx) {
    const unsigned G = gridDim.x * gridDim.y * gridDim.z;
    unsigned sum, cnt, mine, sp = 0u;
    for (;;) {
        sum = 0u; cnt = 0u; mine = 0u;
#pragma unroll
        for (unsigned j = 0; j < 16; ++j) { const unsigned c = xb_ld(&bar[XB_XCNT(j)]); sum += c; cnt += (c > 0u) ? 1u : 0u; mine = (j == x) ? c : mine; }
        if (sum == G) break;
        __builtin_amdgcn_s_sleep(1);
        if ((++sp & 255u) == 0u) { if (xb_ld(&bar[XB_TMO])) break; if (sp > XB_SPIN_CAP) { atomicAdd(&bar[XB_TMO], 1u); break; } }
    }
    nloc = mine > 0u ? mine : 1u; nx = cnt > 0u ? cnt : 1u;
}

__device__ __forceinline__ void xcd_barrier(const XcdBarrier& b) {
    asm volatile("s_waitcnt vmcnt(0)" ::: "memory");
    __syncthreads();
    if (threadIdx.x == 0) {
        unsigned* bar = b.bar;
        __builtin_amdgcn_s_waitcnt(0);
        unsigned nloc = b.st[0], nx = b.st[1];
        if (nloc == 0u) { xcd_barrier_complete(bar, b.x, nloc, nx); b.st[0] = nloc; b.st[1] = nx; }
        const unsigned old = xb_add(&bar[XB_XSUB(b.x)], 1u);
        const unsigned gen = old / nloc;
        if (old + 1u == (gen + 1u) * nloc) {
            __builtin_amdgcn_fence(__ATOMIC_RELEASE, "agent");
            asm volatile("s_waitcnt vmcnt(0)" ::: "memory");
            const unsigned og = xb_add(&bar[XB_TOP], 1u);
            const unsigned tg = og / nx;
            if (og + 1u == (tg + 1u) * nx) xb_add(&bar[XB_TOPGEN], 1u);
            else XB_SPIN(xb_ld(&bar[XB_TOPGEN]) == tg, bar);
            __builtin_amdgcn_fence(__ATOMIC_ACQUIRE, "agent");
            xb_add(&bar[XB_XGEN(b.x)], 1u);
            asm volatile("s_waitcnt vmcnt(0)" ::: "memory");
        } else {
            XB_SPIN(xb_ld(&bar[XB_XGEN(b.x)]) == gen, bar);
            __builtin_amdgcn_fence(__ATOMIC_ACQUIRE, "agent");
            asm volatile("s_waitcnt vmcnt(0)" ::: "memory");
        }
    }
    __syncthreads();
}

constexpr int NPHASE = 13;
#ifndef SKN
#define SKN 2
#endif
#ifndef MK_MULTI
#define MK_MULTI 0
#endif
#ifndef TSW
#define TSW 0
#endif
__global__ void __launch_bounds__(512, 2) mk_fwd(Params P_) {
    CP P = (CP)__builtin_amdgcn_kernarg_segment_ptr(); asm volatile("" : "+s"(P));
    extern __shared__ __attribute__((aligned(16))) unsigned char lds_raw[];
    LAS unsigned char* lds = (LAS unsigned char*)lds_raw;
    const int G = gridDim.x, bid = blockIdx.x;
    volatile LAS unsigned* bar_st = (volatile LAS unsigned*)(lds + LDS_BYTES - 16);
    if (threadIdx.x < 4) bar_st[threadIdx.x] = 0u;
    __syncthreads();
    XcdBarrier xbar = xcd_barrier_post((unsigned*)P_.ws, bar_st);
#define TLW CP P = (CP)__builtin_amdgcn_kernarg_segment_ptr(); asm volatile("" : "+s"(P)); unsigned char* ws = P->ws; (void)ws; int tid = threadIdx.x; asm volatile("" : "+v"(tid)); const int lane = tid & 63, wave = __builtin_amdgcn_readfirstlane(tid >> 6); const int gw = bid * 8 + wave, NGW = G * 8; (void)gw; (void)NGW; (void)lane;
    unsigned char* ws = P->ws;
    const int lo = P->ph_lo, hi = P->ph_hi;
#ifndef PHMASK
#define PHMASK 0xffff
#endif
#define IN(k) (((PHMASK >> (k)) & 1) && lo <= (k) && (k) < hi)
#ifndef REP_PHASE
#define REP_PHASE -1
#endif
#define NREP(k) ((k) == REP_PHASE ? 2 : 1)
#define SEAM(k) do { if (IN(k) && IN((k) + 1)) xcd_barrier(xbar); } while (0)
    bf16_t* R = (bf16_t*)(ws + WS_R);
#ifdef DUMP_BUF
    if (lo == 100) { TLW const bf16_t* src = (const bf16_t*)(ws + DUMP_BUF);
        for (size_t i = (size_t)bid * 512 + tid; i < (size_t)TT * 1024; i += (size_t)G * 512) { float v = bf2f(src[i]); if (!(fabsf(v) < 1e30f)) v = 12345.f; P->out[i] = v; } }
#endif

    if (IN(0)) for (int rep = 0; rep < NREP(0); ++rep) { TLW phase_prologue(P, lds, gw, NGW, wave, lane); }
    SEAM(0);
    if (IN(1)) {
        pg8::Gemm g{R, R, 0, 0, 1024}; Order S{754, G, bid, 0, 0};
        EpiP1 E{(bf16_t*)(ws + WS_PROJ), (bf16_t*)(ws + WS_MK), (bf16_t*)(ws + WS_MV), (bf16_t*)(ws + WS_MVT), (bf16_t*)(ws + WS_KVT)};
        pg8::gemm_phase<EpiP1, Order, true, true>(lds, g, S, E);
    }
    SEAM(1);
    if (IN(2)) for (int rep = 0; rep < NREP(2); ++rep) {
        TLW
        if (!(TSW & 4)) for (int u = bid; u < 256; u += G) ssd_pass_a(P, lds, u, tid, wave, lane);
        if (!(TSW & 8)) for (int u = bid; u < 256; u += G) swa_prompt(P, lds, u, tid, wave, lane);
        if (!(TSW & 16)) for (int u = bid; u < 256; u += G) ssd_sample(P, lds, u, tid, wave, lane);
        if (!(TSW & 32)) for (int u = bid; u < 256; u += G) swa_sample(P, lds, u, tid, wave, lane);
    }
    SEAM(2);
    if (IN(3)) { { TLW ssd_state_scan(P, bid, G, tid); } xcd_barrier(xbar); }
    if (IN(3)) for (int rep = 0; rep < NREP(3); ++rep) { TLW for (int u = bid; u < 256; u += G) ssd_pass_b(P, lds, u, tid, wave, lane); }
    SEAM(3);
    if (IN(4)) for (int rep = 0; rep < NREP(4); ++rep) {
        pg8::Gemm g{(const bf16_t*)(ws + WS_MIXIN), (const bf16_t*)(ws + WS_WOUT), TT, 1024, 1024}; Order S{272, G, bid, 3, 16};
        EpiBf E{(bf16_t*)(ws + WS_CB16), 1024, 1.f, (float*)(ws + WS_SPLIT)};
        pg8::gemm_phase<EpiBf, Order, true, true>(lds, g, S, E);
        if (bid + G >= 272 && rep == 0) { TLW const int nb_ = G - (272 - G > 0 ? 272 - G : 0); tr_items(P, lds, 1, (bid - (G - nb_)) * 8 + wave, nb_ * 8, wave, lane); }
        if ((SKN >> 0) & 1) { TLW skinny_gemm((const bf16_t*)(ws + WS_MIXIN), (const bf16_t*)(ws + WS_WOUT), (bf16_t*)(ws + WS_CB16), 1024, bid, G, wave, lane); }
    }
    SEAM(4);
#ifdef SYNC_EXTRA
    for (int r_ = 0; r_ < SYNC_EXTRA; ++r_) cg::this_grid().sync();
#endif
    if (IN(5)) for (int rep = 0; rep < NREP(5); ++rep) { TLW phase_resid(P, 0, gw, NGW, lane); }
    SEAM(5);
    if (IN(6)) {
        pg8::Gemm g{(const bf16_t*)(ws + WS_H0), (const bf16_t*)(ws + WS_WXQ), TT, 1024, 1024}; Order S{256, G, bid, 1, 4};
        EpiBf E{(bf16_t*)(ws + WS_Q2), 1024, 1.f, nullptr};
        pg8::gemm_phase<EpiBf, Order, true, true>(lds, g, S, E);
        if ((SKN >> 1) & 1) { TLW skinny_gemm((const bf16_t*)(ws + WS_H0), (const bf16_t*)(ws + WS_WXQ), (bf16_t*)(ws + WS_Q2), 1024, bid, G, wave, lane); }
    }
    SEAM(6);
    if (IN(7)) for (int rep = 0; rep < NREP(7); ++rep) {
        TLW
        if ((bid >> 3) & 1) { for (int u = bid; u < 256; u += G) xattn_prompt2(P, lds, u, tid, wave, lane); }
        for (int u = bid; u < 512; u += G) xattn_sample(P, lds, u, tid, wave, lane);
        if (!((bid >> 3) & 1)) { for (int u = bid; u < 256; u += G) xattn_prompt2(P, lds, u, tid, wave, lane); }
    }
    SEAM(7);
    if (IN(8)) {
        pg8::Gemm g{(const bf16_t*)(ws + WS_OX), (const bf16_t*)(ws + WS_WXO), TT, 1024, 1024}; Order S{272, G, bid, 3, 16};
        EpiBf E{(bf16_t*)(ws + WS_CB16), 1024, 1.f, (float*)(ws + WS_SPLIT) + 8 * 512 * 1024};
        pg8::gemm_phase<EpiBf, Order, true, true>(lds, g, S, E);
        { TLW const int first_ = G > 16 ? 16 : 0; if (bid >= first_) copy_caches(P, 0, (bid - first_) * 512 + tid, (G - first_) * 512); }
        if ((SKN >> 2) & 1) { TLW skinny_gemm((const bf16_t*)(ws + WS_OX), (const bf16_t*)(ws + WS_WXO), (bf16_t*)(ws + WS_CB16), 1024, bid, G, wave, lane); }
    }
    SEAM(8);
    if (IN(9)) { TLW phase_resid(P, 1, gw, NGW, lane); }
    SEAM(9);
    if (IN(10)) for (int rep = 0; rep < NREP(10); ++rep) {
        pg8::Gemm g{(const bf16_t*)(ws + WS_H0), (const bf16_t*)(ws + WS_WGU), TT, 2 * DFF, 1024}; Order S{66 * 22, G, bid, 1, 22};
        EpiGU E{(bf16_t*)(ws + WS_ACT)};
        pg8::gemm_phase<EpiGU, Order, true, true>(lds, g, S, E);
    }
    SEAM(10);
    if (IN(11)) for (int rep = 0; rep < NREP(11); ++rep) {
        pg8::Gemm g{(const bf16_t*)(ws + WS_ACT), (const bf16_t*)(ws + WS_WDN), TT, 1024, DFF}; Order S{288, G, bid, 2, 44};
        EpiBf E{(bf16_t*)(ws + WS_CB16), 1024, 1.f, (float*)(ws + WS_SPLIT) + 12 * 512 * 1024};
        pg8::gemm_phase<EpiBf, Order, true, true>(lds, g, S, E);
        if (rep == 0) { TLW const int first_ = G > 32 ? 32 : 0; if (bid >= first_) copy_caches(P, 1, (bid - first_) * 512 + tid, (G - first_) * 512); }
        if ((SKN >> 3) & 1) { TLW skinny_gemm((const bf16_t*)(ws + WS_ACT), (const bf16_t*)(ws + WS_WDN), (bf16_t*)(ws + WS_CB16), DFF, bid, G, wave, lane); }
    }
    SEAM(11);
    if (IN(12)) { TLW phase_resid(P, 2, gw, NGW, lane); }
#undef IN
#undef SEAM
}

#ifndef MK_MULTI
#define MK_MULTI 0
#endif
#ifndef NPH_RUN
#define NPH_RUN 13
#endif
extern "C" void kernel_launch(void* const* d_in, const int* in_sizes, int n_in, void* d_out, int out_size, void* d_ws, size_t ws_size, hipStream_t stream) {
    static int grid = 0;
    if (grid == 0) {
        if (n_in != 32 || ws_size < WS_END) { fprintf(stderr, "kernel_launch: n_in %d ws %zu (need %zu)\n", n_in, ws_size, (size_t)WS_END); grid = -1; return; }
        int dev = 0, cus = 0, per_cu = 0;
        hipGetDevice(&dev); hipDeviceGetAttribute(&cus, hipDeviceAttributeMultiprocessorCount, dev);
        hipFuncSetAttribute((const void*)mk_fwd, hipFuncAttributeMaxDynamicSharedMemorySize, LDS_BYTES);
        hipOccupancyMaxActiveBlocksPerMultiprocessor(&per_cu, (const void*)mk_fwd, 512, LDS_BYTES);
        if (per_cu < 1) { fprintf(stderr, "kernel_launch: occupancy query says %d blocks per CU\n", per_cu); per_cu = 1; }
        grid = cus;
        (void)hipGetLastError();
    }
    if (grid < 0) return;
    (void)hipMemsetAsync(d_ws, 0, 16384, stream);
    Params p{};
    for (int i = 0; i < 32; ++i) p.in[i] = (const float*)d_in[i];
    p.out = (float*)d_out; p.ws = (unsigned char*)d_ws;
#if MK_MULTI
    for (int ph = 0; ph < NPH_RUN; ++ph) { p.ph_lo = ph; p.ph_hi = ph + 1; hipLaunchKernelGGL(mk_fwd, dim3(grid), dim3(512), LDS_BYTES, stream, p); }
#ifdef DUMP_BUF
    p.ph_lo = 100; p.ph_hi = 100; hipLaunchKernelGGL(mk_fwd, dim3(grid), dim3(512), LDS_BYTES, stream, p);
#endif
#else
    p.ph_lo = 0; p.ph_hi = NPHASE;
    void* args[] = {&p};
    hipError_t e = hipLaunchCooperativeKernel((const void*)mk_fwd, dim3(grid), dim3(512), args, LDS_BYTES, stream);
    if (e != hipSuccess) fprintf(stderr, "cooperative launch failed: %s (grid %d)\n", hipGetErrorString(e), grid);
#endif
}
```

```cpp
#include <hip/hip_runtime.h>
#include <hip/hip_cooperative_groups.h>
#include <cstdio>
#include <cstdint>
namespace cg = cooperative_groups;
namespace pg8 {
#define PG8_LAS __attribute__((address_space(3)))
typedef unsigned short bf16_t;
typedef short bf16x8 __attribute__((ext_vector_type(8)));
typedef float f32x4 __attribute__((ext_vector_type(4)));
typedef unsigned u32x4 __attribute__((ext_vector_type(4)));
constexpr int BM = 256, BK = 64, HALF = 128, HTB = HALF * BK * 2  , STAGE_BYTES = 8 * HTB, NXCD = 8, WGM = 8;

__host__ __device__ __forceinline__ int lds_byte(int r, int c) { const int st = (r >> 4) * 2 + (c >> 5), rr = r & 15, cc = c & 31, ob = rr * 64 + cc * 2; return st * 1024 + (ob ^ (((ob >> 9) & 1) << 5)); }
__host__ __device__ __forceinline__ void stage_rc(int b, int& R, int& C) { const int st = b / 1024, sb = b % 1024, swz = sb ^ (((sb >> 9) & 1) << 5); R = (st >> 1) * 16 + swz / 64; C = (st & 1) * 32 + (swz % 64) / 2; }
__host__ __device__ __forceinline__ int perm32(int rho) { const int n = rho >> 4, i = rho & 15; return 8 * (i >> 2) + 4 * n + (i & 3); }

struct Unit { int pm, pn, kofs, nt, q; };
struct Gemm { const bf16_t* A; const bf16_t* Bt; int M, N, K; };

struct StaticOrder {
    int nM, nN, nwg, G, c;
    __host__ __device__ void init(int M, int N, int G_, int c_) { nM = M / BM; nN = N / BM; nwg = nM * nN; G = G_; c = c_; }
    __host__ __device__ bool next(int i, Unit& u) const {
        const long L = (long)i * G + c; if (L >= nwg) return false;
        int wgid = (int)L; { const int q = nwg / NXCD, r = nwg % NXCD, xcd = wgid % NXCD, off = wgid / NXCD; wgid = (xcd < r ? xcd * (q + 1) : r * (q + 1) + (xcd - r) * q) + off; }
        const int nig = WGM * nN, gid = wgid / nig, fm = gid * WGM, gsz = (nM - fm) < WGM ? (nM - fm) : WGM;
        u.pm = fm + ((wgid % nig) % gsz); u.pn = (wgid % nig) / gsz; return true;
    }
    __device__ __forceinline__ void a_ready(const Unit&) const {}
    __device__ __forceinline__ void done(const Unit&) const {}
};

__device__ __forceinline__ unsigned cvt_pk_bf16(float lo, float hi) { unsigned r; asm volatile("v_cvt_pk_bf16_f32 %0, %1, %2" : "=v"(r) : "v"(lo), "v"(hi)); return r; }
typedef float f32x2 __attribute__((ext_vector_type(2)));
template <class Epi, class Sched, bool ALIGN_EPI = false, bool SP2 = false>
__device__ __forceinline__ void gemm_phase(PG8_LAS unsigned char* lds, const Gemm g, const Sched& S, const Epi& E) {
    int tid_ = threadIdx.x; asm volatile("" : "+v"(tid_));
    const int tid = tid_, wid = __builtin_amdgcn_readfirstlane(tid >> 6), lane = tid & 63, wr = wid >> 2, wc = wid & 3, fr = lane & 15, fq = lane >> 4;
    const int K = g.K; int nt = K / BK;
    unsigned voffA[2], voffB[2];
#pragma unroll
    for (int i = 0; i < 2; ++i) { int R, C; stage_rc(tid * 16 + i * 8192, R, C); const int Rb = Epi::PERM ? ((R & ~31) + perm32(R & 31)) : R;
        voffA[i] = (unsigned)(R * K + C) * 2u; voffB[i] = (unsigned)(Rb * K + C) * 2u; }
    const size_t kstep = (size_t)(BK * 2);
    const size_t hstep = (size_t)HALF * K * 2;
    const size_t tstep = 2 * hstep;
    const unsigned ldsw = (unsigned)wid * 1024u;
    const int aoff = lds_byte(wr * 64 + fr, fq * 8), boff = lds_byte(wc * 32 + fr, fq * 8);
#define PG8_SA(b, h) (((b) * 2 + (h)) * HTB)
#define PG8_SB(b, h) ((4 + (b) * 2 + (h)) * HTB)
#define PG8_STAGE(bufoff, gbase, voff) do { _Pragma("unroll") for (int _i = 0; _i < 2; ++_i) \
        __builtin_amdgcn_global_load_lds((const unsigned*)((const char*)(gbase) + (voff)[_i]), (PG8_LAS unsigned*)(lds + (bufoff) + ldsw + _i * 8192), 16, 0, 0); } while (0)
#define PG8_LDA(dst, b, h) do { _Pragma("unroll") for (int m = 0; m < 4; ++m) _Pragma("unroll") for (int k = 0; k < 2; ++k) dst[m][k] = *(const PG8_LAS bf16x8*)(lds + PG8_SA(b, h) + aoff + m * 2048 + k * 1024); } while (0)
#define PG8_LDB(dst, b, h) do { _Pragma("unroll") for (int n = 0; n < 2; ++n) _Pragma("unroll") for (int k = 0; k < 2; ++k) dst[n][k] = *(const PG8_LAS bf16x8*)(lds + PG8_SB(b, h) + boff + n * 2048 + k * 1024); } while (0)
#define PG8_MMA(ai, bj, At, Bt) do { __builtin_amdgcn_s_setprio(1); _Pragma("unroll") for (int m = 0; m < 4; ++m) _Pragma("unroll") for (int n = 0; n < 2; ++n) _Pragma("unroll") for (int k = 0; k < 2; ++k) \
        acc[ai][bj][m][n] = __builtin_amdgcn_mfma_f32_16x16x32_bf16(Bt[n][k], At[m][k], acc[ai][bj][m][n], 0, 0, 0); __builtin_amdgcn_s_setprio(0); } while (0)
#define PG8_WAIT_V(n) asm volatile("s_waitcnt vmcnt(" #n ")" ::: "memory")
#define PG8_WAIT_L(n) asm volatile("s_waitcnt lgkmcnt(" #n ")" ::: "memory")
#define PG8_BAR __builtin_amdgcn_s_barrier()
#define PG8_SCHED __builtin_amdgcn_sched_barrier(0)
    Unit cur, nxt; int ui = 0;
    if (!S.next(0, cur)) return;
    f32x4 acc[2][2][4][2];
#pragma unroll
    for (int a = 0; a < 2; ++a)
#pragma unroll
        for (int b = 0; b < 2; ++b)
#pragma unroll
            for (int m = 0; m < 4; ++m)
#pragma unroll
                for (int n = 0; n < 2; ++n) acc[a][b][m][n] = (f32x4){0.f, 0.f, 0.f, 0.f};
    bf16x8 At[4][2], B0[2][2], B1[2][2];
    const char* cA = (const char*)g.A + (size_t)cur.pm * tstep + (size_t)cur.kofs * 2; const char* cB = (const char*)g.Bt + (size_t)cur.pn * tstep + (size_t)cur.kofs * 2;
    if (cur.nt) nt = cur.nt;
    S.a_ready(cur);
    if constexpr (SP2) {
        PG8_STAGE(PG8_SB(0, 0), cB, voffB); PG8_STAGE(PG8_SB(0, 1), cB + hstep, voffB); PG8_STAGE(PG8_SA(0, 0), cA, voffA); PG8_STAGE(PG8_SA(0, 1), cA + hstep, voffA);
        if (wr == 1) PG8_BAR;
        PG8_WAIT_V(2); PG8_BAR;
        PG8_STAGE(PG8_SB(1, 0), cB + kstep, voffB); PG8_STAGE(PG8_SA(1, 0), cA + kstep, voffA); PG8_STAGE(PG8_SB(1, 1), cB + hstep + kstep, voffB);
        PG8_WAIT_V(6); PG8_BAR;
    } else {
        PG8_STAGE(PG8_SB(0, 0), cB, voffB); PG8_STAGE(PG8_SA(0, 0), cA, voffA); PG8_STAGE(PG8_SB(0, 1), cB + hstep, voffB); PG8_STAGE(PG8_SA(0, 1), cA + hstep, voffA);
        if (wr == 1) PG8_BAR;
        PG8_WAIT_V(4); PG8_BAR;
        PG8_STAGE(PG8_SB(1, 0), cB + kstep, voffB); PG8_STAGE(PG8_SA(1, 0), cA + kstep, voffA); PG8_STAGE(PG8_SB(1, 1), cB + hstep + kstep, voffB);
        PG8_WAIT_V(6); PG8_BAR;
    }
    for (;;) {
        const bool has_next = S.next(ui + 1, nxt);
        const char* nA = has_next ? (const char*)g.A + (size_t)nxt.pm * tstep + (size_t)nxt.kofs * 2 : cA; const char* nB = has_next ? (const char*)g.Bt + (size_t)nxt.pn * tstep + (size_t)nxt.kofs * 2 : cB;
        for (int t = 0; t < nt; t += 2) {
            const bool last = (t == nt - 2);
            const char* a1 = cA + (size_t)(t + 1) * kstep;
            const char* a2 = last ? nA : cA + (size_t)(t + 2) * kstep; const char* b2 = last ? nB : cB + (size_t)(t + 2) * kstep;
            const char* a3 = a2 + kstep; const char* b3 = b2 + kstep;
            if (last && has_next) S.a_ready(nxt);
            if constexpr (SP2) {
            PG8_LDB(B0, 0, 0); PG8_LDB(B1, 0, 1); PG8_SCHED; PG8_LDA(At, 0, 0); PG8_STAGE(PG8_SA(1, 1), a1 + hstep, voffA);
            PG8_WAIT_V(8); PG8_WAIT_L(0); PG8_BAR; PG8_MMA(0, 0, At, B0); PG8_MMA(0, 1, At, B1); PG8_BAR; PG8_SCHED;
            PG8_LDA(At, 0, 1); PG8_STAGE(PG8_SB(0, 0), b2, voffB); PG8_STAGE(PG8_SB(0, 1), b2 + hstep, voffB); PG8_STAGE(PG8_SA(0, 0), a2, voffA);
            PG8_WAIT_V(8); PG8_WAIT_L(0); PG8_BAR; PG8_MMA(1, 0, At, B0); PG8_MMA(1, 1, At, B1); PG8_BAR; PG8_SCHED;
            PG8_LDB(B0, 1, 0); PG8_LDB(B1, 1, 1); PG8_SCHED; PG8_LDA(At, 1, 0); PG8_STAGE(PG8_SA(0, 1), a2 + hstep, voffA);
            PG8_WAIT_V(8); PG8_WAIT_L(0); PG8_BAR; PG8_MMA(0, 0, At, B0); PG8_MMA(0, 1, At, B1); PG8_BAR; PG8_SCHED;
            PG8_LDA(At, 1, 1); PG8_STAGE(PG8_SB(1, 0), b3, voffB); PG8_STAGE(PG8_SB(1, 1), b3 + hstep, voffB); PG8_STAGE(PG8_SA(1, 0), a3, voffA);
            PG8_WAIT_V(8); PG8_WAIT_L(0); PG8_BAR; PG8_MMA(1, 0, At, B0); PG8_MMA(1, 1, At, B1); PG8_BAR; PG8_SCHED;
            } else {
            PG8_LDB(B0, 0, 0); PG8_SCHED; PG8_LDA(At, 0, 0); PG8_STAGE(PG8_SA(1, 1), a1 + hstep, voffA);
            PG8_WAIT_L(8); PG8_BAR; PG8_WAIT_L(0); PG8_MMA(0, 0, At, B0); PG8_BAR; PG8_SCHED;
            PG8_LDB(B1, 0, 1); PG8_STAGE(PG8_SB(0, 0), b2, voffB);
            PG8_BAR; PG8_WAIT_L(0); PG8_MMA(0, 1, At, B1); PG8_BAR;
            PG8_LDA(At, 0, 1); PG8_STAGE(PG8_SA(0, 0), a2, voffA);
            PG8_BAR; PG8_WAIT_L(0); PG8_MMA(1, 0, At, B0); PG8_BAR; PG8_SCHED;
            PG8_STAGE(PG8_SB(0, 1), b2 + hstep, voffB);
            PG8_WAIT_V(6); PG8_BAR; PG8_MMA(1, 1, At, B1); PG8_BAR;
            PG8_LDB(B0, 1, 0); PG8_SCHED; PG8_LDA(At, 1, 0); PG8_STAGE(PG8_SA(0, 1), a2 + hstep, voffA);
            PG8_WAIT_L(8); PG8_BAR; PG8_WAIT_L(0); PG8_MMA(0, 0, At, B0); PG8_BAR; PG8_SCHED;
            PG8_LDB(B1, 1, 1); PG8_STAGE(PG8_SB(1, 0), b3, voffB);
            PG8_BAR; PG8_WAIT_L(0); PG8_MMA(0, 1, At, B1); PG8_BAR;
            PG8_LDA(At, 1, 1); PG8_STAGE(PG8_SA(1, 0), a3, voffA);
            PG8_BAR; PG8_WAIT_L(0); PG8_MMA(1, 0, At, B0); PG8_BAR; PG8_SCHED;
            PG8_STAGE(PG8_SB(1, 1), b3 + hstep, voffB);
            PG8_WAIT_V(6); PG8_BAR; PG8_MMA(1, 1, At, B1); PG8_BAR;
            }
        }
        if constexpr (ALIGN_EPI) { if (wr == 0) PG8_BAR; }
        if constexpr (!Epi::AFTER_DRAIN) { E(acc, cur, wr, wc, fr, fq); S.done(cur); }
        if (!has_next) break;
#pragma unroll
        for (int a = 0; a < 2; ++a)
#pragma unroll
            for (int b = 0; b < 2; ++b)
#pragma unroll
                for (int m = 0; m < 4; ++m)
#pragma unroll
                    for (int n = 0; n < 2; ++n) acc[a][b][m][n] = (f32x4){0.f, 0.f, 0.f, 0.f};
        cur = nxt; cA = nA; cB = nB; ++ui; nt = cur.nt ? cur.nt : K / BK;
        if constexpr (ALIGN_EPI) { if (wr == 1) PG8_BAR; }
    }
    PG8_WAIT_V(0);
    if constexpr (!ALIGN_EPI) { if (wr == 0) PG8_BAR; }
    PG8_BAR;
    if constexpr (Epi::AFTER_DRAIN) { E.fused(acc, cur, wr, wc, fr, fq, lds, wid, lane); S.done(cur); }
#undef PG8_SA
#undef PG8_SB
#undef PG8_STAGE
#undef PG8_LDA
#undef PG8_LDB
#undef PG8_MMA
#undef PG8_WAIT_V
#undef PG8_WAIT_L
#undef PG8_BAR
#undef PG8_SCHED
}
}
#define LAS __attribute__((address_space(3)))
typedef unsigned short bf16_t;
typedef float f32x4 __attribute__((ext_vector_type(4)));
typedef short bf16x8 __attribute__((ext_vector_type(8)));
typedef unsigned u32x4 __attribute__((ext_vector_type(4)));
typedef unsigned u32x2 __attribute__((ext_vector_type(2)));

constexpr int DM = 1024, TP = 16384, TS = 512, TT = TP + TS, SEQ = 2048, NB = 8, NSB = 128;
constexpr int NPROJ = 2304, INDIM = 2312, DFF = 2816;
constexpr float EPS = 1e-6f;
constexpr int RT_H0 = 0, RT_MN = 66, RT_WIN = 74, RT_WXKV = 83, RT_END = 91;
constexpr size_t WS_R = 1u << 20;
constexpr size_t WS_H0 = WS_R;
constexpr size_t WS_MN = WS_R + (size_t)RT_MN * 256 * 2048;
constexpr size_t WS_WIN = WS_R + (size_t)RT_WIN * 256 * 2048;
constexpr size_t WS_WXKV = WS_R + (size_t)RT_WXKV * 256 * 2048;
constexpr size_t WS_WOUT = WS_R + (size_t)RT_END * 256 * 2048;
constexpr size_t WS_WXQ = WS_WOUT + 2097152;
constexpr size_t WS_WXO = WS_WXQ + 2097152;
constexpr size_t WS_WGU = WS_WXO + 2097152;
constexpr size_t WS_WDN = WS_WGU + (size_t)2 * DFF * 1024 * 2;
constexpr size_t WS_DTRAW = WS_WDN + (size_t)1024 * DFF * 2;
constexpr size_t WS_SPLIT = WS_DTRAW + (size_t)TT * 8 * 4;
constexpr size_t WS_ATOT = WS_SPLIT + (size_t)16 * 512 * 1024 * 4;
constexpr size_t WS_MIXIN = WS_ATOT + 8192;
constexpr size_t WS_CB16 = WS_MIXIN + (size_t)TT * 1024 * 2;
constexpr size_t WS_Q2 = WS_CB16 + (size_t)TT * 1024 * 2;
constexpr size_t WS_OX = WS_Q2 + (size_t)TT * 1024 * 2;
constexpr size_t WS_PROJ = WS_OX + (size_t)TT * 1024 * 2;
constexpr size_t WS_KVT = WS_PROJ + (size_t)TT * NPROJ * 2;
constexpr size_t WS_MK = WS_KVT + (size_t)256 * TT * 2;
constexpr size_t WS_MVT = WS_MK + (size_t)2048 * 1024 * 2;
constexpr size_t WS_MV = WS_MVT + (size_t)2048 * 1024 * 2;
constexpr size_t WS_CS = WS_MV + (size_t)2048 * 1024 * 2;
constexpr size_t WS_X1 = WS_CS;
constexpr size_t WS_END1 = WS_X1 + (size_t)TT * 1024 * 2 > WS_CS + (size_t)8 * 16 * 8 * 8192 * 4 ? WS_X1 + (size_t)TT * 1024 * 2 : WS_CS + (size_t)8 * 16 * 8 * 8192 * 4;
constexpr size_t WS_ACT = WS_PROJ;
constexpr size_t WS_END2 = WS_ACT + (size_t)TT * DFF * 2;
constexpr size_t WS_END = WS_END1 > WS_END2 ? WS_END1 : WS_END2;
constexpr size_t O_Y = 0, O_PSSM = 17301504, O_PCONV = 17825792, O_PWK = 17850368, O_PWV = 17981440, O_PMK = 18112512, O_PMV = 20209664,
                 O_SSSM = 22306816, O_SCONV = 30695424, O_SWK = 31088640, O_SWV = 33185792;
constexpr int LDS_BYTES = 147456;

struct Params {
    const float* in[32]; float* out; unsigned char* ws; int ph_lo, ph_hi;
};
typedef const __attribute__((address_space(4))) Params* CP;

__device__ __forceinline__ float bf2f(bf16_t h) { return __uint_as_float(((unsigned)h) << 16); }
__device__ __forceinline__ unsigned pk2(float lo, float hi) { return pg8::cvt_pk_bf16(lo, hi); }
__device__ __forceinline__ bf16_t f2bf(float f) { return (bf16_t)(pk2(f, 0.f) & 0xffffu); }
__device__ __forceinline__ float wave_sum(float v) {
#pragma unroll
    for (int o = 1; o < 64; o <<= 1) v += __shfl_xor(v, o);
    return v;
}
__device__ __forceinline__ float wave_max(float v) {
#pragma unroll
    for (int o = 1; o < 64; o <<= 1) v = fmaxf(v, __shfl_xor(v, o));
    return v;
}
__device__ __forceinline__ float silu_f(float x) { return x / (1.f + __expf(-x)); }
__device__ __forceinline__ float softplus_f(float x) { return x > 20.f ? x : log1pf(__expf(x)); }
#define LDSW() asm volatile("s_waitcnt lgkmcnt(0)" ::: "memory")

template <int NT>
__device__ __forceinline__ void mma_lds(f32x4 (&acc)[NT], const LAS bf16_t* A, int lda, const LAS bf16_t* B, int ldb, int K, int lane) {
    const int fr = lane & 15, fq = lane >> 4;
    for (int k0 = 0; k0 < K; k0 += 32) {
        const bf16x8 a = *(const LAS bf16x8*)(A + fr * lda + k0 + 8 * fq);
#pragma unroll
        for (int n = 0; n < NT; ++n) {
            const bf16x8 b = *(const LAS bf16x8*)(B + (16 * n + fr) * ldb + k0 + 8 * fq);
            acc[n] = __builtin_amdgcn_mfma_f32_16x16x32_bf16(b, a, acc[n], 0, 0, 0);
        }
    }
}
template <int NT, int KS, int ks0, int nks>
__device__ __forceinline__ void mma_areg(f32x4 (&acc)[NT], const bf16x8 (&a)[KS], const LAS bf16_t* B, int ldb, int lane) {
    const int fr = lane & 15, fq = lane >> 4;
#pragma unroll
    for (int ks = 0; ks < nks; ++ks) {
#pragma unroll
        for (int n = 0; n < NT; ++n) {
            const bf16x8 b = *(const LAS bf16x8*)(B + (16 * n + fr) * ldb + ks * 32 + 8 * fq);
            acc[n] = __builtin_amdgcn_mfma_f32_16x16x32_bf16(b, a[ks0 + ks], acc[n], 0, 0, 0);
        }
        __builtin_amdgcn_sched_barrier(0);
    }
}

struct Order {
    int n, G, c, mode, nN;
    __device__ __forceinline__ bool next(int i, pg8::Unit& u) const {
        const long L0 = (long)i * G + c; if (L0 >= n) return false;
        u.kofs = 0; u.nt = 0; u.q = 0;
        if (mode == 2) { const int L = (int)L0; if (L < 256) { const int v = (L % 8) * 32 + L / 8; u.pm = v / 4; u.pn = v % 4; }
            else { const int l = L - 256, q = l & 3, hi = ((nN + 7) / 8) * 2, lo = (nN - 2 * hi) / 2; u.pm = 64 + (l >> 4); u.pn = (l >> 2) & 3; u.q = q; u.nt = q < 2 ? hi : lo; u.kofs = 64 * (q < 2 ? q * hi : 2 * hi + (q - 2) * lo); } return true; }
        if (mode == 3) { const int L = (int)L0; if (L < 256) { const int v = (L % 8) * 32 + L / 8; u.pm = v / 4; u.pn = v % 4; }
            else { const int l = L - 256, q = l & 1; u.pm = 64 + (l >> 3); u.pn = (l >> 1) & 3; u.q = q; u.nt = nN / 2; u.kofs = 64 * q * (nN / 2); } return true; }
        int L = (int)L0; { const int q = n / 8, r = n % 8, xcd = L % 8, off = L / 8; L = (xcd < r ? xcd * (q + 1) : r * (q + 1) + (xcd - r) * q) + off; }
        if (mode == 0) {
            if (L < 594) { u.pm = L / 9; u.pn = RT_WIN + L % 9; }
            else if (L < 658) { const int l = L - 594; u.pm = RT_MN + l / 8; u.pn = RT_WXKV + l % 8; }
            else if (L < 690) { const int l = L - 658; u.pm = RT_WXKV + 4 + l / 8; u.pn = RT_MN + l % 8; }
            else { u.pm = RT_WIN + 8; u.pn = L - 690; }
        } else { u.pm = L / nN; u.pn = L % nN; }
        return true;
    }
    __device__ __forceinline__ void a_ready(const pg8::Unit&) const {}
    __device__ __forceinline__ void done(const pg8::Unit&) const {}
};
struct EpiP1 {
    static constexpr bool PERM = false, AFTER_DRAIN = false;
    bf16_t* proj; bf16_t* mk; bf16_t* mv; bf16_t* mvt; bf16_t* kvt;
    __device__ __forceinline__ void operator()(const f32x4 (&acc)[2][2][4][2], const pg8::Unit& u, int wr, int wc, int fr, int fq) const {
        bf16_t* base; int ld;
        if (u.pm < RT_MN) { base = proj + (size_t)(u.pm * 256) * NPROJ + (u.pn - RT_WIN) * 256; ld = NPROJ; }
        else if (u.pm < RT_WIN) { const int ct = u.pn - RT_WXKV; base = (ct < 4 ? mk + ct * 256 : mv + (ct - 4) * 256) + (size_t)((u.pm - RT_MN) * 256) * 1024; ld = 1024; }
        else if (u.pm == RT_WIN + 8) { base = kvt + u.pn * 256; ld = TT; }
        else { base = mvt + (size_t)((u.pm - RT_WXKV - 4) * 256) * 2048 + (u.pn - RT_MN) * 256; ld = 2048; }
#pragma unroll
        for (int ai = 0; ai < 2; ++ai)
#pragma unroll
            for (int m = 0; m < 4; ++m) {
                bf16_t* rowp = base + (size_t)(128 * ai + 64 * wr + 16 * m + fr) * ld + 32 * wc + 4 * fq;
#pragma unroll
                for (int bj = 0; bj < 2; ++bj)
#pragma unroll
                    for (int n = 0; n < 2; ++n) { const f32x4 v = acc[ai][bj][m][n]; u32x2 w; w.x = pk2(v[0], v[1]); w.y = pk2(v[2], v[3]); *(u32x2*)(rowp + 128 * bj + 16 * n) = w; }
            }
    }
};
struct EpiBf {
    static constexpr bool PERM = false, AFTER_DRAIN = false;
    bf16_t* O; int ldc; float scale; float* part;
    __device__ __forceinline__ void operator()(const f32x4 (&acc)[2][2][4][2], const pg8::Unit& u, int wr, int wc, int fr, int fq) const {
        if (u.nt) {
#pragma unroll
            for (int ai = 0; ai < 2; ++ai)
#pragma unroll
                for (int m = 0; m < 4; ++m) { float* rowp = part + (size_t)u.q * 512 * 1024 + (size_t)((u.pm - 64) * 256 + 128 * ai + 64 * wr + 16 * m + fr) * 1024 + u.pn * 256 + 32 * wc + 4 * fq;
#pragma unroll
                    for (int bj = 0; bj < 2; ++bj)
#pragma unroll
                        for (int n = 0; n < 2; ++n) *(f32x4*)(rowp + 128 * bj + 16 * n) = acc[ai][bj][m][n]; }
            return;
        }
#pragma unroll
        for (int ai = 0; ai < 2; ++ai)
#pragma unroll
            for (int m = 0; m < 4; ++m) {
                bf16_t* rowp = O + (size_t)(u.pm * 256 + 128 * ai + 64 * wr + 16 * m + fr) * ldc + u.pn * 256 + 32 * wc + 4 * fq;
#pragma unroll
                for (int bj = 0; bj < 2; ++bj)
#pragma unroll
                    for (int n = 0; n < 2; ++n) { const f32x4 v = acc[ai][bj][m][n] * scale; u32x2 w; w.x = pk2(v[0], v[1]); w.y = pk2(v[2], v[3]); *(u32x2*)(rowp + 128 * bj + 16 * n) = w; }
            }
    }
};
struct EpiGU {
    static constexpr bool PERM = false, AFTER_DRAIN = false;
    bf16_t* O;
    __device__ __forceinline__ void operator()(const f32x4 (&acc)[2][2][4][2], const pg8::Unit& u, int wr, int wc, int fr, int fq) const {
#pragma unroll
        for (int ai = 0; ai < 2; ++ai)
#pragma unroll
            for (int m = 0; m < 4; ++m) {
                bf16_t* rowp = O + (size_t)(u.pm * 256 + 128 * ai + 64 * wr + 16 * m + fr) * DFF + u.pn * 128 + 16 * wc + 4 * fq;
#pragma unroll
                for (int bj = 0; bj < 2; ++bj) { const f32x4 g = acc[ai][bj][m][0], up = acc[ai][bj][m][1];
                    u32x2 w; w.x = pk2(silu_f(g[0]) * up[0], silu_f(g[1]) * up[1]); w.y = pk2(silu_f(g[2]) * up[2], silu_f(g[3]) * up[3]); *(u32x2*)(rowp + 64 * bj) = w; }
            }
    }
};

struct TrSrc { const float* lo; const float* hi; int ld; };
__device__ __forceinline__ void tr_item(const TrSrc s, int k0, bf16_t* dst, int K, LAS float* scr, int lane) {
    const float* p = (lane & 16) ? s.hi + (lane & 15) : s.lo + (lane & 15);
    float tv[32];
#pragma unroll
    for (int i = 0; i < 32; ++i) { const int kk = 2 * i + (lane >> 5); tv[i] = __builtin_nontemporal_load(p + (size_t)(k0 + kk) * s.ld); }
#pragma unroll
    for (int i = 0; i < 32; ++i) { const int kk = 2 * i + (lane >> 5); scr[kk * 33 + (lane & 31)] = tv[i]; }
    LDSW();
    const int c = lane & 7;
#pragma unroll
    for (int j = 0; j < 4; ++j) { const int n = (lane >> 3) + 8 * j; const LAS float* q = scr + (8 * c) * 33 + n;
        u32x4 o; o.x = pk2(q[0], q[33]); o.y = pk2(q[2 * 33], q[3 * 33]); o.z = pk2(q[4 * 33], q[5 * 33]); o.w = pk2(q[6 * 33], q[7 * 33]);
        *(u32x4*)(dst + (size_t)n * K + 8 * c) = o; }
    LDSW();
}
__device__ __forceinline__ void rms_apply(f32x4 (&v)[4], const float* g, int lane) {
    float ss = 0.f;
#pragma unroll
    for (int j = 0; j < 4; ++j) ss += (v[j][0] * v[j][0] + v[j][1] * v[j][1]) + (v[j][2] * v[j][2] + v[j][3] * v[j][3]);
    const float r = rsqrtf(wave_sum(ss) * (1.f / 1024.f) + EPS);
#pragma unroll
    for (int j = 0; j < 4; ++j) { const f32x4 gv = *(const f32x4*)(g + 4 * lane + 256 * j); v[j] = v[j] * r * gv; }
}
__device__ __forceinline__ void store_row_bf16(bf16_t* o, const f32x4 (&v)[4], int lane) {
#pragma unroll
    for (int j = 0; j < 4; ++j) { u32x2 w; w.x = pk2(v[j][0], v[j][1]); w.y = pk2(v[j][2], v[j][3]); *(u32x2*)(o + 4 * lane + 256 * j) = w; }
}
__device__ __forceinline__ void load_row_f32(f32x4 (&v)[4], const float* x, int lane) {
#pragma unroll
    for (int j = 0; j < 4; ++j) v[j] = __builtin_nontemporal_load((const f32x4*)(x + 4 * lane + 256 * j));
}

__device__ __forceinline__ void tr_items(CP P, LAS unsigned char* lds, int part, int gw, int NGW, int wave, int lane) {
    unsigned char* ws = P->ws;
    LAS float* scr = (LAS float*)(lds + wave * 16384);
    constexpr int I_IN = 72 * 16, I_SQ = 512, I_GU = 176 * 16, I_DN = 32 * 44;
    const int nitems = part == 0 ? I_IN + 3 * I_SQ : 2 * I_SQ + I_GU + I_DN;
    for (int it = gw; it < nitems; it += NGW) {
        int r = it; TrSrc s; bf16_t* dst; int K = 1024, k0; int which = -1;
        if (part == 0) { if (r >= I_IN) { r -= I_IN; const int w3 = r / I_SQ; r %= I_SQ; which = w3 == 0 ? 0 : w3 + 2; } }
        else { if (r < 2 * I_SQ) { which = 1 + r / I_SQ; r %= I_SQ; } else r -= 2 * I_SQ; }
        if (part == 0 && which < 0) { const int nb = r / 16, kb = r % 16, n0 = nb * 32, sc = n0 + (n0 >= 1536 ? 8 : 0);
            s.lo = P->in[10] + sc; s.hi = s.lo + 16; s.ld = INDIM; k0 = kb * 64; dst = (bf16_t*)(ws + WS_WIN) + (size_t)n0 * 1024 + k0; }
        else if (which >= 0) { const int nb = r / 16, kb = r % 16;
            const float* W = which == 0 ? P->in[18] : which == 1 ? P->in[21] : which == 2 ? P->in[25] : which == 3 ? P->in[23] : P->in[24];
            bf16_t* D = which == 0 ? (bf16_t*)(ws + WS_WOUT) : which == 1 ? (bf16_t*)(ws + WS_WXQ) : which == 2 ? (bf16_t*)(ws + WS_WXO) : which == 3 ? (bf16_t*)(ws + WS_WXKV) : (bf16_t*)(ws + WS_WXKV) + (size_t)1024 * 1024;
            s.lo = W + nb * 32; s.hi = s.lo + 16; s.ld = 1024; k0 = kb * 64; dst = D + (size_t)nb * 32 * 1024 + k0; }
        else if (r < I_GU) { const int nb = r / 16, kb = r % 16;
            s.lo = P->in[28] + nb * 16; s.hi = P->in[29] + nb * 16; s.ld = DFF; k0 = kb * 64; dst = (bf16_t*)(ws + WS_WGU) + (size_t)nb * 32 * 1024 + k0; }
        else { r -= I_GU; const int nb = r / 44, kb = r % 44; K = DFF;
            s.lo = P->in[30] + nb * 32; s.hi = s.lo + 16; s.ld = 1024; k0 = kb * 64; dst = (bf16_t*)(ws + WS_WDN) + (size_t)nb * 32 * DFF + k0; }
        tr_item(s, k0, dst, K, scr, lane);
    }
}
__device__ __forceinline__ void phase_prologue(CP P, LAS unsigned char* lds, int gw, int NGW, int wave, int lane) {
    unsigned char* ws = P->ws;
    tr_items(P, lds, 0, gw, NGW, wave, lane);
    __syncthreads();
    LAS float* wT = (LAS float*)lds;
    { const int tid = wave * 64 + lane;
#pragma unroll
      for (int it = 0; it < 4; ++it) { const int idx = tid + 512 * it, c = idx >> 1, hf = idx & 1; const f32x4 w = *(const f32x4*)(P->in[10] + (size_t)c * INDIM + 1536 + 4 * hf);
          wT[(4 * hf + 0) * 1024 + c] = w[0]; wT[(4 * hf + 1) * 1024 + c] = w[1]; wT[(4 * hf + 2) * 1024 + c] = w[2]; wT[(4 * hf + 3) * 1024 + c] = w[3]; } }
    __syncthreads();
    {
        f32x4 nx[4];
        if (gw < TT) load_row_f32(nx, gw < TP ? P->in[0] + (size_t)gw * 1024 : P->in[1] + (size_t)(gw - TP) * 1024, lane);
        for (int m = gw; m < TT; m += NGW) {
            f32x4 v[4];
#pragma unroll
            for (int j = 0; j < 4; ++j) v[j] = nx[j];
            const int m2 = m + NGW;
            if (m2 < TT) load_row_f32(nx, m2 < TP ? P->in[0] + (size_t)m2 * 1024 : P->in[1] + (size_t)(m2 - TP) * 1024, lane);
            rms_apply(v, P->in[9], lane);
            store_row_bf16((bf16_t*)(ws + WS_H0) + (size_t)m * 1024, v, lane);
            float d[8];
#pragma unroll
            for (int e = 0; e < 8; ++e) { float a = 0.f;
#pragma unroll
                for (int j = 0; j < 4; ++j) { const f32x4 w = *(const LAS f32x4*)(wT + e * 1024 + 4 * lane + 256 * j); a += (v[j][0] * w[0] + v[j][1] * w[1]) + (v[j][2] * w[2] + v[j][3] * w[3]); }
                d[e] = wave_sum(a); }
            if (lane == 0) { float* o = (float*)(ws + WS_DTRAW) + (size_t)m * 8; *(f32x4*)o = (f32x4){d[0], d[1], d[2], d[3]}; *(f32x4*)(o + 4) = (f32x4){d[4], d[5], d[6], d[7]}; }
        }
    }
    __syncthreads();
    for (int m = gw; m < 2048; m += NGW) {
        f32x4 v[4]; load_row_f32(v, P->in[8] + (size_t)m * 1024, lane); rms_apply(v, P->in[22], lane);
        store_row_bf16((bf16_t*)(ws + WS_MN) + (size_t)m * 1024, v, lane);
    }
}

__device__ __forceinline__ void phase_resid(CP P, int stage, int gw, int NGW, int lane) {
    unsigned char* ws = P->ws; const bf16_t* C = (const bf16_t*)(ws + WS_CB16); bf16_t* XB = (bf16_t*)(ws + WS_X1);
    const float* g1 = stage == 0 ? P->in[19] : stage == 1 ? P->in[26] : P->in[31];
    const float* g2 = stage == 0 ? P->in[20] : P->in[27];
    for (int m = gw; m < TT; m += NGW) {
        f32x4 c[4], x[4];
        if (m >= TP) { const float* pp_ = (const float*)(ws + WS_SPLIT) + (size_t)(stage == 0 ? 0 : stage == 1 ? 8 : 12) * 512 * 1024 + (size_t)(m - TP) * 1024; f32x4 c1[4], c2[4], c3[4];
            load_row_f32(c, pp_, lane); load_row_f32(c1, pp_ + 512 * 1024, lane);
            if (stage == 2) { load_row_f32(c2, pp_ + 2 * 512 * 1024, lane); load_row_f32(c3, pp_ + 3 * 512 * 1024, lane); }
#pragma unroll
            for (int j = 0; j < 4; ++j) c[j] = stage == 2 ? (c[j] + c1[j]) + (c2[j] + c3[j]) : c[j] + c1[j]; }
        else {
#pragma unroll
        for (int j = 0; j < 4; ++j) { const u32x2 w = __builtin_nontemporal_load((const u32x2*)(C + (size_t)m * 1024 + 4 * lane + 256 * j));
            c[j] = (f32x4){__uint_as_float(w.x << 16), __uint_as_float(w.x & 0xffff0000u), __uint_as_float(w.y << 16), __uint_as_float(w.y & 0xffff0000u)}; }
        }
        if (stage == 0) load_row_f32(x, m < TP ? P->in[0] + (size_t)m * 1024 : P->in[1] + (size_t)(m - TP) * 1024, lane);
        else {
#pragma unroll
            for (int j = 0; j < 4; ++j) { const u32x2 w = *(const u32x2*)(XB + (size_t)m * 1024 + 4 * lane + 256 * j);
                x[j] = (f32x4){__uint_as_float(w.x << 16), __uint_as_float(w.x & 0xffff0000u), __uint_as_float(w.y << 16), __uint_as_float(w.y & 0xffff0000u)}; }
        }
        rms_apply(c, g1, lane);
#pragma unroll
        for (int j = 0; j < 4; ++j) x[j] = x[j] + c[j];
        if (stage == 2) {
#pragma unroll
            for (int j = 0; j < 4; ++j) *(f32x4*)(P->out + (size_t)m * 1024 + 4 * lane + 256 * j) = x[j];
        } else {
#pragma unroll
            for (int j = 0; j < 4; ++j) { u32x2 w; w.x = pk2(x[j][0], x[j][1]); w.y = pk2(x[j][2], x[j][3]); *(u32x2*)(XB + (size_t)m * 1024 + 4 * lane + 256 * j) = w;
                x[j] = (f32x4){__uint_as_float(w.x << 16), __uint_as_float(w.x & 0xffff0000u), __uint_as_float(w.y << 16), __uint_as_float(w.y & 0xffff0000u)}; }
            rms_apply(x, g2, lane); store_row_bf16((bf16_t*)(ws + WS_H0) + (size_t)m * 1024, x, lane);
        }
    }
}

__device__ __forceinline__ void conv8(const bf16_t* col, int t0, bool zero_hist, const float (&w)[4], float bias, float (&out)[8], float (&raw)[11]) {
#pragma unroll
    for (int i = 0; i < 11; ++i) { const int r = t0 - 3 + i; raw[i] = (r < 0 && zero_hist) ? 0.f : bf2f(col[(long)r * NPROJ]); }
#pragma unroll
    for (int j = 0; j < 8; ++j) out[j] = silu_f(bias + w[0] * raw[j] + w[1] * raw[j + 1] + w[2] * raw[j + 2] + w[3] * raw[j + 3]);
}
__device__ __forceinline__ void conv8x2(const bf16_t* col, int t0, bool zero_hist, const float* cw, const float* cb, int ch, float (&o0)[8], float (&o1)[8]) {
    float r0[11], r1[11];
#pragma unroll
    for (int i = 0; i < 11; ++i) { const int r = t0 - 3 + i; unsigned w = 0u; if (!(r < 0 && zero_hist)) w = *(const unsigned*)(col + (long)r * NPROJ); r0[i] = __uint_as_float(w << 16); r1[i] = __uint_as_float(w & 0xffff0000u); }
    const float b0 = cb[ch], b1 = cb[ch + 1];
    float w0[4], w1[4];
#pragma unroll
    for (int j = 0; j < 4; ++j) { w0[j] = cw[j * 1024 + ch]; w1[j] = cw[j * 1024 + ch + 1]; }
#pragma unroll
    for (int j = 0; j < 8; ++j) { o0[j] = silu_f(b0 + w0[0] * r0[j] + w0[1] * r0[j + 1] + w0[2] * r0[j + 2] + w0[3] * r0[j + 3]);
                                  o1[j] = silu_f(b1 + w1[0] * r1[j] + w1[1] * r1[j + 1] + w1[2] * r1[j + 2] + w1[3] * r1[j + 3]); }
}
__device__ __forceinline__ void dt_acum(CP P, int row0, int g, LAS float* dtv, LAS float* acum, int wave, int lane) {
    if (wave < 4) {
        const int h = g * 4 + wave; const float* dr = (const float*)(P->ws + WS_DTRAW);
        const float bias = P->in[13][h], a = -__expf(P->in[14][h]);
        const float d0 = softplus_f(dr[(size_t)(row0 + 2 * lane) * 8 + h] + bias), d1 = softplus_f(dr[(size_t)(row0 + 2 * lane + 1) * 8 + h] + bias);
        const float a0 = a * d0, a1 = a * d1; float s = a0 + a1;
#pragma unroll
        for (int o = 1; o < 64; o <<= 1) { const float t = __shfl_up(s, o); if (lane >= o) s += t; }
        dtv[(2 * lane) * 4 + wave] = d0; dtv[(2 * lane + 1) * 4 + wave] = d1;
        acum[(2 * lane) * 4 + wave] = s - a1; acum[(2 * lane + 1) * 4 + wave] = s;
    }
}

constexpr int PT = 136;
__device__ __forceinline__ void ssd_pass_a(CP P, LAS unsigned char* lds, int unit, int tid, int wave, int lane) {
    const int b = unit >> 5, c = (unit >> 1) & 15, g = unit & 1, row0 = b * SEQ + c * 128;
    LAS bf16_t* BT = (LAS bf16_t*)lds;
    LAS bf16_t* XW = (LAS bf16_t*)(lds + 128 * PT * 2);
    LAS float* dtv = (LAS float*)(lds + 384 * PT * 2); LAS float* acum = dtv + 512;
    const bf16_t* proj = (const bf16_t*)(P->ws + WS_PROJ);
    dt_acum(P, row0, g, dtv, acum, wave, lane);
    __syncthreads();
#pragma unroll 3
    for (int kk_ = 0; kk_ < 6; ++kk_) {
        const int it = tid + 512 * kk_;
        const int pr = it % 192, tb = it / 192, t0 = tb * 8, chl = 2 * pr;
        const int ch = chl < 256 ? g * 256 + chl : 512 + g * 128 + (chl - 256);
        float o0[8], o1[8]; conv8x2(proj + (size_t)row0 * NPROJ + 512 + ch, t0, c == 0, P->in[11], P->in[12], ch, o0, o1);
        if (chl < 256) { const int hh = chl >> 6; const float aend = acum[127 * 4 + hh];
#pragma unroll
            for (int j = 0; j < 8; ++j) { const float wg = dtv[(t0 + j) * 4 + hh] * __expf(aend - acum[(t0 + j) * 4 + hh]); o0[j] *= wg; o1[j] *= wg; } }
        u32x4 pk0, pk1; pk0.x = pk2(o0[0], o0[1]); pk0.y = pk2(o0[2], o0[3]); pk0.z = pk2(o0[4], o0[5]); pk0.w = pk2(o0[6], o0[7]);
        pk1.x = pk2(o1[0], o1[1]); pk1.y = pk2(o1[2], o1[3]); pk1.z = pk2(o1[4], o1[5]); pk1.w = pk2(o1[6], o1[7]);
        LAS bf16_t* d = chl < 256 ? XW + chl * PT + t0 : BT + (chl - 256) * PT + t0;
        *(LAS u32x4*)d = pk0; *(LAS u32x4*)(d + PT) = pk1;
    }
    __syncthreads();
    float* cs = (float*)(P->ws + WS_CS) + (size_t)((b * 16 + c) * 8 + g * 4) * 8192;
#pragma unroll
    for (int mt = 0; mt < 2; ++mt) {
        f32x4 acc[8];
#pragma unroll
        for (int n = 0; n < 8; ++n) acc[n] = (f32x4){0.f, 0.f, 0.f, 0.f};
        const int r0 = 32 * wave + 16 * mt;
        mma_lds<8>(acc, XW + r0 * PT, PT, BT, PT, 128, lane);
        const int fr = lane & 15, fq = lane >> 4;
#pragma unroll
        for (int n = 0; n < 8; ++n) *(f32x4*)(cs + (size_t)(r0 + fr) * 128 + 16 * n + 4 * fq) = acc[n];
    }
    if (tid < 4) ((float*)(P->ws + WS_ATOT))[(b * 16 + c) * 8 + g * 4 + tid] = acum[127 * 4 + tid];
    __syncthreads();
}

__device__ __forceinline__ void ssd_state_scan(CP P, int bid, int G, int tid) {
    for (int base_ = bid * 512; base_ < 8 * 8 * 2048; base_ += G * 512) {
        const int i = base_ + tid, bh = i >> 11, e4 = i & 2047, b = bh >> 3, h = bh & 7;
        float* cs = (float*)(P->ws + WS_CS) + (size_t)(b * 16 * 8 + h) * 8192 + 4 * e4;
        const float* at = (const float*)(P->ws + WS_ATOT) + b * 16 * 8 + h;
        f32x4 v[16]; float dec[16];
#pragma unroll
        for (int c = 0; c < 16; ++c) { v[c] = *(const f32x4*)(cs + (size_t)c * 8 * 8192); dec[c] = __expf(at[c * 8]); }
        f32x4 st = (f32x4){0.f, 0.f, 0.f, 0.f};
#pragma unroll
        for (int c = 0; c < 16; ++c) { *(f32x4*)(cs + (size_t)c * 8 * 8192) = st; st = st * dec[c] + v[c]; }
        *(f32x4*)(P->out + O_PSSM + (size_t)(b * 8 + h) * 8192 + 4 * e4) = st;
    }
}

__device__ __forceinline__ void ssd_pass_b(CP P, LAS unsigned char* lds, int unit, int tid, int wave, int lane) {
    const int b = unit >> 5, c = (unit >> 1) & 15, g = unit & 1, row0 = b * SEQ + c * 128;
    const int fr = lane & 15, fq = lane >> 4;
    LAS bf16_t* Cs = (LAS bf16_t*)lds;
    LAS bf16_t* Bs = (LAS bf16_t*)(lds + 128 * PT * 2);
    LAS bf16_t* XT = (LAS bf16_t*)(lds + 256 * PT * 2);
    LAS bf16_t* SI = (LAS bf16_t*)(lds + 320 * PT * 2);
    LAS float* dtv = (LAS float*)(lds + 384 * PT * 2); LAS float* acum = dtv + 512;
    const bf16_t* proj = (const bf16_t*)(P->ws + WS_PROJ);
    dt_acum(P, row0, g, dtv, acum, wave, lane);
#pragma unroll 4
    for (int kk_ = 0; kk_ < 4; ++kk_) {
        const int it = tid + 512 * kk_;
        const int chl = 2 * (it & 127), tb = it >> 7, t0 = tb * 8;
        const int ch = chl < 128 ? 512 + g * 128 + chl : 768 + g * 128 + (chl - 128);
        float o0[8], o1[8]; conv8x2(proj + (size_t)row0 * NPROJ + 512 + ch, t0, c == 0, P->in[11], P->in[12], ch, o0, o1);
        LAS bf16_t* d = chl < 128 ? Bs + chl : Cs + (chl - 128);
#pragma unroll
        for (int j = 0; j < 8; ++j) *(LAS unsigned*)(d + (t0 + j) * PT) = pk2(o0[j], o1[j]);
    }
    if (c == 15) {
        const int ch = tid < 256 ? g * 256 + tid : (tid < 384 ? 512 + g * 128 + (tid - 256) : 768 + g * 128 + (tid - 384));
#pragma unroll
        for (int i = 0; i < 3; ++i) P->out[O_PCONV + (size_t)(b * 3 + i) * 1024 + ch] = bf2f(proj[(size_t)(row0 + 125 + i) * NPROJ + 512 + ch]);
    }
    __syncthreads();
    f32x4 cb[8];
#pragma unroll
    for (int n = 0; n < 8; ++n) cb[n] = (f32x4){0.f, 0.f, 0.f, 0.f};
    mma_lds<8>(cb, Cs + 16 * wave * PT, PT, Bs, PT, 128, lane);
    __syncthreads();
    LAS bf16_t* Ls = Bs;
    const int t = 16 * wave + fr;
    float ss = 0.f;
    const bf16_t* zr = proj + (size_t)(row0 + t) * NPROJ + g * 256;
    bf16_t* orow = (bf16_t*)(P->ws + WS_MIXIN) + (size_t)(row0 + t) * 1024 + g * 256;
#pragma unroll 1
    for (int hh = 0; hh < 4; ++hh) {
        const int h = g * 4 + hh;
        u32x2 zw4[4];
#pragma unroll
        for (int n = 0; n < 4; ++n) zw4[n] = *(const u32x2*)(zr + hh * 64 + 16 * n + 4 * fq);
        {
            const int p = 2 * (tid & 31), tb = tid >> 5, t0 = tb * 8, ch = h * 64 + p;
            float o0[8], o1[8]; conv8x2(proj + (size_t)row0 * NPROJ + 512 + ch, t0, c == 0, P->in[11], P->in[12], ch, o0, o1);
            u32x4 pk0, pk1; pk0.x = pk2(o0[0], o0[1]); pk0.y = pk2(o0[2], o0[3]); pk0.z = pk2(o0[4], o0[5]); pk0.w = pk2(o0[6], o0[7]);
            pk1.x = pk2(o1[0], o1[1]); pk1.y = pk2(o1[2], o1[3]); pk1.z = pk2(o1[4], o1[5]); pk1.w = pk2(o1[6], o1[7]);
            *(LAS u32x4*)(XT + p * PT + t0) = pk0; *(LAS u32x4*)(XT + (p + 1) * PT + t0) = pk1;
        }
        {
            const int p = tid >> 3, n0 = (tid & 7) * 16;
            const float* src = (const float*)(P->ws + WS_CS) + (size_t)((b * 16 + c) * 8 + h) * 8192 + p * 128 + n0;
#pragma unroll
            for (int q = 0; q < 4; ++q) { const f32x4 sv = *(const f32x4*)(src + 4 * q); u32x2 w2; w2.x = pk2(sv[0], sv[1]); w2.y = pk2(sv[2], sv[3]); *(LAS u32x2*)(SI + p * PT + n0 + 4 * q) = w2; }
        }
        {
            const float at_ = acum[t * 4 + hh];
#pragma unroll
            for (int n = 0; n < 8; ++n) {
                float l[4];
#pragma unroll
                for (int e = 0; e < 4; ++e) { const int s_ = 16 * n + 4 * fq + e; l[e] = (s_ <= t) ? cb[n][e] * __expf(at_ - acum[s_ * 4 + hh]) * dtv[s_ * 4 + hh] : 0.f; }
                u32x2 w2; w2.x = pk2(l[0], l[1]); w2.y = pk2(l[2], l[3]); *(LAS u32x2*)(Ls + t * PT + 16 * n + 4 * fq) = w2;
            }
        }
        __syncthreads();
        {
            f32x4 yd[4], yo[4];
#pragma unroll
            for (int n = 0; n < 4; ++n) { yd[n] = (f32x4){0.f, 0.f, 0.f, 0.f}; yo[n] = (f32x4){0.f, 0.f, 0.f, 0.f}; }
            mma_lds<4>(yd, Ls + 16 * wave * PT, PT, XT, PT, 128, lane);
            mma_lds<4>(yo, Cs + 16 * wave * PT, PT, SI, PT, 128, lane);
            const float ea = __expf(acum[t * 4 + hh]), dsk = P->in[15][h];
#pragma unroll
            for (int n = 0; n < 4; ++n) {
                const u32x2 zw = zw4[n];
                const float z[4] = {__uint_as_float(zw.x << 16), __uint_as_float(zw.x & 0xffff0000u), __uint_as_float(zw.y << 16), __uint_as_float(zw.y & 0xffff0000u)};
                float u[4];
#pragma unroll
                for (int e = 0; e < 4; ++e) { u[e] = (yd[n][e] + ea * yo[n][e] + dsk * bf2f(XT[(16 * n + 4 * fq + e) * PT + t])) * silu_f(z[e]); ss += u[e] * u[e]; }
                u32x2 w2; w2.x = pk2(u[0], u[1]); w2.y = pk2(u[2], u[3]); *(u32x2*)(orow + hh * 64 + 16 * n + 4 * fq) = w2;
            }
        }
        __syncthreads();
    }
    {
        ss += __shfl_xor(ss, 16); ss += __shfl_xor(ss, 32);
        const float r = rsqrtf(ss * (1.f / 256.f) + EPS);
#pragma unroll
        for (int hh = 0; hh < 4; ++hh)
#pragma unroll
            for (int n = 0; n < 4; ++n) { const int col = hh * 64 + 16 * n + 4 * fq; const f32x4 gv = *(const f32x4*)(P->in[16] + g * 256 + col);
                const u32x2 uw = *(const u32x2*)(orow + col);
                const float u0 = __uint_as_float(uw.x << 16) * r * gv[0], u1 = __uint_as_float(uw.x & 0xffff0000u) * r * gv[1], u2 = __uint_as_float(uw.y << 16) * r * gv[2], u3 = __uint_as_float(uw.y & 0xffff0000u) * r * gv[3];
                u32x2 w2; w2.x = pk2(u0, u1); w2.y = pk2(u2, u3); *(u32x2*)(orow + col) = w2; }
    }
    __syncthreads();
}

constexpr int PK = 72, PV = 264;
__device__ __forceinline__ void swa_prompt(CP P, LAS unsigned char* lds, int unit, int tid, int wave, int lane) {
    const int b = unit >> 5, nb = (unit >> 1) & 15, kvh = unit & 1, row0 = b * SEQ + nb * 128;
    const int fr = lane & 15, fq = lane >> 4;
    LAS bf16_t* Ks = (LAS bf16_t*)lds;
    LAS bf16_t* VT = (LAS bf16_t*)(lds + 256 * PK * 2);
    const bf16_t* proj = (const bf16_t*)(P->ws + WS_PROJ); const bf16_t* kvt = (const bf16_t*)(P->ws + WS_KVT);
#pragma unroll
    for (int kk_ = 0; kk_ < 4; ++kk_) {
        const int ci = tid + 512 * kk_;
        { const int row = ci >> 3, c8 = ci & 7; u32x4 v = (u32x4){0u, 0u, 0u, 0u};
          if (!(nb == 0 && row < 128)) v = *(const u32x4*)(proj + (size_t)(row0 - 128 + row) * NPROJ + 2048 + kvh * 64 + c8 * 8);
          *(LAS u32x4*)(Ks + row * PK + c8 * 8) = v; }
        { const int d = ci >> 5, c = ci & 31; u32x4 v = (u32x4){0u, 0u, 0u, 0u};
          if (!(nb == 0 && c < 16)) v = *(const u32x4*)(kvt + (size_t)(128 + kvh * 64 + d) * TT + row0 - 128 + c * 8);
          *(LAS u32x4*)(VT + d * PV + c * 8) = v; }
    }
    __syncthreads();
    const int r = wave >> 1, head = kvh * 4 + r; const float sink = P->in[17][head];
    bf16x8 qn[2];
#pragma unroll
    for (int ks = 0; ks < 2; ++ks) qn[ks] = *(const bf16x8*)(proj + (size_t)(row0 + (wave & 1) * 64 + fr) * NPROJ + 1536 + head * 64 + ks * 32 + 8 * fq);
    for (int st = 0; st < 4; ++st) {
        const int q0 = (wave & 1) * 64 + 16 * st, qi = q0 + fr;
        bf16x8 qf[2];
#pragma unroll
        for (int ks = 0; ks < 2; ++ks) qf[ks] = qn[ks];
        if (st < 3) {
#pragma unroll
            for (int ks = 0; ks < 2; ++ks) qn[ks] = *(const bf16x8*)(proj + (size_t)(row0 + qi + 16) * NPROJ + 1536 + head * 64 + ks * 32 + 8 * fq);
        }
        f32x4 s[16];
#pragma unroll
        for (int n = 0; n < 16; ++n) s[n] = (f32x4){0.f, 0.f, 0.f, 0.f};
        mma_areg<16, 2, 0, 2>(s, qf, Ks, PK, lane);
        float mx = sink;
#pragma unroll
        for (int n = 0; n < 16; ++n)
#pragma unroll
            for (int e = 0; e < 4; ++e) { const int kj = 16 * n + 4 * fq + e; const bool ok = (kj > qi) && (kj <= qi + 128) && (nb > 0 || kj >= 128);
                const float v = ok ? s[n][e] * 0.125f : -INFINITY; s[n][e] = v; mx = fmaxf(mx, v); }
        mx = fmaxf(mx, __shfl_xor(mx, 16)); mx = fmaxf(mx, __shfl_xor(mx, 32));
        float sum = 0.f;
#pragma unroll
        for (int n = 0; n < 16; ++n)
#pragma unroll
            for (int e = 0; e < 4; ++e) { const float ev = __expf(s[n][e] - mx); s[n][e] = ev; sum += ev; }
        sum += __shfl_xor(sum, 16); sum += __shfl_xor(sum, 32);
        const float inv = 1.f / (sum + __expf(sink - mx));
        bf16x8 pf[8];
#pragma unroll
        for (int ks = 0; ks < 8; ++ks) { u32x4 w; w.x = pk2(s[2 * ks][0] * inv, s[2 * ks][1] * inv); w.y = pk2(s[2 * ks][2] * inv, s[2 * ks][3] * inv);
            w.z = pk2(s[2 * ks + 1][0] * inv, s[2 * ks + 1][1] * inv); w.w = pk2(s[2 * ks + 1][2] * inv, s[2 * ks + 1][3] * inv); pf[ks] = __builtin_bit_cast(bf16x8, w); }
        f32x4 o[4];
#pragma unroll
        for (int n = 0; n < 4; ++n) o[n] = (f32x4){0.f, 0.f, 0.f, 0.f};
#pragma unroll
        for (int ks = 0; ks < 8; ++ks) {
#pragma unroll
            for (int n = 0; n < 4; ++n) {
                const LAS bf16_t* vp = VT + (16 * n + fr) * PV + 32 * ks + 4 * fq;
                const u32x2 a0 = *(const LAS u32x2*)vp, a1 = *(const LAS u32x2*)(vp + 16);
                o[n] = __builtin_amdgcn_mfma_f32_16x16x32_bf16(__builtin_bit_cast(bf16x8, (u32x4){a0.x, a0.y, a1.x, a1.y}), pf[ks], o[n], 0, 0, 0);
            }
            __builtin_amdgcn_sched_barrier(0);
        }
        asm volatile("s_nop 7\n\ts_nop 7\n\ts_nop 7" ::: "memory");
        bf16_t* op = (bf16_t*)(P->ws + WS_MIXIN) + (size_t)(row0 + qi) * 1024 + 512 + head * 64 + 4 * fq;
#pragma unroll
        for (int n = 0; n < 4; ++n) { u32x2 w2; w2.x = pk2(o[n][0], o[n][1]); w2.y = pk2(o[n][2], o[n][3]); *(u32x2*)(op + 16 * n) = w2; }
        LDSW();
    }
    __syncthreads();
}

__device__ __forceinline__ void ssd_sample(CP P, LAS unsigned char* lds, int unit, int tid, int wave, int lane) {
    const int b = unit >> 1, g = unit & 1, row0 = TP + b * 4;
    LAS float* xs = (LAS float*)lds;
    LAS float* Bsm = xs + 1024;
    LAS float* Csm = Bsm + 512;
    LAS float* ys = Csm + 512;
    LAS float* dts = ys + 1024;
    const bf16_t* proj = (const bf16_t*)(P->ws + WS_PROJ);
    {
        const int ch = tid < 256 ? g * 256 + tid : (tid < 384 ? 512 + g * 128 + (tid - 256) : 768 + g * 128 + (tid - 384));
        float up[7];
#pragma unroll
        for (int i = 0; i < 3; ++i) up[i] = P->in[3][(size_t)(b * 3 + i) * 1024 + ch];
#pragma unroll
        for (int i = 0; i < 4; ++i) up[3 + i] = bf2f(proj[(size_t)(row0 + i) * NPROJ + 512 + ch]);
        float w[4];
#pragma unroll
        for (int j = 0; j < 4; ++j) w[j] = P->in[11][j * 1024 + ch];
        const float bias = P->in[12][ch];
        LAS float* dst = tid < 256 ? xs + tid : (tid < 384 ? Bsm + (tid - 256) : Csm + (tid - 384)); const int pitch = tid < 256 ? 256 : 128;
#pragma unroll
        for (int i = 0; i < 4; ++i) dst[i * pitch] = silu_f(bias + w[0] * up[i] + w[1] * up[i + 1] + w[2] * up[i + 2] + w[3] * up[i + 3]);
#pragma unroll
        for (int i = 0; i < 3; ++i) P->out[O_SCONV + (size_t)(b * 3 + i) * 1024 + ch] = up[4 + i];
        if (tid < 16) { const int tt = tid >> 2, hh = tid & 3, h = g * 4 + hh; dts[tid] = softplus_f(((const float*)(P->ws + WS_DTRAW))[(size_t)(row0 + tt) * 8 + h] + P->in[13][h]); }
    }
    __syncthreads();
    const int p = tid >> 3, n0 = (tid & 7) * 16;
    f32x4 stv[4][4];
#pragma unroll
    for (int hh = 0; hh < 4; ++hh)
#pragma unroll
        for (int q = 0; q < 4; ++q) stv[hh][q] = __builtin_nontemporal_load((const f32x4*)(P->in[2] + (size_t)((b * 8 + g * 4 + hh) * 64 + p) * 128 + n0 + 4 * q));
#pragma unroll
    for (int hh = 0; hh < 4; ++hh) {
        const int h = g * 4 + hh; const float a = -__expf(P->in[14][h]), dsk = P->in[15][h];
        float st[16];
#pragma unroll
        for (int q = 0; q < 4; ++q) { const f32x4 v = stv[hh][q]; st[4 * q] = v[0]; st[4 * q + 1] = v[1]; st[4 * q + 2] = v[2]; st[4 * q + 3] = v[3]; }
#pragma unroll
        for (int tt = 0; tt < 4; ++tt) {
            const float dt = dts[tt * 4 + hh], dA = __expf(a * dt), xv = xs[tt * 256 + hh * 64 + p], dx = dt * xv; float yv = 0.f;
#pragma unroll
            for (int q = 0; q < 16; ++q) { st[q] = dA * st[q] + dx * Bsm[tt * 128 + n0 + q]; yv += st[q] * Csm[tt * 128 + n0 + q]; }
            yv += __shfl_xor(yv, 1); yv += __shfl_xor(yv, 2); yv += __shfl_xor(yv, 4);
            if ((tid & 7) == 0) ys[tt * 256 + hh * 64 + p] = yv + dsk * xv;
        }
        float* op = P->out + O_SSSM + (size_t)((b * 8 + h) * 64 + p) * 128 + n0;
#pragma unroll
        for (int q = 0; q < 4; ++q) *(f32x4*)(op + 4 * q) = (f32x4){st[4 * q], st[4 * q + 1], st[4 * q + 2], st[4 * q + 3]};
    }
    __syncthreads();
    if (wave < 4) {
        const int tt = wave; const bf16_t* zr = proj + (size_t)(row0 + tt) * NPROJ + g * 256 + 4 * lane;
        const u32x2 zw = *(const u32x2*)zr; const float z[4] = {__uint_as_float(zw.x << 16), __uint_as_float(zw.x & 0xffff0000u), __uint_as_float(zw.y << 16), __uint_as_float(zw.y & 0xffff0000u)};
        float u[4], ss = 0.f;
#pragma unroll
        for (int e = 0; e < 4; ++e) { u[e] = ys[tt * 256 + 4 * lane + e] * silu_f(z[e]); ss += u[e] * u[e]; }
        const float r = rsqrtf(wave_sum(ss) * (1.f / 256.f) + EPS); const f32x4 gv = *(const f32x4*)(P->in[16] + g * 256 + 4 * lane);
        u32x2 w2; w2.x = pk2(u[0] * r * gv[0], u[1] * r * gv[1]); w2.y = pk2(u[2] * r * gv[2], u[3] * r * gv[3]);
        *(u32x2*)((bf16_t*)(P->ws + WS_MIXIN) + (size_t)(row0 + tt) * 1024 + g * 256 + 4 * lane) = w2;
    }
    __syncthreads();
}

__device__ __forceinline__ void swa_sample(CP P, LAS unsigned char* lds, int unit, int tid, int wave, int lane) {
    const int b = unit >> 1, kvh = unit & 1, row0 = TP + b * 4;
    LAS float* Kf = (LAS float*)lds;
    LAS float* Vf = Kf + 132 * 65;
    LAS float* qf = Vf + 132 * 64;
    LAS float* sc = qf + 16 * 65;
    const bf16_t* proj = (const bf16_t*)(P->ws + WS_PROJ);
    {
        f32x4 kq[5], vq[5];
#pragma unroll
        for (int it = 0; it < 5; ++it) {
            const int i4 = tid + 512 * it, kk = i4 >> 4, d4 = (i4 & 15) * 4; kq[it] = (f32x4){0.f, 0.f, 0.f, 0.f}; vq[it] = kq[it];
            if (i4 < 132 * 16) {
                if (kk < 128) { const size_t o = (size_t)((b * 128 + kk) * 2 + kvh) * 64 + d4; kq[it] = *(const f32x4*)(P->in[4] + o); vq[it] = *(const f32x4*)(P->in[5] + o); }
                else { const bf16_t* pr = proj + (size_t)(row0 + kk - 128) * NPROJ + kvh * 64 + d4; const u32x2 a = *(const u32x2*)(pr + 2048), c = *(const u32x2*)(pr + 2176);
                    kq[it] = (f32x4){__uint_as_float(a.x << 16), __uint_as_float(a.x & 0xffff0000u), __uint_as_float(a.y << 16), __uint_as_float(a.y & 0xffff0000u)};
                    vq[it] = (f32x4){__uint_as_float(c.x << 16), __uint_as_float(c.x & 0xffff0000u), __uint_as_float(c.y << 16), __uint_as_float(c.y & 0xffff0000u)}; }
            }
        }
#pragma unroll
        for (int it = 0; it < 5; ++it) {
            const int i4 = tid + 512 * it, kk = i4 >> 4, d4 = (i4 & 15) * 4;
            if (i4 < 132 * 16) { Kf[kk * 65 + d4] = kq[it][0]; Kf[kk * 65 + d4 + 1] = kq[it][1]; Kf[kk * 65 + d4 + 2] = kq[it][2]; Kf[kk * 65 + d4 + 3] = kq[it][3]; *(LAS f32x4*)(Vf + kk * 64 + d4) = vq[it]; }
        }
    }
    for (int kk_ = 0; kk_ < 2; ++kk_) { const int i = tid + 512 * kk_; const int r16 = i >> 6, d = i & 63, tt = r16 >> 2, r = r16 & 3;
        qf[r16 * 65 + d] = bf2f(proj[(size_t)(row0 + tt) * NPROJ + 1536 + (kvh * 4 + r) * 64 + d]); }
    __syncthreads();
    { const int r16 = tid & 15, kg = tid >> 4, tt = r16 >> 2;
      for (int j_ = 0; j_ < 5; ++j_) {
          const int kk = kg + 32 * j_; if (kk >= 132) continue;
          float s = 0.f;
#pragma unroll 16
          for (int d = 0; d < 64; ++d) s += qf[r16 * 65 + d] * Kf[kk * 65 + d];
          const bool ok = kk < 128 ? (kk >= tt + 1) : (kk - 128 <= tt);
          sc[r16 * 136 + kk] = ok ? s * 0.125f : -INFINITY;
      } }
    __syncthreads();
#pragma unroll
    for (int rr = 0; rr < 2; ++rr) {
        const int r16 = 2 * wave + rr; const float sink = P->in[17][kvh * 4 + (r16 & 3)];
        float v[3]; float mx = sink;
#pragma unroll
        for (int j = 0; j < 3; ++j) { const int kk = lane + 64 * j; v[j] = kk < 132 ? sc[r16 * 136 + kk] : -INFINITY; mx = fmaxf(mx, v[j]); }
        mx = wave_max(mx); float sum = 0.f;
#pragma unroll
        for (int j = 0; j < 3; ++j) { v[j] = __expf(v[j] - mx); sum += v[j]; }
        const float inv = 1.f / (wave_sum(sum) + __expf(sink - mx));
#pragma unroll
        for (int j = 0; j < 3; ++j) { const int kk = lane + 64 * j; if (kk < 132) sc[r16 * 136 + kk] = v[j] * inv; }
    }
    __syncthreads();
    { const int r16 = tid >> 5, d2 = (tid & 31) * 2, tt = r16 >> 2, r = r16 & 3; float o0 = 0.f, o1 = 0.f;
      for (int kk = 0; kk < 132; ++kk) { const float p = sc[r16 * 136 + kk]; o0 += p * Vf[kk * 64 + d2]; o1 += p * Vf[kk * 64 + d2 + 1]; }
      *(unsigned*)((bf16_t*)(P->ws + WS_MIXIN) + (size_t)(row0 + tt) * 1024 + 512 + (kvh * 4 + r) * 64 + d2) = pk2(o0, o1); }
    __syncthreads();
}

__device__ __forceinline__ void xattn_prompt(CP P, LAS unsigned char* lds, int unit, int tid, int wave, int lane) {
    const int b = unit >> 6, h = (unit >> 4) & 3, qb = unit & 15;
    const int fr = lane & 15, fq = lane >> 4;
    LAS bf16_t* KV = (LAS bf16_t*)lds;
    LAS bf16_t* Ps = (LAS bf16_t*)(lds + 256 * PK * 2) + wave * 16 * PV;
    const bf16_t* q2 = (const bf16_t*)(P->ws + WS_Q2); const bf16_t* mk = (const bf16_t*)(P->ws + WS_MK); const bf16_t* mvt = (const bf16_t*)(P->ws + WS_MVT);
    const int row = b * SEQ + qb * 128 + 16 * wave + fr;
    f32x4 s[16];
#pragma unroll
    for (int n = 0; n < 16; ++n) s[n] = (f32x4){0.f, 0.f, 0.f, 0.f};
    u32x4 tmp[4];
#define XLOADK(dcv) { _Pragma("unroll") for (int it = 0; it < 4; ++it) { const int ci = tid + 512 * it, m = ci >> 3, c8 = ci & 7; tmp[it] = *(const u32x4*)(mk + (size_t)(b * 256 + m) * 1024 + h * 256 + (dcv) * 64 + c8 * 8); } }
#define XLOADV(dcv) { _Pragma("unroll") for (int it = 0; it < 4; ++it) { const int ci = tid + 512 * it, d = ci >> 5, c = ci & 31; tmp[it] = *(const u32x4*)(mvt + (size_t)(h * 256 + (dcv) * 64 + d) * 2048 + b * 256 + c * 8); } }
    XLOADK(0)
    for (int dc = 0; dc < 4; ++dc) {
        bf16x8 qf[2];
#pragma unroll
        for (int ks = 0; ks < 2; ++ks) qf[ks] = *(const bf16x8*)(q2 + (size_t)row * 1024 + h * 256 + dc * 64 + ks * 32 + 8 * fq);
        __syncthreads();
#pragma unroll
        for (int it = 0; it < 4; ++it) { const int ci = tid + 512 * it, m = ci >> 3, c8 = ci & 7; *(LAS u32x4*)(KV + m * PK + c8 * 8) = tmp[it]; }
        if (dc < 3) XLOADK(dc + 1) else XLOADV(0)
        __syncthreads();
        mma_areg<16, 2, 0, 2>(s, qf, KV, PK, lane);
    }
    float mx = -INFINITY;
#pragma unroll
    for (int n = 0; n < 16; ++n)
#pragma unroll
        for (int e = 0; e < 4; ++e) { s[n][e] *= 0.0625f; mx = fmaxf(mx, s[n][e]); }
    mx = fmaxf(mx, __shfl_xor(mx, 16)); mx = fmaxf(mx, __shfl_xor(mx, 32));
    float sum = 0.f;
#pragma unroll
    for (int n = 0; n < 16; ++n)
#pragma unroll
        for (int e = 0; e < 4; ++e) { const float ev = __expf(s[n][e] - mx); s[n][e] = ev; sum += ev; }
    sum += __shfl_xor(sum, 16); sum += __shfl_xor(sum, 32);
    const float inv = 1.f / sum;
    bf16x8 pf[8];
#pragma unroll
    for (int ks = 0; ks < 8; ++ks) { u32x4 w; w.x = pk2(s[2 * ks][0] * inv, s[2 * ks][1] * inv); w.y = pk2(s[2 * ks][2] * inv, s[2 * ks][3] * inv);
        w.z = pk2(s[2 * ks + 1][0] * inv, s[2 * ks + 1][1] * inv); w.w = pk2(s[2 * ks + 1][2] * inv, s[2 * ks + 1][3] * inv); pf[ks] = __builtin_bit_cast(bf16x8, w); }
    for (int dc = 0; dc < 4; ++dc) {
        __syncthreads();
#pragma unroll
        for (int it = 0; it < 4; ++it) { const int ci = tid + 512 * it, d = ci >> 5, c = ci & 31; *(LAS u32x4*)(KV + d * PV + c * 8) = tmp[it]; }
        if (dc < 3) XLOADV(dc + 1)
        __syncthreads();
        f32x4 o[4];
#pragma unroll
        for (int n = 0; n < 4; ++n) o[n] = (f32x4){0.f, 0.f, 0.f, 0.f};
#pragma unroll
        for (int ks = 0; ks < 8; ++ks) {
#pragma unroll
            for (int n = 0; n < 4; ++n) {
                const LAS bf16_t* vp = KV + (16 * n + fr) * PV + 32 * ks + 4 * fq;
                const u32x2 a0 = *(const LAS u32x2*)vp, a1 = *(const LAS u32x2*)(vp + 16);
                const u32x4 av = (u32x4){a0.x, a0.y, a1.x, a1.y};
                o[n] = __builtin_amdgcn_mfma_f32_16x16x32_bf16(__builtin_bit_cast(bf16x8, av), pf[ks], o[n], 0, 0, 0);
            }
            __builtin_amdgcn_sched_barrier(0);
        }
        bf16_t* op = (bf16_t*)(P->ws + WS_OX) + (size_t)row * 1024 + h * 256 + dc * 64 + 4 * fq;
#pragma unroll
        for (int n = 0; n < 4; ++n) { u32x2 w2; w2.x = pk2(o[n][0], o[n][1]); w2.y = pk2(o[n][2], o[n][3]); *(u32x2*)(op + 16 * n) = w2; }
    }
#undef XLOADK
#undef XLOADV
    __syncthreads();
}

__device__ __forceinline__ void xattn_prompt2(CP P, LAS unsigned char* lds, int unit, int tid, int wave, int lane) {
    const int b = unit >> 5, h = (unit >> 3) & 3, qb = unit & 7;
    const int fr = lane & 15, fq = lane >> 4;
    LAS bf16_t* KV = (LAS bf16_t*)lds;
    const bf16_t* q2 = (const bf16_t*)(P->ws + WS_Q2); const bf16_t* mk = (const bf16_t*)(P->ws + WS_MK); const bf16_t* mvt = (const bf16_t*)(P->ws + WS_MVT);
    const int row = b * SEQ + qb * 256 + 32 * wave + fr;
    f32x4 s[2][16];
#pragma unroll
    for (int mt = 0; mt < 2; ++mt)
#pragma unroll
        for (int n = 0; n < 16; ++n) s[mt][n] = (f32x4){0.f, 0.f, 0.f, 0.f};
    u32x4 tmp[4];
#define XLOADK(dcv) { _Pragma("unroll") for (int it = 0; it < 4; ++it) { const int ci = tid + 512 * it, m = ci >> 3, c8 = ci & 7; tmp[it] = *(const u32x4*)(mk + (size_t)(b * 256 + m) * 1024 + h * 256 + (dcv) * 64 + c8 * 8); } }
#define XLOADV(dcv) { _Pragma("unroll") for (int it = 0; it < 4; ++it) { const int ci = tid + 512 * it, d = ci >> 5, c = ci & 31; tmp[it] = *(const u32x4*)(mvt + (size_t)(h * 256 + (dcv) * 64 + d) * 2048 + b * 256 + c * 8); } }
    XLOADK(0)
    for (int dc = 0; dc < 4; ++dc) {
        bf16x8 qf[2][2];
#pragma unroll
        for (int mt = 0; mt < 2; ++mt)
#pragma unroll
            for (int ks = 0; ks < 2; ++ks) qf[mt][ks] = __builtin_nontemporal_load((const bf16x8*)(q2 + (size_t)(row + 16 * mt) * 1024 + h * 256 + dc * 64 + ks * 32 + 8 * fq));
        __syncthreads();
#pragma unroll
        for (int it = 0; it < 4; ++it) { const int ci = tid + 512 * it, m = ci >> 3, c8 = ci & 7; *(LAS u32x4*)(KV + m * PK + c8 * 8) = tmp[it]; }
        if (dc < 3) XLOADK(dc + 1)
        __syncthreads();
#pragma unroll
        for (int ks = 0; ks < 2; ++ks) {
#pragma unroll
            for (int n = 0; n < 16; ++n) {
                const bf16x8 bfr = *(const LAS bf16x8*)(KV + (16 * n + fr) * PK + ks * 32 + 8 * fq);
                s[0][n] = __builtin_amdgcn_mfma_f32_16x16x32_bf16(bfr, qf[0][ks], s[0][n], 0, 0, 0);
                s[1][n] = __builtin_amdgcn_mfma_f32_16x16x32_bf16(bfr, qf[1][ks], s[1][n], 0, 0, 0);
                if ((n & 3) == 3) __builtin_amdgcn_sched_barrier(0);
            }
        }
    }
    bf16x8 pf[2][8];
#pragma unroll
    for (int mt = 0; mt < 2; ++mt) {
        float mx = -INFINITY;
#pragma unroll
        for (int n = 0; n < 16; ++n)
#pragma unroll
            for (int e = 0; e < 4; ++e) { s[mt][n][e] *= 0.0625f; mx = fmaxf(mx, s[mt][n][e]); }
        mx = fmaxf(mx, __shfl_xor(mx, 16)); mx = fmaxf(mx, __shfl_xor(mx, 32));
        float sum = 0.f;
#pragma unroll
        for (int n = 0; n < 16; ++n)
#pragma unroll
            for (int e = 0; e < 4; ++e) { const float ev = __expf(s[mt][n][e] - mx); s[mt][n][e] = ev; sum += ev; }
        sum += __shfl_xor(sum, 16); sum += __shfl_xor(sum, 32);
        const float inv = 1.f / sum;
#pragma unroll
        for (int ks = 0; ks < 8; ++ks) { u32x4 w; w.x = pk2(s[mt][2 * ks][0] * inv, s[mt][2 * ks][1] * inv); w.y = pk2(s[mt][2 * ks][2] * inv, s[mt][2 * ks][3] * inv);
            w.z = pk2(s[mt][2 * ks + 1][0] * inv, s[mt][2 * ks + 1][1] * inv); w.w = pk2(s[mt][2 * ks + 1][2] * inv, s[mt][2 * ks + 1][3] * inv); pf[mt][ks] = __builtin_bit_cast(bf16x8, w); }
    }
    XLOADV(0)
    for (int dc = 0; dc < 4; ++dc) {
        __syncthreads();
#pragma unroll
        for (int it = 0; it < 4; ++it) { const int ci = tid + 512 * it, d = ci >> 5, c = ci & 31; *(LAS u32x4*)(KV + d * PV + c * 8) = tmp[it]; }
        if (dc < 3) XLOADV(dc + 1)
        __syncthreads();
        f32x4 o[2][4];
#pragma unroll
        for (int mt = 0; mt < 2; ++mt)
#pragma unroll
            for (int n = 0; n < 4; ++n) o[mt][n] = (f32x4){0.f, 0.f, 0.f, 0.f};
#pragma unroll
        for (int ks = 0; ks < 8; ++ks) {
#pragma unroll
            for (int n = 0; n < 4; ++n) {
                const LAS bf16_t* vp = KV + (16 * n + fr) * PV + 32 * ks + 4 * fq;
                const u32x2 a0 = *(const LAS u32x2*)vp, a1 = *(const LAS u32x2*)(vp + 16);
                const bf16x8 av = __builtin_bit_cast(bf16x8, (u32x4){a0.x, a0.y, a1.x, a1.y});
                o[0][n] = __builtin_amdgcn_mfma_f32_16x16x32_bf16(av, pf[0][ks], o[0][n], 0, 0, 0);
                o[1][n] = __builtin_amdgcn_mfma_f32_16x16x32_bf16(av, pf[1][ks], o[1][n], 0, 0, 0);
            }
            __builtin_amdgcn_sched_barrier(0);
        }
        asm volatile("s_nop 7\n\ts_nop 7\n\ts_nop 7" ::: "memory");
#pragma unroll
        for (int mt = 0; mt < 2; ++mt) {
            bf16_t* op = (bf16_t*)(P->ws + WS_OX) + (size_t)(row + 16 * mt) * 1024 + h * 256 + dc * 64 + 4 * fq;
#pragma unroll
            for (int n = 0; n < 4; ++n) { u32x2 w2; w2.x = pk2(o[mt][n][0], o[mt][n][1]); w2.y = pk2(o[mt][n][2], o[mt][n][3]); *(u32x2*)(op + 16 * n) = w2; }
        }
    }
#undef XLOADK
#undef XLOADV
    __syncthreads();
}

__device__ __forceinline__ void xattn_sample(CP P, LAS unsigned char* lds, int unit, int tid, int wave, int lane) {
    const int b = unit >> 2, h = unit & 3, row0 = TP + b * 4;
    LAS float* sc = (LAS float*)lds;
    LAS float* red = sc + 1024;
    const bf16_t* q2 = (const bf16_t*)(P->ws + WS_Q2);
    const float* kb = P->in[6] + ((size_t)(b * 256) * 4 + h) * 256;
    const float* vb = P->in[7] + ((size_t)(b * 256) * 4 + h) * 256 + 4 * lane;
    {
        const int fr = lane & 15, fq = lane >> 4;
        bf16x8 qf[8];
#pragma unroll
        for (int ks = 0; ks < 8; ++ks) { u32x4 z = (u32x4){0u, 0u, 0u, 0u}; if (fr < 4) z = *(const u32x4*)(q2 + (size_t)(row0 + fr) * 1024 + h * 256 + ks * 32 + 8 * fq); qf[ks] = __builtin_bit_cast(bf16x8, z); }
#pragma unroll
        for (int mt = 0; mt < 2; ++mt) {
            const int m0 = 32 * wave + 16 * mt; const float* kr = kb + (size_t)(m0 + fr) * 1024 + 8 * fq;
            f32x4 kv[16];
#pragma unroll
            for (int ks = 0; ks < 8; ++ks) { kv[2 * ks] = __builtin_nontemporal_load((const f32x4*)(kr + ks * 32)); kv[2 * ks + 1] = __builtin_nontemporal_load((const f32x4*)(kr + ks * 32 + 4)); }
            f32x4 acc = (f32x4){0.f, 0.f, 0.f, 0.f};
#pragma unroll
            for (int ks = 0; ks < 8; ++ks) { u32x4 a; a.x = pk2(kv[2 * ks][0], kv[2 * ks][1]); a.y = pk2(kv[2 * ks][2], kv[2 * ks][3]); a.z = pk2(kv[2 * ks + 1][0], kv[2 * ks + 1][1]); a.w = pk2(kv[2 * ks + 1][2], kv[2 * ks + 1][3]);
                acc = __builtin_amdgcn_mfma_f32_16x16x32_bf16(__builtin_bit_cast(bf16x8, a), qf[ks], acc, 0, 0, 0); }
            if (fr < 4) *(LAS f32x4*)(sc + fr * 256 + m0 + 4 * fq) = acc * 0.0625f;
        }
    }
    __syncthreads();
    if (wave < 4) {
        float v[4]; float mx = -INFINITY;
#pragma unroll
        for (int j = 0; j < 4; ++j) { v[j] = sc[wave * 256 + lane + 64 * j]; mx = fmaxf(mx, v[j]); }
        mx = wave_max(mx); float sum = 0.f;
#pragma unroll
        for (int j = 0; j < 4; ++j) { v[j] = __expf(v[j] - mx); sum += v[j]; }
        const float inv = 1.f / wave_sum(sum);
#pragma unroll
        for (int j = 0; j < 4; ++j) sc[wave * 256 + lane + 64 * j] = v[j] * inv;
    }
    __syncthreads();
    f32x4 acc[4];
#pragma unroll
    for (int tt = 0; tt < 4; ++tt) acc[tt] = (f32x4){0.f, 0.f, 0.f, 0.f};
#pragma unroll 8
    for (int i = 0; i < 32; ++i) {
        const int m = 32 * wave + i; const f32x4 v = __builtin_nontemporal_load((const f32x4*)(vb + (size_t)m * 1024));
#pragma unroll
        for (int tt = 0; tt < 4; ++tt) acc[tt] += v * sc[tt * 256 + m];
    }
#pragma unroll
    for (int tt = 0; tt < 4; ++tt) *(LAS f32x4*)(red + (wave * 4 + tt) * 256 + 4 * lane) = acc[tt];
    __syncthreads();
    for (int kk_ = 0; kk_ < 2; ++kk_) { const int i = tid + 512 * kk_; float s = 0.f;
#pragma unroll
        for (int w = 0; w < 8; ++w) s += red[w * 1024 + i];
        const int tt = i >> 8, d = i & 255; ((bf16_t*)(P->ws + WS_OX))[(size_t)(row0 + tt) * 1024 + h * 256 + d] = f2bf(s); }
    __syncthreads();
}

__device__ __forceinline__ void skinny_gemm(const bf16_t* A, const bf16_t* Wt, bf16_t* C, int K, int bid, int G, int wave, int lane) {
    const int fr = lane & 15, fq = lane >> 4;
    for (int t = bid; t < 256; t += G) {
        const int r0 = TP + 32 * (t & 15) + 16 * (wave & 1), c0 = 64 * (t >> 4) + 16 * (wave >> 1);
        const bf16_t* ap = A + (size_t)(r0 + fr) * K + 8 * fq; const bf16_t* bp = Wt + (size_t)(c0 + fr) * K + 8 * fq;
        f32x4 acc = (f32x4){0.f, 0.f, 0.f, 0.f};
        for (int kb = 0; kb < K; kb += 512) {
            bf16x8 av[16], bv[16];
#pragma unroll
            for (int j = 0; j < 16; ++j) { av[j] = *(const bf16x8*)(ap + kb + 32 * j); bv[j] = *(const bf16x8*)(bp + kb + 32 * j); }
#pragma unroll
            for (int j = 0; j < 16; ++j) acc = __builtin_amdgcn_mfma_f32_16x16x32_bf16(bv[j], av[j], acc, 0, 0, 0);
        }
        __builtin_amdgcn_sched_barrier(0);
        asm volatile("s_nop 7\n\ts_nop 7\n\ts_nop 7" ::: "memory");
        u32x2 w; w.x = pk2(acc[0], acc[1]); w.y = pk2(acc[2], acc[3]);
        *(u32x2*)(C + (size_t)(r0 + fr) * 1024 + c0 + 4 * fq) = w;
    }
}

__device__ __forceinline__ void copy_caches(CP P, int part, int t0_, int NT_) {
    unsigned char* ws = P->ws; const bf16_t* proj = (const bf16_t*)(ws + WS_PROJ);
    if (part == 0) {
        for (int base_ = 0; base_ < 2048 * 1024 / 4; base_ += 4 * NT_) {
            u32x2 a[4], c[4];
#pragma unroll
            for (int k = 0; k < 4; ++k) { const int i = base_ + k * NT_ + t0_; a[k] = (u32x2){0u, 0u}; c[k] = a[k]; if (i < 2048 * 1024 / 4) { a[k] = ((const u32x2*)(ws + WS_MK))[i]; c[k] = ((const u32x2*)(ws + WS_MV))[i]; } }
#pragma unroll
            for (int k = 0; k < 4; ++k) { const int i = base_ + k * NT_ + t0_; if (i < 2048 * 1024 / 4) {
                ((f32x4*)(P->out + O_PMK))[i] = (f32x4){__uint_as_float(a[k].x << 16), __uint_as_float(a[k].x & 0xffff0000u), __uint_as_float(a[k].y << 16), __uint_as_float(a[k].y & 0xffff0000u)};
                ((f32x4*)(P->out + O_PMV))[i] = (f32x4){__uint_as_float(c[k].x << 16), __uint_as_float(c[k].x & 0xffff0000u), __uint_as_float(c[k].y << 16), __uint_as_float(c[k].y & 0xffff0000u)}; } }
        }
        for (int base_ = 0; base_ < 8 * 128 * 128; base_ += NT_) { const int i = base_ + t0_; if (i >= 8 * 128 * 128) continue; const int b = i >> 14, r = (i >> 7) & 127, cidx = i & 127;
            const bf16_t* pr = proj + (size_t)(b * SEQ + 1920 + r) * NPROJ + cidx; P->out[O_PWK + i] = bf2f(pr[2048]); P->out[O_PWV + i] = bf2f(pr[2176]); }
        for (int base_ = 0; base_ < 128 * 4 * 128; base_ += NT_) { const int j = base_ + t0_; if (j >= 128 * 4 * 128) continue; const int b = j >> 9, t = (j >> 7) & 3, cidx = j & 127;
            const bf16_t* pr = proj + (size_t)(TP + b * 4 + t) * NPROJ + cidx; const size_t o = (size_t)(b * 128 + 124 + t) * 128 + cidx; P->out[O_SWK + o] = bf2f(pr[2048]); P->out[O_SWV + o] = bf2f(pr[2176]); }
    } else {
        for (int base_ = 0; base_ < 128 * 124 * 32; base_ += 4 * NT_) {
            f32x4 kv[4], vv[4];
#pragma unroll
            for (int k = 0; k < 4; ++k) { const int j = base_ + k * NT_ + t0_; kv[k] = (f32x4){0.f, 0.f, 0.f, 0.f}; vv[k] = kv[k];
                if (j < 128 * 124 * 32) { const int b = j / (124 * 32), rem = j - b * (124 * 32); const size_t i = (size_t)b * 16384 + 4 * rem; kv[k] = __builtin_nontemporal_load((const f32x4*)(P->in[4] + i + 512)); vv[k] = __builtin_nontemporal_load((const f32x4*)(P->in[5] + i + 512)); } }
#pragma unroll
            for (int k = 0; k < 4; ++k) { const int j = base_ + k * NT_ + t0_;
                if (j < 128 * 124 * 32) { const int b = j / (124 * 32), rem = j - b * (124 * 32); const size_t i = (size_t)b * 16384 + 4 * rem; *(f32x4*)(P->out + O_SWK + i) = kv[k]; *(f32x4*)(P->out + O_SWV + i) = vv[k]; } }
        }
    }
}

#define XB_TMO      128
#define XB_XCNT(j)  (256  + 64 * (j))
#define XB_XSUB(j)  (1280 + 64 * (j))
#define XB_XGEN(j)  (2304 + 64 * (j))
#define XB_TOP      3328
#define XB_TOPGEN   3392
#define XCD_BAR_WORDS 3456
#define XB_SPIN_CAP (1u << 18)

__device__ __forceinline__ unsigned xb_ld(unsigned* p)              { return __hip_atomic_load(p, __ATOMIC_RELAXED, __HIP_MEMORY_SCOPE_AGENT); }
__device__ __forceinline__ unsigned xb_add(unsigned* p, unsigned v) { return __hip_atomic_fetch_add(p, v, __ATOMIC_RELAXED, __HIP_MEMORY_SCOPE_AGENT); }
__device__ __forceinline__ unsigned xb_xcc_id() { return (unsigned)__builtin_amdgcn_s_getreg((3 << 11) | 20) & 0xFu; }
#define XB_SPIN(cond, bar) do { unsigned _sp = 0; while (cond) { __builtin_amdgcn_s_sleep(1); \
    if ((++_sp & 255u) == 0u) { if (xb_ld(&(bar)[XB_TMO])) break; if (_sp > XB_SPIN_CAP) { atomicAdd(&(bar)[XB_TMO], 1u); break; } } } } while (0)

struct XcdBarrier {
    unsigned* bar; unsigned x;
    volatile LAS unsigned* st;
};

__device__ __forceinline__ XcdBarrier xcd_barrier_post(unsigned* bar, volatile LAS unsigned* st) {
    XcdBarrier b; b.bar = bar; b.x = xb_xcc_id(); b.st = st;
    if (threadIdx.x == 0) (void)xb_add(&bar[XB_XCNT(b.x)], 1u);
    return b;
}
__device__ __forceinline__ void xcd_barrier_complete(unsigned* bar, unsigned x, unsigned& nloc, unsigned& nx) {
    const unsigned G = gridDim.x * gridDim.y * gridDim.z;
    unsigned sum, cnt, mine, sp = 0u;
    for (;;) {
        sum = 0u; cnt = 0u; mine = 0u;
#pragma unroll
        for (unsigned j = 0; j < 16; ++j) { const unsigned c = xb_ld(&bar[XB_XCNT(j)]); sum += c; cnt += (c > 0u) ? 1u : 0u; mine = (j == x) ? c : mine; }
        if (sum == G) break;
        __builtin_amdgcn_s_sleep(1);
        if ((++sp & 255u) == 0u) { if (xb_ld(&bar[XB_TMO])) break; if (sp > XB_SPIN_CAP) { atomicAdd(&bar[XB_TMO], 1u); break; } }
    }
    nloc = mine > 0u ? mine : 1u; nx = cnt > 0u ? cnt : 1u;
}

__device__ __forceinline__ void xcd_barrier(const XcdBarrier& b) {
    asm volatile("s_waitcnt vmcnt(0)" ::: "memory");
    __syncthreads();
    if (threadIdx.x == 0) {
        unsigned* bar = b.bar;
        __builtin_amdgcn_s_waitcnt(0);
        unsigned nloc = b.st[0], nx = b.st[1];
        if (nloc == 0u) { xcd_barrier_complete(bar, b.x, nloc, nx); b.st[0] = nloc; b.st[1] = nx; }
        const unsigned old = xb_add(&bar[XB_XSUB(b.x)], 1u);
        const unsigned gen = old / nloc;
        if (old + 1u == (gen + 1u) * nloc) {
            __builtin_amdgcn_fence(__ATOMIC_RELEASE, "agent");
            asm volatile("s_waitcnt vmcnt(0)" ::: "memory");
            const unsigned og = xb_add(&bar[XB_TOP], 1u);
            const unsigned tg = og / nx;
            if (og + 1u == (tg + 1u) * nx) xb_add(&bar[XB_TOPGEN], 1u);
            else XB_SPIN(xb_ld(&bar[XB_TOPGEN]) == tg, bar);
            __builtin_amdgcn_fence(__ATOMIC_ACQUIRE, "agent");
            xb_add(&bar[XB_XGEN(b.x)], 1u);
            asm volatile("s_waitcnt vmcnt(0)" ::: "memory");
        } else {
            XB_SPIN(xb_ld(&bar[XB_XGEN(b.x)]) == gen, bar);
            __builtin_amdgcn_fence(__ATOMIC_ACQUIRE, "agent");
            asm volatile("s_waitcnt vmcnt(0)" ::: "memory");
        }
    }
    __syncthreads();
}

constexpr int NPHASE = 13;
#ifndef SKN
#define SKN 2
#endif
#ifndef MK_MULTI
#define MK_MULTI 0
#endif
#ifndef TSW
#define TSW 0
#endif
__global__ void __launch_bounds__(512, 2) mk_fwd(Params P_) {
    CP P = (CP)__builtin_amdgcn_kernarg_segment_ptr(); asm volatile("" : "+s"(P));
    extern __shared__ __attribute__((aligned(16))) unsigned char lds_raw[];
    LAS unsigned char* lds = (LAS unsigned char*)lds_raw;
    const int G = gridDim.x, bid = blockIdx.x;
    volatile LAS unsigned* bar_st = (volatile LAS unsigned*)(lds + LDS_BYTES - 16);
    if (threadIdx.x < 4) bar_st[threadIdx.x] = 0u;
    __syncthreads();
    XcdBarrier xbar = xcd_barrier_post((unsigned*)P_.ws, bar_st);
#define TLW CP P = (CP)__builtin_amdgcn_kernarg_segment_ptr(); asm volatile("" : "+s"(P)); unsigned char* ws = P->ws; (void)ws; int tid = threadIdx.x; asm volatile("" : "+v"(tid)); const int lane = tid & 63, wave = __builtin_amdgcn_readfirstlane(tid >> 6); const int gw = bid * 8 + wave, NGW = G * 8; (void)gw; (void)NGW; (void)lane;
    unsigned char* ws = P->ws;
    const int lo = P->ph_lo, hi = P->ph_hi;
#ifndef PHMASK
#define PHMASK 0xffff
#endif
#define IN(k) (((PHMASK >> (k)) & 1) && lo <= (k) && (k) < hi)
#ifndef REP_PHASE
#define REP_PHASE -1
#endif
#define NREP(k) ((k) == REP_PHASE ? 2 : 1)
#define SEAM(k) do { if (IN(k) && IN((k) + 1)) xcd_barrier(xbar); } while (0)
    bf16_t* R = (bf16_t*)(ws + WS_R);
#ifdef DUMP_BUF
    if (lo == 100) { TLW const bf16_t* src = (const bf16_t*)(ws + DUMP_BUF);
        for (size_t i = (size_t)bid * 512 + tid; i < (size_t)TT * 1024; i += (size_t)G * 512) { float v = bf2f(src[i]); if (!(fabsf(v) < 1e30f)) v = 12345.f; P->out[i] = v; } }
#endif

    if (IN(0)) for (int rep = 0; rep < NREP(0); ++rep) { TLW phase_prologue(P, lds, gw, NGW, wave, lane); }
    SEAM(0);
    if (IN(1)) {
        pg8::Gemm g{R, R, 0, 0, 1024}; Order S{754, G, bid, 0, 0};
        EpiP1 E{(bf16_t*)(ws + WS_PROJ), (bf16_t*)(ws + WS_MK), (bf16_t*)(ws + WS_MV), (bf16_t*)(ws + WS_MVT), (bf16_t*)(ws + WS_KVT)};
        pg8::gemm_phase<EpiP1, Order, true, true>(lds, g, S, E);
    }
    SEAM(1);
    if (IN(2)) for (int rep = 0; rep < NREP(2); ++rep) {
        TLW
        if (!(TSW & 4)) for (int u = bid; u < 256; u += G) ssd_pass_a(P, lds, u, tid, wave, lane);
        if (!(TSW & 8)) for (int u = bid; u < 256; u += G) swa_prompt(P, lds, u, tid, wave, lane);
        if (!(TSW & 16)) for (int u = bid; u < 256; u += G) ssd_sample(P, lds, u, tid, wave, lane);
        if (!(TSW & 32)) for (int u = bid; u < 256; u += G) swa_sample(P, lds, u, tid, wave, lane);
    }
    SEAM(2);
    if (IN(3)) { { TLW ssd_state_scan(P, bid, G, tid); } xcd_barrier(xbar); }
    if (IN(3)) for (int rep = 0; rep < NREP(3); ++rep) { TLW for (int u = bid; u < 256; u += G) ssd_pass_b(P, lds, u, tid, wave, lane); }
    SEAM(3);
    if (IN(4)) for (int rep = 0; rep < NREP(4); ++rep) {
        pg8::Gemm g{(const bf16_t*)(ws + WS_MIXIN), (const bf16_t*)(ws + WS_WOUT), TT, 1024, 1024}; Order S{272, G, bid, 3, 16};
        EpiBf E{(bf16_t*)(ws + WS_CB16), 1024, 1.f, (float*)(ws + WS_SPLIT)};
        pg8::gemm_phase<EpiBf, Order, true, true>(lds, g, S, E);
        if (bid + G >= 272 && rep == 0) { TLW const int nb_ = G - (272 - G > 0 ? 272 - G : 0); tr_items(P, lds, 1, (bid - (G - nb_)) * 8 + wave, nb_ * 8, wave, lane); }
        if ((SKN >> 0) & 1) { TLW skinny_gemm((const bf16_t*)(ws + WS_MIXIN), (const bf16_t*)(ws + WS_WOUT), (bf16_t*)(ws + WS_CB16), 1024, bid, G, wave, lane); }
    }
    SEAM(4);
#ifdef SYNC_EXTRA
    for (int r_ = 0; r_ < SYNC_EXTRA; ++r_) cg::this_grid().sync();
#endif
    if (IN(5)) for (int rep = 0; rep < NREP(5); ++rep) { TLW phase_resid(P, 0, gw, NGW, lane); }
    SEAM(5);
    if (IN(6)) {
        pg8::Gemm g{(const bf16_t*)(ws + WS_H0), (const bf16_t*)(ws + WS_WXQ), TT, 1024, 1024}; Order S{256, G, bid, 1, 4};
        EpiBf E{(bf16_t*)(ws + WS_Q2), 1024, 1.f, nullptr};
        pg8::gemm_phase<EpiBf, Order, true, true>(lds, g, S, E);
        if ((SKN >> 1) & 1) { TLW skinny_gemm((const bf16_t*)(ws + WS_H0), (const bf16_t*)(ws + WS_WXQ), (bf16_t*)(ws + WS_Q2), 1024, bid, G, wave, lane); }
    }
    SEAM(6);
    if (IN(7)) for (int rep = 0; rep < NREP(7); ++rep) {
        TLW
        if ((bid >> 3) & 1) { for (int u = bid; u < 256; u += G) xattn_prompt2(P, lds, u, tid, wave, lane); }
        for (int u = bid; u < 512; u += G) xattn_sample(P, lds, u, tid, wave, lane);
        if (!((bid >> 3) & 1)) { for (int u = bid; u < 256; u += G) xattn_prompt2(P, lds, u, tid, wave, lane); }
    }
    SEAM(7);
    if (IN(8)) {
        pg8::Gemm g{(const bf16_t*)(ws + WS_OX), (const bf16_t*)(ws + WS_WXO), TT, 1024, 1024}; Order S{272, G, bid, 3, 16};
        EpiBf E{(bf16_t*)(ws + WS_CB16), 1024, 1.f, (float*)(ws + WS_SPLIT) + 8 * 512 * 1024};
        pg8::gemm_phase<EpiBf, Order, true, true>(lds, g, S, E);
        { TLW const int first_ = G > 16 ? 16 : 0; if (bid >= first_) copy_caches(P, 0, (bid - first_) * 512 + tid, (G - first_) * 512); }
        if ((SKN >> 2) & 1) { TLW skinny_gemm((const bf16_t*)(ws + WS_OX), (const bf16_t*)(ws + WS_WXO), (bf16_t*)(ws + WS_CB16), 1024, bid, G, wave, lane); }
    }
    SEAM(8);
    if (IN(9)) { TLW phase_resid(P, 1, gw, NGW, lane); }
    SEAM(9);
    if (IN(10)) for (int rep = 0; rep < NREP(10); ++rep) {
        pg8::Gemm g{(const bf16_t*)(ws + WS_H0), (const bf16_t*)(ws + WS_WGU), TT, 2 * DFF, 1024}; Order S{66 * 22, G, bid, 1, 22};
        EpiGU E{(bf16_t*)(ws + WS_ACT)};
        pg8::gemm_phase<EpiGU, Order, true, true>(lds, g, S, E);
    }
    SEAM(10);
    if (IN(11)) for (int rep = 0; rep < NREP(11); ++rep) {
        pg8::Gemm g{(const bf16_t*)(ws + WS_ACT), (const bf16_t*)(ws + WS_WDN), TT, 1024, DFF}; Order S{288, G, bid, 2, 44};
        EpiBf E{(bf16_t*)(ws + WS_CB16), 1024, 1.f, (float*)(ws + WS_SPLIT) + 12 * 512 * 1024};
        pg8::gemm_phase<EpiBf, Order, true, true>(lds, g, S, E);
        if (rep == 0) { TLW const int first_ = G > 32 ? 32 : 0; if (bid >= first_) copy_caches(P, 1, (bid - first_) * 512 + tid, (G - first_) * 512); }
        if ((SKN >> 3) & 1) { TLW skinny_gemm((const bf16_t*)(ws + WS_ACT), (const bf16_t*)(ws + WS_WDN), (bf16_t*)(ws + WS_CB16), DFF, bid, G, wave, lane); }
    }
    SEAM(11);
    if (IN(12)) { TLW phase_resid(P, 2, gw, NGW, lane); }
#undef IN
#undef SEAM
}

#ifndef MK_MULTI
#define MK_MULTI 0
#endif
#ifndef NPH_RUN
#define NPH_RUN 13
#endif
extern "C" void kernel_launch(void* const* d_in, const int* in_sizes, int n_in, void* d_out, int out_size, void* d_ws, size_t ws_size, hipStream_t stream) {
    static int grid = 0;
    if (grid == 0) {
        if (n_in != 32 || ws_size < WS_END) { fprintf(stderr, "kernel_launch: n_in %d ws %zu (need %zu)\n", n_in, ws_size, (size_t)WS_END); grid = -1; return; }
        int dev = 0, cus = 0, per_cu = 0;
        hipGetDevice(&dev); hipDeviceGetAttribute(&cus, hipDeviceAttributeMultiprocessorCount, dev);
        hipFuncSetAttribute((const void*)mk_fwd, hipFuncAttributeMaxDynamicSharedMemorySize, LDS_BYTES);
        hipOccupancyMaxActiveBlocksPerMultiprocessor(&per_cu, (const void*)mk_fwd, 512, LDS_BYTES);
        if (per_cu < 1) { fprintf(stderr, "kernel_launch: occupancy query says %d blocks per CU\n", per_cu); per_cu = 1; }
        grid = cus;
        (void)hipGetLastError();
    }
    if (grid < 0) return;
    (void)hipMemsetAsync(d_ws, 0, 16384, stream);
    Params p{};
    for (int i = 0; i < 32; ++i) p.in[i] = (const float*)d_in[i];
    p.out = (float*)d_out; p.ws = (unsigned char*)d_ws;
#if MK_MULTI
    for (int ph = 0; ph < NPH_RUN; ++ph) { p.ph_lo = ph; p.ph_hi = ph + 1; hipLaunchKernelGGL(mk_fwd, dim3(grid), dim3(512), LDS_BYTES, stream, p); }
#ifdef DUMP_BUF
    p.ph_lo = 100; p.ph_hi = 100; hipLaunchKernelGGL(mk_fwd, dim3(grid), dim3(512), LDS_BYTES, stream, p);
#endif
#else
    p.ph_lo = 0; p.ph_hi = NPHASE;
    void* args[] = {&p};
    hipError_t e = hipLaunchCooperativeKernel((const void*)mk_fwd, dim3(grid), dim3(512), args, LDS_BYTES, stream);
    if (e != hipSuccess) fprintf(stderr, "cooperative launch failed: %s (grid %d)\n", hipGetErrorString(e), grid);
#endif
}
```

```cpp
#include <hip/hip_runtime.h>
#include <hip/hip_cooperative_groups.h>
#include <cstdio>
#include <cstdint>
namespace cg = cooperative_groups;
namespace pg8 {
#define PG8_LAS __attribute__((address_space(3)))
typedef unsigned short bf16_t;
typedef short bf16x8 __attribute__((ext_vector_type(8)));
typedef float f32x4 __attribute__((ext_vector_type(4)));
typedef unsigned u32x4 __attribute__((ext_vector_type(4)));
constexpr int BM = 256, BK = 64, HALF = 128, HTB = HALF * BK * 2  , STAGE_BYTES = 8 * HTB, NXCD = 8, WGM = 8;

__host__ __device__ __forceinline__ int lds_byte(int r, int c) { const int st = (r >> 4) * 2 + (c >> 5), rr = r & 15, cc = c & 31, ob = rr * 64 + cc * 2; return st * 1024 + (ob ^ (((ob >> 9) & 1) << 5)); }
__host__ __device__ __forceinline__ void stage_rc(int b, int& R, int& C) { const int st = b / 1024, sb = b % 1024, swz = sb ^ (((sb >> 9) & 1) << 5); R = (st >> 1) * 16 + swz / 64; C = (st & 1) * 32 + (swz % 64) / 2; }
__host__ __device__ __forceinline__ int perm32(int rho) { const int n = rho >> 4, i = rho & 15; return 8 * (i >> 2) + 4 * n + (i & 3); }

struct Unit { int pm, pn, kofs, nt, q; };
struct Gemm { const bf16_t* A; const bf16_t* Bt; int M, N, K; };

struct StaticOrder {
    int nM, nN, nwg, G, c;
    __host__ __device__ void init(int M, int N, int G_, int c_) { nM = M / BM; nN = N / BM; nwg = nM * nN; G = G_; c = c_; }
    __host__ __device__ bool next(int i, Unit& u) const {
        const long L = (long)i * G + c; if (L >= nwg) return false;
        int wgid = (int)L; { const int q = nwg / NXCD, r = nwg % NXCD, xcd = wgid % NXCD, off = wgid / NXCD; wgid = (xcd < r ? xcd * (q + 1) : r * (q + 1) + (xcd - r) * q) + off; }
        const int nig = WGM * nN, gid = wgid / nig, fm = gid * WGM, gsz = (nM - fm) < WGM ? (nM - fm) : WGM;
        u.pm = fm + ((wgid % nig) % gsz); u.pn = (wgid % nig) / gsz; return true;
    }
    __device__ __forceinline__ void a_ready(const Unit&) const {}
    __device__ __forceinline__ void done(const Unit&) const {}
};

__device__ __forceinline__ unsigned cvt_pk_bf16(float lo, float hi) { unsigned r; asm volatile("v_cvt_pk_bf16_f32 %0, %1, %2" : "=v"(r) : "v"(lo), "v"(hi)); return r; }
typedef float f32x2 __attribute__((ext_vector_type(2)));
template <class Epi, class Sched, bool ALIGN_EPI = false, bool SP2 = false>
__device__ __forceinline__ void gemm_phase(PG8_LAS unsigned char* lds, const Gemm g, const Sched& S, const Epi& E) {
    int tid_ = threadIdx.x; asm volatile("" : "+v"(tid_));
    const int tid = tid_, wid = __builtin_amdgcn_readfirstlane(tid >> 6), lane = tid & 63, wr = wid >> 2, wc = wid & 3, fr = lane & 15, fq = lane >> 4;
    const int K = g.K; int nt = K / BK;
    unsigned voffA[2], voffB[2];
#pragma unroll
    for (int i = 0; i < 2; ++i) { int R, C; stage_rc(tid * 16 + i * 8192, R, C); const int Rb = Epi::PERM ? ((R & ~31) + perm32(R & 31)) : R;
        voffA[i] = (unsigned)(R * K + C) * 2u; voffB[i] = (unsigned)(Rb * K + C) * 2u; }
    const size_t kstep = (size_t)(BK * 2);
    const size_t hstep = (size_t)HALF * K * 2;
    const size_t tstep = 2 * hstep;
    const unsigned ldsw = (unsigned)wid * 1024u;
    const int aoff = lds_byte(wr * 64 + fr, fq * 8), boff = lds_byte(wc * 32 + fr, fq * 8);
#define PG8_SA(b, h) (((b) * 2 + (h)) * HTB)
#define PG8_SB(b, h) ((4 + (b) * 2 + (h)) * HTB)
#define PG8_STAGE(bufoff, gbase, voff) do { _Pragma("unroll") for (int _i = 0; _i < 2; ++_i) \
        __builtin_amdgcn_global_load_lds((const unsigned*)((const char*)(gbase) + (voff)[_i]), (PG8_LAS unsigned*)(lds + (bufoff) + ldsw + _i * 8192), 16, 0, 0); } while (0)
#define PG8_LDA(dst, b, h) do { _Pragma("unroll") for (int m = 0; m < 4; ++m) _Pragma("unroll") for (int k = 0; k < 2; ++k) dst[m][k] = *(const PG8_LAS bf16x8*)(lds + PG8_SA(b, h) + aoff + m * 2048 + k * 1024); } while (0)
#define PG8_LDB(dst, b, h) do { _Pragma("unroll") for (int n = 0; n < 2; ++n) _Pragma("unroll") for (int k = 0; k < 2; ++k) dst[n][k] = *(const PG8_LAS bf16x8*)(lds + PG8_SB(b, h) + boff + n * 2048 + k * 1024); } while (0)
#define PG8_MMA(ai, bj, At, Bt) do { __builtin_amdgcn_s_setprio(1); _Pragma("unroll") for (int m = 0; m < 4; ++m) _Pragma("unroll") for (int n = 0; n < 2; ++n) _Pragma("unroll") for (int k = 0; k < 2; ++k) \
        acc[ai][bj][m][n] = __builtin_amdgcn_mfma_f32_16x16x32_bf16(Bt[n][k], At[m][k], acc[ai][bj][m][n], 0, 0, 0); __builtin_amdgcn_s_setprio(0); } while (0)
#define PG8_WAIT_V(n) asm volatile("s_waitcnt vmcnt(" #n ")" ::: "memory")
#define PG8_WAIT_L(n) asm volatile("s_waitcnt lgkmcnt(" #n ")" ::: "memory")
#define PG8_BAR __builtin_amdgcn_s_barrier()
#define PG8_SCHED __builtin_amdgcn_sched_barrier(0)
    Unit cur, nxt; int ui = 0;
    if (!S.next(0, cur)) return;
    f32x4 acc[2][2][4][2];
#pragma unroll
    for (int a = 0; a < 2; ++a)
#pragma unroll
        for (int b = 0; b < 2; ++b)
#pragma unroll
            for (int m = 0; m < 4; ++m)
#pragma unroll
                for (int n = 0; n < 2; ++n) acc[a][b][m][n] = (f32x4){0.f, 0.f, 0.f, 0.f};
    bf16x8 At[4][2], B0[2][2], B1[2][2];
    const char* cA = (const char*)g.A + (size_t)cur.pm * tstep + (size_t)cur.kofs * 2; const char* cB = (const char*)g.Bt + (size_t)cur.pn * tstep + (size_t)cur.kofs * 2;
    if (cur.nt) nt = cur.nt;
    S.a_ready(cur);
    if constexpr (SP2) {
        PG8_STAGE(PG8_SB(0, 0), cB, voffB); PG8_STAGE(PG8_SB(0, 1), cB + hstep, voffB); PG8_STAGE(PG8_SA(0, 0), cA, voffA); PG8_STAGE(PG8_SA(0, 1), cA + hstep, voffA);
        if (wr == 1) PG8_BAR;
        PG8_WAIT_V(2); PG8_BAR;
        PG8_STAGE(PG8_SB(1, 0), cB + kstep, voffB); PG8_STAGE(PG8_SA(1, 0), cA + kstep, voffA); PG8_STAGE(PG8_SB(1, 1), cB + hstep + kstep, voffB);
        PG8_WAIT_V(6); PG8_BAR;
    } else {
        PG8_STAGE(PG8_SB(0, 0), cB, voffB); PG8_STAGE(PG8_SA(0, 0), cA, voffA); PG8_STAGE(PG8_SB(0, 1), cB + hstep, voffB); PG8_STAGE(PG8_SA(0, 1), cA + hstep, voffA);
        if (wr == 1) PG8_BAR;
        PG8_WAIT_V(4); PG8_BAR;
        PG8_STAGE(PG8_SB(1, 0), cB + kstep, voffB); PG8_STAGE(PG8_SA(1, 0), cA + kstep, voffA); PG8_STAGE(PG8_SB(1, 1), cB + hstep + kstep, voffB);
        PG8_WAIT_V(6); PG8_BAR;
    }
    for (;;) {
        const bool has_next = S.next(ui + 1, nxt);
        const char* nA = has_next ? (const char*)g.A + (size_t)nxt.pm * tstep + (size_t)nxt.kofs * 2 : cA; const char* nB = has_next ? (const char*)g.Bt + (size_t)nxt.pn * tstep + (size_t)nxt.kofs * 2 : cB;
        for (int t = 0; t < nt; t += 2) {
            const bool last = (t == nt - 2);
            const char* a1 = cA + (size_t)(t + 1) * kstep;
            const char* a2 = last ? nA : cA + (size_t)(t + 2) * kstep; const char* b2 = last ? nB : cB + (size_t)(t + 2) * kstep;
            const char* a3 = a2 + kstep; const char* b3 = b2 + kstep;
            if (last && has_next) S.a_ready(nxt);
            if constexpr (SP2) {
            PG8_LDB(B0, 0, 0); PG8_LDB(B1, 0, 1); PG8_SCHED; PG8_LDA(At, 0, 0); PG8_STAGE(PG8_SA(1, 1), a1 + hstep, voffA);
            PG8_WAIT_V(8); PG8_WAIT_L(0); PG8_BAR; PG8_MMA(0, 0, At, B0); PG8_MMA(0, 1, At, B1); PG8_BAR; PG8_SCHED;
            PG8_LDA(At, 0, 1); PG8_STAGE(PG8_SB(0, 0), b2, voffB); PG8_STAGE(PG8_SB(0, 1), b2 + hstep, voffB); PG8_STAGE(PG8_SA(0, 0), a2, voffA);
            PG8_WAIT_V(8); PG8_WAIT_L(0); PG8_BAR; PG8_MMA(1, 0, At, B0); PG8_MMA(1, 1, At, B1); PG8_BAR; PG8_SCHED;
            PG8_LDB(B0, 1, 0); PG8_LDB(B1, 1, 1); PG8_SCHED; PG8_LDA(At, 1, 0); PG8_STAGE(PG8_SA(0, 1), a2 + hstep, voffA);
            PG8_WAIT_V(8); PG8_WAIT_L(0); PG8_BAR; PG8_MMA(0, 0, At, B0); PG8_MMA(0, 1, At, B1); PG8_BAR; PG8_SCHED;
            PG8_LDA(At, 1, 1); PG8_STAGE(PG8_SB(1, 0), b3, voffB); PG8_STAGE(PG8_SB(1, 1), b3 + hstep, voffB); PG8_STAGE(PG8_SA(1, 0), a3, voffA);
            PG8_WAIT_V(8); PG8_WAIT_L(0); PG8_BAR; PG8_MMA(1, 0, At, B0); PG8_MMA(1, 1, At, B1); PG8_BAR; PG8_SCHED;
            } else {
            PG8_LDB(B0, 0, 0); PG8_SCHED; PG8_LDA(At, 0, 0); PG8_STAGE(PG8_SA(1, 1), a1 + hstep, voffA);
            PG8_WAIT_L(8); PG8_BAR; PG8_WAIT_L(0); PG8_MMA(0, 0, At, B0); PG8_BAR; PG8_SCHED;
            PG8_LDB(B1, 0, 1); PG8_STAGE(PG8_SB(0, 0), b2, voffB);
            PG8_BAR; PG8_WAIT_L(0); PG8_MMA(0, 1, At, B1); PG8_BAR;
            PG8_LDA(At, 0, 1); PG8_STAGE(PG8_SA(0, 0), a2, voffA);
            PG8_BAR; PG8_WAIT_L(0); PG8_MMA(1, 0, At, B0); PG8_BAR; PG8_SCHED;
            PG8_STAGE(PG8_SB(0, 1), b2 + hstep, voffB);
            PG8_WAIT_V(6); PG8_BAR; PG8_MMA(1, 1, At, B1); PG8_BAR;
            PG8_LDB(B0, 1, 0); PG8_SCHED; PG8_LDA(At, 1, 0); PG8_STAGE(PG8_SA(0, 1), a2 + hstep, voffA);
            PG8_WAIT_L(8); PG8_BAR; PG8_WAIT_L(0); PG8_MMA(0, 0, At, B0); PG8_BAR; PG8_SCHED;
            PG8_LDB(B1, 1, 1); PG8_STAGE(PG8_SB(1, 0), b3, voffB);
            PG8_BAR; PG8_WAIT_L(0); PG8_MMA(0, 1, At, B1); PG8_BAR;
            PG8_LDA(At, 1, 1); PG8_STAGE(PG8_SA(1, 0), a3, voffA);
            PG8_BAR; PG8_WAIT_L(0); PG8_MMA(1, 0, At, B0); PG8_BAR; PG8_SCHED;
            PG8_STAGE(PG8_SB(1, 1), b3 + hstep, voffB);
            PG8_WAIT_V(6); PG8_BAR; PG8_MMA(1, 1, At, B1); PG8_BAR;
            }
        }
        if constexpr (ALIGN_EPI) { if (wr == 0) PG8_BAR; }
        if constexpr (!Epi::AFTER_DRAIN) { E(acc, cur, wr, wc, fr, fq); S.done(cur); }
        if (!has_next) break;
#pragma unroll
        for (int a = 0; a < 2; ++a)
#pragma unroll
            for (int b = 0; b < 2; ++b)
#pragma unroll
                for (int m = 0; m < 4; ++m)
#pragma unroll
                    for (int n = 0; n < 2; ++n) acc[a][b][m][n] = (f32x4){0.f, 0.f, 0.f, 0.f};
        cur = nxt; cA = nA; cB = nB; ++ui; nt = cur.nt ? cur.nt : K / BK;
        if constexpr (ALIGN_EPI) { if (wr == 1) PG8_BAR; }
    }
    PG8_WAIT_V(0);
    if constexpr (!ALIGN_EPI) { if (wr == 0) PG8_BAR; }
    PG8_BAR;
    if constexpr (Epi::AFTER_DRAIN) { E.fused(acc, cur, wr, wc, fr, fq, lds, wid, lane); S.done(cur); }
#undef PG8_SA
#undef PG8_SB
#undef PG8_STAGE
#undef PG8_LDA
#undef PG8_LDB
#undef PG8_MMA
#undef PG8_WAIT_V
#undef PG8_WAIT_L
#undef PG8_BAR
#undef PG8_SCHED
}
}
#define LAS __attribute__((address_space(3)))
typedef unsigned short bf16_t;
typedef float f32x4 __attribute__((ext_vector_type(4)));
typedef short bf16x8 __attribute__((ext_vector_type(8)));
typedef unsigned u32x4 __attribute__((ext_vector_type(4)));
typedef unsigned u32x2 __attribute__((ext_vector_type(2)));

constexpr int DM = 1024, TP = 16384, TS = 512, TT = TP + TS, SEQ = 2048, NB = 8, NSB = 128;
constexpr int NPROJ = 2304, INDIM = 2312, DFF = 2816;
constexpr float EPS = 1e-6f;
constexpr int RT_H0 = 0, RT_MN = 66, RT_WIN = 74, RT_WXKV = 83, RT_END = 91;
constexpr size_t WS_R = 1u << 20;
constexpr size_t WS_H0 = WS_R;
constexpr size_t WS_MN = WS_R + (size_t)RT_MN * 256 * 2048;
constexpr size_t WS_WIN = WS_R + (size_t)RT_WIN * 256 * 2048;
constexpr size_t WS_WXKV = WS_R + (size_t)RT_WXKV * 256 * 2048;
constexpr size_t WS_WOUT = WS_R + (size_t)RT_END * 256 * 2048;
constexpr size_t WS_WXQ = WS_WOUT + 2097152;
constexpr size_t WS_WXO = WS_WXQ + 2097152;
constexpr size_t WS_WGU = WS_WXO + 2097152;
constexpr size_t WS_WDN = WS_WGU + (size_t)2 * DFF * 1024 * 2;
constexpr size_t WS_DTRAW = WS_WDN + (size_t)1024 * DFF * 2;
constexpr size_t WS_SPLIT = WS_DTRAW + (size_t)TT * 8 * 4;
constexpr size_t WS_ATOT = WS_SPLIT + (size_t)16 * 512 * 1024 * 4;
constexpr size_t WS_MIXIN = WS_ATOT + 8192;
constexpr size_t WS_CB16 = WS_MIXIN + (size_t)TT * 1024 * 2;
constexpr size_t WS_Q2 = WS_CB16 + (size_t)TT * 1024 * 2;
constexpr size_t WS_OX = WS_Q2 + (size_t)TT * 1024 * 2;
constexpr size_t WS_PROJ = WS_OX + (size_t)TT * 1024 * 2;
constexpr size_t WS_KVT = WS_PROJ + (size_t)TT * NPROJ * 2;
constexpr size_t WS_MK = WS_KVT + (size_t)256 * TT * 2;
constexpr size_t WS_MVT = WS_MK + (size_t)2048 * 1024 * 2;
constexpr size_t WS_MV = WS_MVT + (size_t)2048 * 1024 * 2;
constexpr size_t WS_CS = WS_MV + (size_t)2048 * 1024 * 2;
constexpr size_t WS_X1 = WS_CS;
constexpr size_t WS_END1 = WS_X1 + (size_t)TT * 1024 * 2 > WS_CS + (size_t)8 * 16 * 8 * 8192 * 4 ? WS_X1 + (size_t)TT * 1024 * 2 : WS_CS + (size_t)8 * 16 * 8 * 8192 * 4;
constexpr size_t WS_ACT = WS_PROJ;
constexpr size_t WS_END2 = WS_ACT + (size_t)TT * DFF * 2;
constexpr size_t WS_END = WS_END1 > WS_END2 ? WS_END1 : WS_END2;
constexpr size_t O_Y = 0, O_PSSM = 17301504, O_PCONV = 17825792, O_PWK = 17850368, O_PWV = 17981440, O_PMK = 18112512, O_PMV = 20209664,
                 O_SSSM = 22306816, O_SCONV = 30695424, O_SWK = 31088640, O_SWV = 33185792;
constexpr int LDS_BYTES = 147456;

struct Params {
    const float* in[32]; float* out; unsigned char* ws; int ph_lo, ph_hi;
};
typedef const __attribute__((address_space(4))) Params* CP;

__device__ __forceinline__ float bf2f(bf16_t h) { return __uint_as_float(((unsigned)h) << 16); }
__device__ __forceinline__ unsigned pk2(float lo, float hi) { return pg8::cvt_pk_bf16(lo, hi); }
__device__ __forceinline__ bf16_t f2bf(float f) { return (bf16_t)(pk2(f, 0.f) & 0xffffu); }
__device__ __forceinline__ float wave_sum(float v) {
#pragma unroll
    for (int o = 1; o < 64; o <<= 1) v += __shfl_xor(v, o);
    return v;
}
__device__ __forceinline__ float wave_max(float v) {
#pragma unroll
    for (int o = 1; o < 64; o <<= 1) v = fmaxf(v, __shfl_xor(v, o));
    return v;
}
__device__ __forceinline__ float silu_f(float x) { return x / (1.f + __expf(-x)); }
__device__ __forceinline__ float softplus_f(float x) { return x > 20.f ? x : log1pf(__expf(x)); }
#define LDSW() asm volatile("s_waitcnt lgkmcnt(0)" ::: "memory")

template <int NT>
__device__ __forceinline__ void mma_lds(f32x4 (&acc)[NT], const LAS bf16_t* A, int lda, const LAS bf16_t* B, int ldb, int K, int lane) {
    const int fr = lane & 15, fq = lane >> 4;
    for (int k0 = 0; k0 < K; k0 += 32) {
        const bf16x8 a = *(const LAS bf16x8*)(A + fr * lda + k0 + 8 * fq);
#pragma unroll
        for (int n = 0; n < NT; ++n) {
            const bf16x8 b = *(const LAS bf16x8*)(B + (16 * n + fr) * ldb + k0 + 8 * fq);
            acc[n] = __builtin_amdgcn_mfma_f32_16x16x32_bf16(b, a, acc[n], 0, 0, 0);
        }
    }
}
template <int NT, int KS, int ks0, int nks>
__device__ __forceinline__ void mma_areg(f32x4 (&acc)[NT], const bf16x8 (&a)[KS], const LAS bf16_t* B, int ldb, int lane) {
    const int fr = lane & 15, fq = lane >> 4;
#pragma unroll
    for (int ks = 0; ks < nks; ++ks) {
#pragma unroll
        for (int n = 0; n < NT; ++n) {
            const bf16x8 b = *(const LAS bf16x8*)(B + (16 * n + fr) * ldb + ks * 32 + 8 * fq);
            acc[n] = __builtin_amdgcn_mfma_f32_16x16x32_bf16(b, a[ks0 + ks], acc[n], 0, 0, 0);
        }
        __builtin_amdgcn_sched_barrier(0);
    }
}

struct Order {
    int n, G, c, mode, nN;
    __device__ __forceinline__ bool next(int i, pg8::Unit& u) const {
        const long L0 = (long)i * G + c; if (L0 >= n) return false;
        u.kofs = 0; u.nt = 0; u.q = 0;
        if (mode == 2) { const int L = (int)L0; if (L < 256) { const int v = (L % 8) * 32 + L / 8; u.pm = v / 4; u.pn = v % 4; }
            else { const int l = L - 256, q = l & 3, hi = ((nN + 7) / 8) * 2, lo = (nN - 2 * hi) / 2; u.pm = 64 + (l >> 4); u.pn = (l >> 2) & 3; u.q = q; u.nt = q < 2 ? hi : lo; u.kofs = 64 * (q < 2 ? q * hi : 2 * hi + (q - 2) * lo); } return true; }
        if (mode == 3) { const int L = (int)L0; if (L < 256) { const int v = (L % 8) * 32 + L / 8; u.pm = v / 4; u.pn = v % 4; }
            else { const int l = L - 256, q = l & 1; u.pm = 64 + (l >> 3); u.pn = (l >> 1) & 3; u.q = q; u.nt = nN / 2; u.kofs = 64 * q * (nN / 2); } return true; }
        int L = (int)L0; { const int q = n / 8, r = n % 8, xcd = L % 8, off = L / 8; L = (xcd < r ? xcd * (q + 1) : r * (q + 1) + (xcd - r) * q) + off; }
        if (mode == 0) {
            if (L < 594) { u.pm = L / 9; u.pn = RT_WIN + L % 9; }
            else if (L < 658) { const int l = L - 594; u.pm = RT_MN + l / 8; u.pn = RT_WXKV + l % 8; }
            else if (L < 690) { const int l = L - 658; u.pm = RT_WXKV + 4 + l / 8; u.pn = RT_MN + l % 8; }
            else { u.pm = RT_WIN + 8; u.pn = L - 690; }
        } else { u.pm = L / nN; u.pn = L % nN; }
        return true;
    }
    __device__ __forceinline__ void a_ready(const pg8::Unit&) const {}
    __device__ __forceinline__ void done(const pg8::Unit&) const {}
};
struct EpiP1 {
    static constexpr bool PERM = false, AFTER_DRAIN = false;
    bf16_t* proj; bf16_t* mk; bf16_t* mv; bf16_t* mvt; bf16_t* kvt;
    __device__ __forceinline__ void operator()(const f32x4 (&acc)[2][2][4][2], const pg8::Unit& u, int wr, int wc, int fr, int fq) const {
        bf16_t* base; int ld;
        if (u.pm < RT_MN) { base = proj + (size_t)(u.pm * 256) * NPROJ + (u.pn - RT_WIN) * 256; ld = NPROJ; }
        else if (u.pm < RT_WIN) { const int ct = u.pn - RT_WXKV; base = (ct < 4 ? mk + ct * 256 : mv + (ct - 4) * 256) + (size_t)((u.pm - RT_MN) * 256) * 1024; ld = 1024; }
        else if (u.pm == RT_WIN + 8) { base = kvt + u.pn * 256; ld = TT; }
        else { base = mvt + (size_t)((u.pm - RT_WXKV - 4) * 256) * 2048 + (u.pn - RT_MN) * 256; ld = 2048; }
#pragma unroll
        for (int ai = 0; ai < 2; ++ai)
#pragma unroll
            for (int m = 0; m < 4; ++m) {
                bf16_t* rowp = base + (size_t)(128 * ai + 64 * wr + 16 * m + fr) * ld + 32 * wc + 4 * fq;
#pragma unroll
                for (int bj = 0; bj < 2; ++bj)
#pragma unroll
                    for (int n = 0; n < 2; ++n) { const f32x4 v = acc[ai][bj][m][n]; u32x2 w; w.x = pk2(v[0], v[1]); w.y = pk2(v[2], v[3]); *(u32x2*)(rowp + 128 * bj + 16 * n) = w; }
            }
    }
};
struct EpiBf {
    static constexpr bool PERM = false, AFTER_DRAIN = false;
    bf16_t* O; int ldc; float scale; float* part;
    __device__ __forceinline__ void operator()(const f32x4 (&acc)[2][2][4][2], const pg8::Unit& u, int wr, int wc, int fr, int fq) const {
        if (u.nt) {
#pragma unroll
            for (int ai = 0; ai < 2; ++ai)
#pragma unroll
                for (int m = 0; m < 4; ++m) { float* rowp = part + (size_t)u.q * 512 * 1024 + (size_t)((u.pm - 64) * 256 + 128 * ai + 64 * wr + 16 * m + fr) * 1024 + u.pn * 256 + 32 * wc + 4 * fq;
#pragma unroll
                    for (int bj = 0; bj < 2; ++bj)
#pragma unroll
                        for (int n = 0; n < 2; ++n) *(f32x4*)(rowp + 128 * bj + 16 * n) = acc[ai][bj][m][n]; }
            return;
        }
#pragma unroll
        for (int ai = 0; ai < 2; ++ai)
#pragma unroll
            for (int m = 0; m < 4; ++m) {
                bf16_t* rowp = O + (size_t)(u.pm * 256 + 128 * ai + 64 * wr + 16 * m + fr) * ldc + u.pn * 256 + 32 * wc + 4 * fq;
#pragma unroll
                for (int bj = 0; bj < 2; ++bj)
#pragma unroll
                    for (int n = 0; n < 2; ++n) { const f32x4 v = acc[ai][bj][m][n] * scale; u32x2 w; w.x = pk2(v[0], v[1]); w.y = pk2(v[2], v[3]); *(u32x2*)(rowp + 128 * bj + 16 * n) = w; }
            }
    }
};
struct EpiGU {
    static constexpr bool PERM = false, AFTER_DRAIN = false;
    bf16_t* O;
    __device__ __forceinline__ void operator()(const f32x4 (&acc)[2][2][4][2], const pg8::Unit& u, int wr, int wc, int fr, int fq) const {
#pragma unroll
        for (int ai = 0; ai < 2; ++ai)
#pragma unroll
            for (int m = 0; m < 4; ++m) {
                bf16_t* rowp = O + (size_t)(u.pm * 256 + 128 * ai + 64 * wr + 16 * m + fr) * DFF + u.pn * 128 + 16 * wc + 4 * fq;
#pragma unroll
                for (int bj = 0; bj < 2; ++bj) { const f32x4 g = acc[ai][bj][m][0], up = acc[ai][bj][m][1];
                    u32x2 w; w.x = pk2(silu_f(g[0]) * up[0], silu_f(g[1]) * up[1]); w.y = pk2(silu_f(g[2]) * up[2], silu_f(g[3]) * up[3]); *(u32x2*)(rowp + 64 * bj) = w; }
            }
    }
};

struct TrSrc { const float* lo; const float* hi; int ld; };
__device__ __forceinline__ void tr_item(const TrSrc s, int k0, bf16_t* dst, int K, LAS float* scr, int lane) {
    const float* p = (lane & 16) ? s.hi + (lane & 15) : s.lo + (lane & 15);
    float tv[32];
#pragma unroll
    for (int i = 0; i < 32; ++i) { const int kk = 2 * i + (lane >> 5); tv[i] = __builtin_nontemporal_load(p + (size_t)(k0 + kk) * s.ld); }
#pragma unroll
    for (int i = 0; i < 32; ++i) { const int kk = 2 * i + (lane >> 5); scr[kk * 33 + (lane & 31)] = tv[i]; }
    LDSW();
    const int c = lane & 7;
#pragma unroll
    for (int j = 0; j < 4; ++j) { const int n = (lane >> 3) + 8 * j; const LAS float* q = scr + (8 * c) * 33 + n;
        u32x4 o; o.x = pk2(q[0], q[33]); o.y = pk2(q[2 * 33], q[3 * 33]); o.z = pk2(q[4 * 33], q[5 * 33]); o.w = pk2(q[6 * 33], q[7 * 33]);
        *(u32x4*)(dst + (size_t)n * K + 8 * c) = o; }
    LDSW();
}
__device__ __forceinline__ void rms_apply(f32x4 (&v)[4], const float* g, int lane) {
    float ss = 0.f;
#pragma unroll
    for (int j = 0; j < 4; ++j) ss += (v[j][0] * v[j][0] + v[j][1] * v[j][1]) + (v[j][2] * v[j][2] + v[j][3] * v[j][3]);
    const float r = rsqrtf(wave_sum(ss) * (1.f / 1024.f) + EPS);
#pragma unroll
    for (int j = 0; j < 4; ++j) { const f32x4 gv = *(const f32x4*)(g + 4 * lane + 256 * j); v[j] = v[j] * r * gv; }
}
__device__ __forceinline__ void store_row_bf16(bf16_t* o, const f32x4 (&v)[4], int lane) {
#pragma unroll
    for (int j = 0; j < 4; ++j) { u32x2 w; w.x = pk2(v[j][0], v[j][1]); w.y = pk2(v[j][2], v[j][3]); *(u32x2*)(o + 4 * lane + 256 * j) = w; }
}
__device__ __forceinline__ void load_row_f32(f32x4 (&v)[4], const float* x, int lane) {
#pragma unroll
    for (int j = 0; j < 4; ++j) v[j] = __builtin_nontemporal_load((const f32x4*)(x + 4 * lane + 256 * j));
}

__device__ __forceinline__ void tr_items(CP P, LAS unsigned char* lds, int part, int gw, int NGW, int wave, int lane) {
    unsigned char* ws = P->ws;
    LAS float* scr = (LAS float*)(lds + wave * 16384);
    constexpr int I_IN = 72 * 16, I_SQ = 512, I_GU = 176 * 16, I_DN = 32 * 44;
    const int nitems = part == 0 ? I_IN + 3 * I_SQ : 2 * I_SQ + I_GU + I_DN;
    for (int it = gw; it < nitems; it += NGW) {
        int r = it; TrSrc s; bf16_t* dst; int K = 1024, k0; int which = -1;
        if (part == 0) { if (r >= I_IN) { r -= I_IN; const int w3 = r / I_SQ; r %= I_SQ; which = w3 == 0 ? 0 : w3 + 2; } }
        else { if (r < 2 * I_SQ) { which = 1 + r / I_SQ; r %= I_SQ; } else r -= 2 * I_SQ; }
        if (part == 0 && which < 0) { const int nb = r / 16, kb = r % 16, n0 = nb * 32, sc = n0 + (n0 >= 1536 ? 8 : 0);
            s.lo = P->in[10] + sc; s.hi = s.lo + 16; s.ld = INDIM; k0 = kb * 64; dst = (bf16_t*)(ws + WS_WIN) + (size_t)n0 * 1024 + k0; }
        else if (which >= 0) { const int nb = r / 16, kb = r % 16;
            const float* W = which == 0 ? P->in[18] : which == 1 ? P->in[21] : which == 2 ? P->in[25] : which == 3 ? P->in[23] : P->in[24];
            bf16_t* D = which == 0 ? (bf16_t*)(ws + WS_WOUT) : which == 1 ? (bf16_t*)(ws + WS_WXQ) : which == 2 ? (bf16_t*)(ws + WS_WXO) : which == 3 ? (bf16_t*)(ws + WS_WXKV) : (bf16_t*)(ws + WS_WXKV) + (size_t)1024 * 1024;
            s.lo = W + nb * 32; s.hi = s.lo + 16; s.ld = 1024; k0 = kb * 64; dst = D + (size_t)nb * 32 * 1024 + k0; }
        else if (r < I_GU) { const int nb = r / 16, kb = r % 16;
            s.lo = P->in[28] + nb * 16; s.hi = P->in[29] + nb * 16; s.ld = DFF; k0 = kb * 64; dst = (bf16_t*)(ws + WS_WGU) + (size_t)nb * 32 * 1024 + k0; }
        else { r -= I_GU; const int nb = r / 44, kb = r % 44; K = DFF;
            s.lo = P->in[30] + nb * 32; s.hi = s.lo + 16; s.ld = 1024; k0 = kb * 64; dst = (bf16_t*)(ws + WS_WDN) + (size_t)nb * 32 * DFF + k0; }
        tr_item(s, k0, dst, K, scr, lane);
    }
}
__device__ __forceinline__ void phase_prologue(CP P, LAS unsigned char* lds, int gw, int NGW, int wave, int lane) {
    unsigned char* ws = P->ws;
    tr_items(P, lds, 0, gw, NGW, wave, lane);
    __syncthreads();
    LAS float* wT = (LAS float*)lds;
    { const int tid = wave * 64 + lane;
#pragma unroll
      for (int it = 0; it < 4; ++it) { const int idx = tid + 512 * it, c = idx >> 1, hf = idx & 1; const f32x4 w = *(const f32x4*)(P->in[10] + (size_t)c * INDIM + 1536 + 4 * hf);
          wT[(4 * hf + 0) * 1024 + c] = w[0]; wT[(4 * hf + 1) * 1024 + c] = w[1]; wT[(4 * hf + 2) * 1024 + c] = w[2]; wT[(4 * hf + 3) * 1024 + c] = w[3]; } }
    __syncthreads();
    {
        f32x4 nx[4];
        if (gw < TT) load_row_f32(nx, gw < TP ? P->in[0] + (size_t)gw * 1024 : P->in[1] + (size_t)(gw - TP) * 1024, lane);
        for (int m = gw; m < TT; m += NGW) {
            f32x4 v[4];
#pragma unroll
            for (int j = 0; j < 4; ++j) v[j] = nx[j];
            const int m2 = m + NGW;
            if (m2 < TT) load_row_f32(nx, m2 < TP ? P->in[0] + (size_t)m2 * 1024 : P->in[1] + (size_t)(m2 - TP) * 1024, lane);
            rms_apply(v, P->in[9], lane);
            store_row_bf16((bf16_t*)(ws + WS_H0) + (size_t)m * 1024, v, lane);
            float d[8];
#pragma unroll
            for (int e = 0; e < 8; ++e) { float a = 0.f;
#pragma unroll
                for (int j = 0; j < 4; ++j) { const f32x4 w = *(const LAS f32x4*)(wT + e * 1024 + 4 * lane + 256 * j); a += (v[j][0] * w[0] + v[j][1] * w[1]) + (v[j][2] * w[2] + v[j][3] * w[3]); }
                d[e] = wave_sum(a); }
            if (lane == 0) { float* o = (float*)(ws + WS_DTRAW) + (size_t)m * 8; *(f32x4*)o = (f32x4){d[0], d[1], d[2], d[3]}; *(f32x4*)(o + 4) = (f32x4){d[4], d[5], d[6], d[7]}; }
        }
    }
    __syncthreads();
    for (int m = gw; m < 2048; m += NGW) {
        f32x4 v[4]; load_row_f32(v, P->in[8] + (size_t)m * 1024, lane); rms_apply(v, P->in[22], lane);
        store_row_bf16((bf16_t*)(ws + WS_MN) + (size_t)m * 1024, v, lane);
    }
}

__device__ __forceinline__ void phase_resid(CP P, int stage, int gw, int NGW, int lane) {
    unsigned char* ws = P->ws; const bf16_t* C = (const bf16_t*)(ws + WS_CB16); bf16_t* XB = (bf16_t*)(ws + WS_X1);
    const float* g1 = stage == 0 ? P->in[19] : stage == 1 ? P->in[26] : P->in[31];
    const float* g2 = stage == 0 ? P->in[20] : P->in[27];
    for (int m = gw; m < TT; m += NGW) {
        f32x4 c[4], x[4];
        if (m >= TP) { const float* pp_ = (const float*)(ws + WS_SPLIT) + (size_t)(stage == 0 ? 0 : stage == 1 ? 8 : 12) * 512 * 1024 + (size_t)(m - TP) * 1024; f32x4 c1[4], c2[4], c3[4];
            load_row_f32(c, pp_, lane); load_row_f32(c1, pp_ + 512 * 1024, lane);
            if (stage == 2) { load_row_f32(c2, pp_ + 2 * 512 * 1024, lane); load_row_f32(c3, pp_ + 3 * 512 * 1024, lane); }
#pragma unroll
            for (int j = 0; j < 4; ++j) c[j] = stage == 2 ? (c[j] + c1[j]) + (c2[j] + c3[j]) : c[j] + c1[j]; }
        else {
#pragma unroll
        for (int j = 0; j < 4; ++j) { const u32x2 w = __builtin_nontemporal_load((const u32x2*)(C + (size_t)m * 1024 + 4 * lane + 256 * j));
            c[j] = (f32x4){__uint_as_float(w.x << 16), __uint_as_float(w.x & 0xffff0000u), __uint_as_float(w.y << 16), __uint_as_float(w.y & 0xffff0000u)}; }
        }
        if (stage == 0) load_row_f32(x, m < TP ? P->in[0] + (size_t)m * 1024 : P->in[1] + (size_t)(m - TP) * 1024, lane);
        else {
#pragma unroll
            for (int j = 0; j < 4; ++j) { const u32x2 w = *(const u32x2*)(XB + (size_t)m * 1024 + 4 * lane + 256 * j);
                x[j] = (f32x4){__uint_as_float(w.x << 16), __uint_as_float(w.x & 0xffff0000u), __uint_as_float(w.y << 16), __uint_as_float(w.y & 0xffff0000u)}; }
        }
        rms_apply(c, g1, lane);
#pragma unroll
        for (int j = 0; j < 4; ++j) x[j] = x[j] + c[j];
        if (stage == 2) {
#pragma unroll
            for (int j = 0; j < 4; ++j) *(f32x4*)(P->out + (size_t)m * 1024 + 4 * lane + 256 * j) = x[j];
        } else {
#pragma unroll
            for (int j = 0; j < 4; ++j) { u32x2 w; w.x = pk2(x[j][0], x[j][1]); w.y = pk2(x[j][2], x[j][3]); *(u32x2*)(XB + (size_t)m * 1024 + 4 * lane + 256 * j) = w;
                x[j] = (f32x4){__uint_as_float(w.x << 16), __uint_as_float(w.x & 0xffff0000u), __uint_as_float(w.y << 16), __uint_as_float(w.y & 0xffff0000u)}; }
            rms_apply(x, g2, lane); store_row_bf16((bf16_t*)(ws + WS_H0) + (size_t)m * 1024, x, lane);
        }
    }
}

__device__ __forceinline__ void conv8(const bf16_t* col, int t0, bool zero_hist, const float (&w)[4], float bias, float (&out)[8], float (&raw)[11]) {
#pragma unroll
    for (int i = 0; i < 11; ++i) { const int r = t0 - 3 + i; raw[i] = (r < 0 && zero_hist) ? 0.f : bf2f(col[(long)r * NPROJ]); }
#pragma unroll
    for (int j = 0; j < 8; ++j) out[j] = silu_f(bias + w[0] * raw[j] + w[1] * raw[j + 1] + w[2] * raw[j + 2] + w[3] * raw[j + 3]);
}
__device__ __forceinline__ void conv8x2(const bf16_t* col, int t0, bool zero_hist, const float* cw, const float* cb, int ch, float (&o0)[8], float (&o1)[8]) {
    float r0[11], r1[11];
#pragma unroll
    for (int i = 0; i < 11; ++i) { const int r = t0 - 3 + i; unsigned w = 0u; if (!(r < 0 && zero_hist)) w = *(const unsigned*)(col + (long)r * NPROJ); r0[i] = __uint_as_float(w << 16); r1[i] = __uint_as_float(w & 0xffff0000u); }
    const float b0 = cb[ch], b1 = cb[ch + 1];
    float w0[4], w1[4];
#pragma unroll
    for (int j = 0; j < 4; ++j) { w0[j] = cw[j * 1024 + ch]; w1[j] = cw[j * 1024 + ch + 1]; }
#pragma unroll
    for (int j = 0; j < 8; ++j) { o0[j] = silu_f(b0 + w0[0] * r0[j] + w0[1] * r0[j + 1] + w0[2] * r0[j + 2] + w0[3] * r0[j + 3]);
                                  o1[j] = silu_f(b1 + w1[0] * r1[j] + w1[1] * r1[j + 1] + w1[2] * r1[j + 2] + w1[3] * r1[j + 3]); }
}
__device__ __forceinline__ void dt_acum(CP P, int row0, int g, LAS float* dtv, LAS float* acum, int wave, int lane) {
    if (wave < 4) {
        const int h = g * 4 + wave; const float* dr = (const float*)(P->ws + WS_DTRAW);
        const float bias = P->in[13][h], a = -__expf(P->in[14][h]);
        const float d0 = softplus_f(dr[(size_t)(row0 + 2 * lane) * 8 + h] + bias), d1 = softplus_f(dr[(size_t)(row0 + 2 * lane + 1) * 8 + h] + bias);
        const float a0 = a * d0, a1 = a * d1; float s = a0 + a1;
#pragma unroll
        for (int o = 1; o < 64; o <<= 1) { const float t = __shfl_up(s, o); if (lane >= o) s += t; }
        dtv[(2 * lane) * 4 + wave] = d0; dtv[(2 * lane + 1) * 4 + wave] = d1;
        acum[(2 * lane) * 4 + wave] = s - a1; acum[(2 * lane + 1) * 4 + wave] = s;
    }
}

constexpr int PT = 136;
__device__ __forceinline__ void ssd_pass_a(CP P, LAS unsigned char* lds, int unit, int tid, int wave, int lane) {
    const int b = unit >> 5, c = (unit >> 1) & 15, g = unit & 1, row0 = b * SEQ + c * 128;
    LAS bf16_t* BT = (LAS bf16_t*)lds;
    LAS bf16_t* XW = (LAS bf16_t*)(lds + 128 * PT * 2);
    LAS float* dtv = (LAS float*)(lds + 384 * PT * 2); LAS float* acum = dtv + 512;
    const bf16_t* proj = (const bf16_t*)(P->ws + WS_PROJ);
    dt_acum(P, row0, g, dtv, acum, wave, lane);
    __syncthreads();
#pragma unroll 3
    for (int kk_ = 0; kk_ < 6; ++kk_) {
        const int it = tid + 512 * kk_;
        const int pr = it % 192, tb = it / 192, t0 = tb * 8, chl = 2 * pr;
        const int ch = chl < 256 ? g * 256 + chl : 512 + g * 128 + (chl - 256);
        float o0[8], o1[8]; conv8x2(proj + (size_t)row0 * NPROJ + 512 + ch, t0, c == 0, P->in[11], P->in[12], ch, o0, o1);
        if (chl < 256) { const int hh = chl >> 6; const float aend = acum[127 * 4 + hh];
#pragma unroll
            for (int j = 0; j < 8; ++j) { const float wg = dtv[(t0 + j) * 4 + hh] * __expf(aend - acum[(t0 + j) * 4 + hh]); o0[j] *= wg; o1[j] *= wg; } }
        u32x4 pk0, pk1; pk0.x = pk2(o0[0], o0[1]); pk0.y = pk2(o0[2], o0[3]); pk0.z = pk2(o0[4], o0[5]); pk0.w = pk2(o0[6], o0[7]);
        pk1.x = pk2(o1[0], o1[1]); pk1.y = pk2(o1[2], o1[3]); pk1.z = pk2(o1[4], o1[5]); pk1.w = pk2(o1[6], o1[7]);
        LAS bf16_t* d = chl < 256 ? XW + chl * PT + t0 : BT + (chl - 256) * PT + t0;
        *(LAS u32x4*)d = pk0; *(LAS u32x4*)(d + PT) = pk1;
    }
    __syncthreads();
    float* cs = (float*)(P->ws + WS_CS) + (size_t)((b * 16 + c) * 8 + g * 4) * 8192;
#pragma unroll
    for (int mt = 0; mt < 2; ++mt) {
        f32x4 acc[8];
#pragma unroll
        for (int n = 0; n < 8; ++n) acc[n] = (f32x4){0.f, 0.f, 0.f, 0.f};
        const int r0 = 32 * wave + 16 * mt;
        mma_lds<8>(acc, XW + r0 * PT, PT, BT, PT, 128, lane);
        const int fr = lane & 15, fq = lane >> 4;
#pragma unroll
        for (int n = 0; n < 8; ++n) *(f32x4*)(cs + (size_t)(r0 + fr) * 128 + 16 * n + 4 * fq) = acc[n];
    }
    if (tid < 4) ((float*)(P->ws + WS_ATOT))[(b * 16 + c) * 8 + g * 4 + tid] = acum[127 * 4 + tid];
    __syncthreads();
}

__device__ __forceinline__ void ssd_state_scan(CP P, int bid, int G, int tid) {
    for (int base_ = bid * 512; base_ < 8 * 8 * 2048; base_ += G * 512) {
        const int i = base_ + tid, bh = i >> 11, e4 = i & 2047, b = bh >> 3, h = bh & 7;
        float* cs = (float*)(P->ws + WS_CS) + (size_t)(b * 16 * 8 + h) * 8192 + 4 * e4;
        const float* at = (const float*)(P->ws + WS_ATOT) + b * 16 * 8 + h;
        f32x4 v[16]; float dec[16];
#pragma unroll
        for (int c = 0; c < 16; ++c) { v[c] = *(const f32x4*)(cs + (size_t)c * 8 * 8192); dec[c] = __expf(at[c * 8]); }
        f32x4 st = (f32x4){0.f, 0.f, 0.f, 0.f};
#pragma unroll
        for (int c = 0; c < 16; ++c) { *(f32x4*)(cs + (size_t)c * 8 * 8192) = st; st = st * dec[c] + v[c]; }
        *(f32x4*)(P->out + O_PSSM + (size_t)(b * 8 + h) * 8192 + 4 * e4) = st;
    }
}

__device__ __forceinline__ void ssd_pass_b(CP P, LAS unsigned char* lds, int unit, int tid, int wave, int lane) {
    const int b = unit >> 5, c = (unit >> 1) & 15, g = unit & 1, row0 = b * SEQ + c * 128;
    const int fr = lane & 15, fq = lane >> 4;
    LAS bf16_t* Cs = (LAS bf16_t*)lds;
    LAS bf16_t* Bs = (LAS bf16_t*)(lds + 128 * PT * 2);
    LAS bf16_t* XT = (LAS bf16_t*)(lds + 256 * PT * 2);
    LAS bf16_t* SI = (LAS bf16_t*)(lds + 320 * PT * 2);
    LAS float* dtv = (LAS float*)(lds + 384 * PT * 2); LAS float* acum = dtv + 512;
    const bf16_t* proj = (const bf16_t*)(P->ws + WS_PROJ);
    dt_acum(P, row0, g, dtv, acum, wave, lane);
#pragma unroll 4
    for (int kk_ = 0; kk_ < 4; ++kk_) {
        const int it = tid + 512 * kk_;
        const int chl = 2 * (it & 127), tb = it >> 7, t0 = tb * 8;
        const int ch = chl < 128 ? 512 + g * 128 + chl : 768 + g * 128 + (chl - 128);
        float o0[8], o1[8]; conv8x2(proj + (size_t)row0 * NPROJ + 512 + ch, t0, c == 0, P->in[11], P->in[12], ch, o0, o1);
        LAS bf16_t* d = chl < 128 ? Bs + chl : Cs + (chl - 128);
#pragma unroll
        for (int j = 0; j < 8; ++j) *(LAS unsigned*)(d + (t0 + j) * PT) = pk2(o0[j], o1[j]);
    }
    if (c == 15) {
        const int ch = tid < 256 ? g * 256 + tid : (tid < 384 ? 512 + g * 128 + (tid - 256) : 768 + g * 128 + (tid - 384));
#pragma unroll
        for (int i = 0; i < 3; ++i) P->out[O_PCONV + (size_t)(b * 3 + i) * 1024 + ch] = bf2f(proj[(size_t)(row0 + 125 + i) * NPROJ + 512 + ch]);
    }
    __syncthreads();
    f32x4 cb[8];
#pragma unroll
    for (int n = 0; n < 8; ++n) cb[n] = (f32x4){0.f, 0.f, 0.f, 0.f};
    mma_lds<8>(cb, Cs + 16 * wave * PT, PT, Bs, PT, 128, lane);
    __syncthreads();
    LAS bf16_t* Ls = Bs;
    const int t = 16 * wave + fr;
    float ss = 0.f;
    const bf16_t* zr = proj + (size_t)(row0 + t) * NPROJ + g * 256;
    bf16_t* orow = (bf16_t*)(P->ws + WS_MIXIN) + (size_t)(row0 + t) * 1024 + g * 256;
#pragma unroll 1
    for (int hh = 0; hh < 4; ++hh) {
        const int h = g * 4 + hh;
        u32x2 zw4[4];
#pragma unroll
        for (int n = 0; n < 4; ++n) zw4[n] = *(const u32x2*)(zr + hh * 64 + 16 * n + 4 * fq);
        {
            const int p = 2 * (tid & 31), tb = tid >> 5, t0 = tb * 8, ch = h * 64 + p;
            float o0[8], o1[8]; conv8x2(proj + (size_t)row0 * NPROJ + 512 + ch, t0, c == 0, P->in[11], P->in[12], ch, o0, o1);
            u32x4 pk0, pk1; pk0.x = pk2(o0[0], o0[1]); pk0.y = pk2(o0[2], o0[3]); pk0.z = pk2(o0[4], o0[5]); pk0.w = pk2(o0[6], o0[7]);
            pk1.x = pk2(o1[0], o1[1]); pk1.y = pk2(o1[2], o1[3]); pk1.z = pk2(o1[4], o1[5]); pk1.w = pk2(o1[6], o1[7]);
            *(LAS u32x4*)(XT + p * PT + t0) = pk0; *(LAS u32x4*)(XT + (p + 1) * PT + t0) = pk1;
        }
        {
            const int p = tid >> 3, n0 = (tid & 7) * 16;
            const float* src = (const float*)(P->ws + WS_CS) + (size_t)((b * 16 + c) * 8 + h) * 8192 + p * 128 + n0;
#pragma unroll
            for (int q = 0; q < 4; ++q) { const f32x4 sv = *(const f32x4*)(src + 4 * q); u32x2 w2; w2.x = pk2(sv[0], sv[1]); w2.y = pk2(sv[2], sv[3]); *(LAS u32x2*)(SI + p * PT + n0 + 4 * q) = w2; }
        }
        {
            const float at_ = acum[t * 4 + hh];
#pragma unroll
            for (int n = 0; n < 8; ++n) {
                float l[4];
#pragma unroll
                for (int e = 0; e < 4; ++e) { const int s_ = 16 * n + 4 * fq + e; l[e] = (s_ <= t) ? cb[n][e] * __expf(at_ - acum[s_ * 4 + hh]) * dtv[s_ * 4 + hh] : 0.f; }
                u32x2 w2; w2.x = pk2(l[0], l[1]); w2.y = pk2(l[2], l[3]); *(LAS u32x2*)(Ls + t * PT + 16 * n + 4 * fq) = w2;
            }
        }
        __syncthreads();
        {
            f32x4 yd[4], yo[4];
#pragma unroll
            for (int n = 0; n < 4; ++n) { yd[n] = (f32x4){0.f, 0.f, 0.f, 0.f}; yo[n] = (f32x4){0.f, 0.f, 0.f, 0.f}; }
            mma_lds<4>(yd, Ls + 16 * wave * PT, PT, XT, PT, 128, lane);
            mma_lds<4>(yo, Cs + 16 * wave * PT, PT, SI, PT, 128, lane);
            const float ea = __expf(acum[t * 4 + hh]), dsk = P->in[15][h];
#pragma unroll
            for (int n = 0; n < 4; ++n) {
                const u32x2 zw = zw4[n];
                const float z[4] = {__uint_as_float(zw.x << 16), __uint_as_float(zw.x & 0xffff0000u), __uint_as_float(zw.y << 16), __uint_as_float(zw.y & 0xffff0000u)};
                float u[4];
#pragma unroll
                for (int e = 0; e < 4; ++e) { u[e] = (yd[n][e] + ea * yo[n][e] + dsk * bf2f(XT[(16 * n + 4 * fq + e) * PT + t])) * silu_f(z[e]); ss += u[e] * u[e]; }
                u32x2 w2; w2.x = pk2(u[0], u[1]); w2.y = pk2(u[2], u[3]); *(u32x2*)(orow + hh * 64 + 16 * n + 4 * fq) = w2;
            }
        }
        __syncthreads();
    }
    {
        ss += __shfl_xor(ss, 16); ss += __shfl_xor(ss, 32);
        const float r = rsqrtf(ss * (1.f / 256.f) + EPS);
#pragma unroll
        for (int hh = 0; hh < 4; ++hh)
#pragma unroll
            for (int n = 0; n < 4; ++n) { const int col = hh * 64 + 16 * n + 4 * fq; const f32x4 gv = *(const f32x4*)(P->in[16] + g * 256 + col);
                const u32x2 uw = *(const u32x2*)(orow + col);
                const float u0 = __uint_as_float(uw.x << 16) * r * gv[0], u1 = __uint_as_float(uw.x & 0xffff0000u) * r * gv[1], u2 = __uint_as_float(uw.y << 16) * r * gv[2], u3 = __uint_as_float(uw.y & 0xffff0000u) * r * gv[3];
                u32x2 w2; w2.x = pk2(u0, u1); w2.y = pk2(u2, u3); *(u32x2*)(orow + col) = w2; }
    }
    __syncthreads();
}

constexpr int PK = 72, PV = 264;
__device__ __forceinline__ void swa_prompt(CP P, LAS unsigned char* lds, int unit, int tid, int wave, int lane) {
    const int b = unit >> 5, nb = (unit >> 1) & 15, kvh = unit & 1, row0 = b * SEQ + nb * 128;
    const int fr = lane & 15, fq = lane >> 4;
    LAS bf16_t* Ks = (LAS bf16_t*)lds;
    LAS bf16_t* VT = (LAS bf16_t*)(lds + 256 * PK * 2);
    const bf16_t* proj = (const bf16_t*)(P->ws + WS_PROJ); const bf16_t* kvt = (const bf16_t*)(P->ws + WS_KVT);
#pragma unroll
    for (int kk_ = 0; kk_ < 4; ++kk_) {
        const int ci = tid + 512 * kk_;
        { const int row = ci >> 3, c8 = ci & 7; u32x4 v = (u32x4){0u, 0u, 0u, 0u};
          if (!(nb == 0 && row < 128)) v = *(const u32x4*)(proj + (size_t)(row0 - 128 + row) * NPROJ + 2048 + kvh * 64 + c8 * 8);
          *(LAS u32x4*)(Ks + row * PK + c8 * 8) = v; }
        { const int d = ci >> 5, c = ci & 31; u32x4 v = (u32x4){0u, 0u, 0u, 0u};
          if (!(nb == 0 && c < 16)) v = *(const u32x4*)(kvt + (size_t)(128 + kvh * 64 + d) * TT + row0 - 128 + c * 8);
          *(LAS u32x4*)(VT + d * PV + c * 8) = v; }
    }
    __syncthreads();
    const int r = wave >> 1, head = kvh * 4 + r; const float sink = P->in[17][head];
    bf16x8 qn[2];
#pragma unroll
    for (int ks = 0; ks < 2; ++ks) qn[ks] = *(const bf16x8*)(proj + (size_t)(row0 + (wave & 1) * 64 + fr) * NPROJ + 1536 + head * 64 + ks * 32 + 8 * fq);
    for (int st = 0; st < 4; ++st) {
        const int q0 = (wave & 1) * 64 + 16 * st, qi = q0 + fr;
        bf16x8 qf[2];
#pragma unroll
        for (int ks = 0; ks < 2; ++ks) qf[ks] = qn[ks];
        if (st < 3) {
#pragma unroll
            for (int ks = 0; ks < 2; ++ks) qn[ks] = *(const bf16x8*)(proj + (size_t)(row0 + qi + 16) * NPROJ + 1536 + head * 64 + ks * 32 + 8 * fq);
        }
        f32x4 s[16];
#pragma unroll
        for (int n = 0; n < 16; ++n) s[n] = (f32x4){0.f, 0.f, 0.f, 0.f};
        mma_areg<16, 2, 0, 2>(s, qf, Ks, PK, lane);
        float mx = sink;
#pragma unroll
        for (int n = 0; n < 16; ++n)
#pragma unroll
            for (int e = 0; e < 4; ++e) { const int kj = 16 * n + 4 * fq + e; const bool ok = (kj > qi) && (kj <= qi + 128) && (nb > 0 || kj >= 128);
                const float v = ok ? s[n][e] * 0.125f : -INFINITY; s[n][e] = v; mx = fmaxf(mx, v); }
        mx = fmaxf(mx, __shfl_xor(mx, 16)); mx = fmaxf(mx, __shfl_xor(mx, 32));
        float sum = 0.f;
#pragma unroll
        for (int n = 0; n < 16; ++n)
#pragma unroll
            for (int e = 0; e < 4; ++e) { const float ev = __expf(s[n][e] - mx); s[n][e] = ev; sum += ev; }
        sum += __shfl_xor(sum, 16); sum += __shfl_xor(sum, 32);
        const float inv = 1.f / (sum + __expf(sink - mx));
        bf16x8 pf[8];
#pragma unroll
        for (int ks = 0; ks < 8; ++ks) { u32x4 w; w.x = pk2(s[2 * ks][0] * inv, s[2 * ks][1] * inv); w.y = pk2(s[2 * ks][2] * inv, s[2 * ks][3] * inv);
            w.z = pk2(s[2 * ks + 1][0] * inv, s[2 * ks + 1][1] * inv); w.w = pk2(s[2 * ks + 1][2] * inv, s[2 * ks + 1][3] * inv); pf[ks] = __builtin_bit_cast(bf16x8, w); }
        f32x4 o[4];
#pragma unroll
        for (int n = 0; n < 4; ++n) o[n] = (f32x4){0.f, 0.f, 0.f, 0.f};
#pragma unroll
        for (int ks = 0; ks < 8; ++ks) {
#pragma unroll
            for (int n = 0; n < 4; ++n) {
                const LAS bf16_t* vp = VT + (16 * n + fr) * PV + 32 * ks + 4 * fq;
                const u32x2 a0 = *(const LAS u32x2*)vp, a1 = *(const LAS u32x2*)(vp + 16);
                o[n] = __builtin_amdgcn_mfma_f32_16x16x32_bf16(__builtin_bit_cast(bf16x8, (u32x4){a0.x, a0.y, a1.x, a1.y}), pf[ks], o[n], 0, 0, 0);
            }
            __builtin_amdgcn_sched_barrier(0);
        }
        asm volatile("s_nop 7\n\ts_nop 7\n\ts_nop 7" ::: "memory");
        bf16_t* op = (bf16_t*)(P->ws + WS_MIXIN) + (size_t)(row0 + qi) * 1024 + 512 + head * 64 + 4 * fq;
#pragma unroll
        for (int n = 0; n < 4; ++n) { u32x2 w2; w2.x = pk2(o[n][0], o[n][1]); w2.y = pk2(o[n][2], o[n][3]); *(u32x2*)(op + 16 * n) = w2; }
        LDSW();
    }
    __syncthreads();
}

__device__ __forceinline__ void ssd_sample(CP P, LAS unsigned char* lds, int unit, int tid, int wave, int lane) {
    const int b = unit >> 1, g = unit & 1, row0 = TP + b * 4;
    LAS float* xs = (LAS float*)lds;
    LAS float* Bsm = xs + 1024;
    LAS float* Csm = Bsm + 512;
    LAS float* ys = Csm + 512;
    LAS float* dts = ys + 1024;
    const bf16_t* proj = (const bf16_t*)(P->ws + WS_PROJ);
    {
        const int ch = tid < 256 ? g * 256 + tid : (tid < 384 ? 512 + g * 128 + (tid - 256) : 768 + g * 128 + (tid - 384));
        float up[7];
#pragma unroll
        for (int i = 0; i < 3; ++i) up[i] = __builtin_nontemporal_load(P->in[3] + (size_t)(b * 3 + i) * 1024 + ch);
#pragma unroll
        for (int i = 0; i < 4; ++i) up[3 + i] = bf2f(proj[(size_t)(row0 + i) * NPROJ + 512 + ch]);
        float w[4];
#pragma unroll
        for (int j = 0; j < 4; ++j) w[j] = P->in[11][j * 1024 + ch];
        const float bias = P->in[12][ch];
        LAS float* dst = tid < 256 ? xs + tid : (tid < 384 ? Bsm + (tid - 256) : Csm + (tid - 384)); const int pitch = tid < 256 ? 256 : 128;
#pragma unroll
        for (int i = 0; i < 4; ++i) dst[i * pitch] = silu_f(bias + w[0] * up[i] + w[1] * up[i + 1] + w[2] * up[i + 2] + w[3] * up[i + 3]);
#pragma unroll
        for (int i = 0; i < 3; ++i) P->out[O_SCONV + (size_t)(b * 3 + i) * 1024 + ch] = up[4 + i];
        if (tid < 16) { const int tt = tid >> 2, hh = tid & 3, h = g * 4 + hh; dts[tid] = softplus_f(((const float*)(P->ws + WS_DTRAW))[(size_t)(row0 + tt) * 8 + h] + P->in[13][h]); }
    }
    __syncthreads();
    const int p = tid >> 3, n0 = (tid & 7) * 16;
    f32x4 stv[4][4];
#pragma unroll
    for (int hh = 0; hh < 4; ++hh)
#pragma unroll
        for (int q = 0; q < 4; ++q) stv[hh][q] = __builtin_nontemporal_load((const f32x4*)(P->in[2] + (size_t)((b * 8 + g * 4 + hh) * 64 + p) * 128 + n0 + 4 * q));
#pragma unroll
    for (int hh = 0; hh < 4; ++hh) {
        const int h = g * 4 + hh; const float a = -__expf(P->in[14][h]), dsk = P->in[15][h];
        float st[16];
#pragma unroll
        for (int q = 0; q < 4; ++q) { const f32x4 v = stv[hh][q]; st[4 * q] = v[0]; st[4 * q + 1] = v[1]; st[4 * q + 2] = v[2]; st[4 * q + 3] = v[3]; }
#pragma unroll
        for (int tt = 0; tt < 4; ++tt) {
            const float dt = dts[tt * 4 + hh], dA = __expf(a * dt), xv = xs[tt * 256 + hh * 64 + p], dx = dt * xv; float yv = 0.f;
#pragma unroll
            for (int q = 0; q < 16; ++q) { st[q] = dA * st[q] + dx * Bsm[tt * 128 + n0 + q]; yv += st[q] * Csm[tt * 128 + n0 + q]; }
            yv += __shfl_xor(yv, 1); yv += __shfl_xor(yv, 2); yv += __shfl_xor(yv, 4);
            if ((tid & 7) == 0) ys[tt * 256 + hh * 64 + p] = yv + dsk * xv;
        }
        float* op = P->out + O_SSSM + (size_t)((b * 8 + h) * 64 + p) * 128 + n0;
#pragma unroll
        for (int q = 0; q < 4; ++q) *(f32x4*)(op + 4 * q) = (f32x4){st[4 * q], st[4 * q + 1], st[4 * q + 2], st[4 * q + 3]};
    }
    __syncthreads();
    if (wave < 4) {
        const int tt = wave; const bf16_t* zr = proj + (size_t)(row0 + tt) * NPROJ + g * 256 + 4 * lane;
        const u32x2 zw = *(const u32x2*)zr; const float z[4] = {__uint_as_float(zw.x << 16), __uint_as_float(zw.x & 0xffff0000u), __uint_as_float(zw.y << 16), __uint_as_float(zw.y & 0xffff0000u)};
        float u[4], ss = 0.f;
#pragma unroll
        for (int e = 0; e < 4; ++e) { u[e] = ys[tt * 256 + 4 * lane + e] * silu_f(z[e]); ss += u[e] * u[e]; }
        const float r = rsqrtf(wave_sum(ss) * (1.f / 256.f) + EPS); const f32x4 gv = *(const f32x4*)(P->in[16] + g * 256 + 4 * lane);
        u32x2 w2; w2.x = pk2(u[0] * r * gv[0], u[1] * r * gv[1]); w2.y = pk2(u[2] * r * gv[2], u[3] * r * gv[3]);
        *(u32x2*)((bf16_t*)(P->ws + WS_MIXIN) + (size_t)(row0 + tt) * 1024 + g * 256 + 4 * lane) = w2;
    }
    __syncthreads();
}

__device__ __forceinline__ void swa_sample(CP P, LAS unsigned char* lds, int unit, int tid, int wave, int lane) {
    const int b = unit >> 1, kvh = unit & 1, row0 = TP + b * 4;
    LAS float* Kf = (LAS float*)lds;
    LAS float* Vf = Kf + 132 * 65;
    LAS float* qf = Vf + 132 * 64;
    LAS float* sc = qf + 16 * 65;
    const bf16_t* proj = (const bf16_t*)(P->ws + WS_PROJ);
    {
        f32x4 kq[5], vq[5];
#pragma unroll
        for (int it = 0; it < 5; ++it) {
            const int i4 = tid + 512 * it, kk = i4 >> 4, d4 = (i4 & 15) * 4; kq[it] = (f32x4){0.f, 0.f, 0.f, 0.f}; vq[it] = kq[it];
            if (i4 < 132 * 16) {
                if (kk < 128) { const size_t o = (size_t)((b * 128 + kk) * 2 + kvh) * 64 + d4; kq[it] = __builtin_nontemporal_load((const f32x4*)(P->in[4] + o)); vq[it] = __builtin_nontemporal_load((const f32x4*)(P->in[5] + o)); }
                else { const bf16_t* pr = proj + (size_t)(row0 + kk - 128) * NPROJ + kvh * 64 + d4; const u32x2 a = *(const u32x2*)(pr + 2048), c = *(const u32x2*)(pr + 2176);
                    kq[it] = (f32x4){__uint_as_float(a.x << 16), __uint_as_float(a.x & 0xffff0000u), __uint_as_float(a.y << 16), __uint_as_float(a.y & 0xffff0000u)};
                    vq[it] = (f32x4){__uint_as_float(c.x << 16), __uint_as_float(c.x & 0xffff0000u), __uint_as_float(c.y << 16), __uint_as_float(c.y & 0xffff0000u)}; }
            }
        }
#pragma unroll
        for (int it = 0; it < 5; ++it) {
            const int i4 = tid + 512 * it, kk = i4 >> 4, d4 = (i4 & 15) * 4;
            if (i4 < 132 * 16) { Kf[kk * 65 + d4] = kq[it][0]; Kf[kk * 65 + d4 + 1] = kq[it][1]; Kf[kk * 65 + d4 + 2] = kq[it][2]; Kf[kk * 65 + d4 + 3] = kq[it][3]; *(LAS f32x4*)(Vf + kk * 64 + d4) = vq[it]; }
        }
    }
    for (int kk_ = 0; kk_ < 2; ++kk_) { const int i = tid + 512 * kk_; const int r16 = i >> 6, d = i & 63, tt = r16 >> 2, r = r16 & 3;
        qf[r16 * 65 + d] = bf2f(proj[(size_t)(row0 + tt) * NPROJ + 1536 + (kvh * 4 + r) * 64 + d]); }
    __syncthreads();
    { const int r16 = tid & 15, kg = tid >> 4, tt = r16 >> 2;
      for (int j_ = 0; j_ < 5; ++j_) {
          const int kk = kg + 32 * j_; if (kk >= 132) continue;
          float s = 0.f;
#pragma unroll 16
          for (int d = 0; d < 64; ++d) s += qf[r16 * 65 + d] * Kf[kk * 65 + d];
          const bool ok = kk < 128 ? (kk >= tt + 1) : (kk - 128 <= tt);
          sc[r16 * 136 + kk] = ok ? s * 0.125f : -INFINITY;
      } }
    __syncthreads();
#pragma unroll
    for (int rr = 0; rr < 2; ++rr) {
        const int r16 = 2 * wave + rr; const float sink = P->in[17][kvh * 4 + (r16 & 3)];
        float v[3]; float mx = sink;
#pragma unroll
        for (int j = 0; j < 3; ++j) { const int kk = lane + 64 * j; v[j] = kk < 132 ? sc[r16 * 136 + kk] : -INFINITY; mx = fmaxf(mx, v[j]); }
        mx = wave_max(mx); float sum = 0.f;
#pragma unroll
        for (int j = 0; j < 3; ++j) { v[j] = __expf(v[j] - mx); sum += v[j]; }
        const float inv = 1.f / (wave_sum(sum) + __expf(sink - mx));
#pragma unroll
        for (int j = 0; j < 3; ++j) { const int kk = lane + 64 * j; if (kk < 132) sc[r16 * 136 + kk] = v[j] * inv; }
    }
    __syncthreads();
    { const int r16 = tid >> 5, d2 = (tid & 31) * 2, tt = r16 >> 2, r = r16 & 3; float o0 = 0.f, o1 = 0.f;
      for (int kk = 0; kk < 132; ++kk) { const float p = sc[r16 * 136 + kk]; o0 += p * Vf[kk * 64 + d2]; o1 += p * Vf[kk * 64 + d2 + 1]; }
      *(unsigned*)((bf16_t*)(P->ws + WS_MIXIN) + (size_t)(row0 + tt) * 1024 + 512 + (kvh * 4 + r) * 64 + d2) = pk2(o0, o1); }
    __syncthreads();
}

__device__ __forceinline__ void xattn_prompt(CP P, LAS unsigned char* lds, int unit, int tid, int wave, int lane) {
    const int b = unit >> 6, h = (unit >> 4) & 3, qb = unit & 15;
    const int fr = lane & 15, fq = lane >> 4;
    LAS bf16_t* KV = (LAS bf16_t*)lds;
    LAS bf16_t* Ps = (LAS bf16_t*)(lds + 256 * PK * 2) + wave * 16 * PV;
    const bf16_t* q2 = (const bf16_t*)(P->ws + WS_Q2); const bf16_t* mk = (const bf16_t*)(P->ws + WS_MK); const bf16_t* mvt = (const bf16_t*)(P->ws + WS_MVT);
    const int row = b * SEQ + qb * 128 + 16 * wave + fr;
    f32x4 s[16];
#pragma unroll
    for (int n = 0; n < 16; ++n) s[n] = (f32x4){0.f, 0.f, 0.f, 0.f};
    u32x4 tmp[4];
#define XLOADK(dcv) { _Pragma("unroll") for (int it = 0; it < 4; ++it) { const int ci = tid + 512 * it, m = ci >> 3, c8 = ci & 7; tmp[it] = *(const u32x4*)(mk + (size_t)(b * 256 + m) * 1024 + h * 256 + (dcv) * 64 + c8 * 8); } }
#define XLOADV(dcv) { _Pragma("unroll") for (int it = 0; it < 4; ++it) { const int ci = tid + 512 * it, d = ci >> 5, c = ci & 31; tmp[it] = *(const u32x4*)(mvt + (size_t)(h * 256 + (dcv) * 64 + d) * 2048 + b * 256 + c * 8); } }
    XLOADK(0)
    for (int dc = 0; dc < 4; ++dc) {
        bf16x8 qf[2];
#pragma unroll
        for (int ks = 0; ks < 2; ++ks) qf[ks] = *(const bf16x8*)(q2 + (size_t)row * 1024 + h * 256 + dc * 64 + ks * 32 + 8 * fq);
        __syncthreads();
#pragma unroll
        for (int it = 0; it < 4; ++it) { const int ci = tid + 512 * it, m = ci >> 3, c8 = ci & 7; *(LAS u32x4*)(KV + m * PK + c8 * 8) = tmp[it]; }
        if (dc < 3) XLOADK(dc + 1) else XLOADV(0)
        __syncthreads();
        mma_areg<16, 2, 0, 2>(s, qf, KV, PK, lane);
    }
    float mx = -INFINITY;
#pragma unroll
    for (int n = 0; n < 16; ++n)
#pragma unroll
        for (int e = 0; e < 4; ++e) { s[n][e] *= 0.0625f; mx = fmaxf(mx, s[n][e]); }
    mx = fmaxf(mx, __shfl_xor(mx, 16)); mx = fmaxf(mx, __shfl_xor(mx, 32));
    float sum = 0.f;
#pragma unroll
    for (int n = 0; n < 16; ++n)
#pragma unroll
        for (int e = 0; e < 4; ++e) { const float ev = __expf(s[n][e] - mx); s[n][e] = ev; sum += ev; }
    sum += __shfl_xor(sum, 16); sum += __shfl_xor(sum, 32);
    const float inv = 1.f / sum;
    bf16x8 pf[8];
#pragma unroll
    for (int ks = 0; ks < 8; ++ks) { u32x4 w; w.x = pk2(s[2 * ks][0] * inv, s[2 * ks][1] * inv); w.y = pk2(s[2 * ks][2] * inv, s[2 * ks][3] * inv);
        w.z = pk2(s[2 * ks + 1][0] * inv, s[2 * ks + 1][1] * inv); w.w = pk2(s[2 * ks + 1][2] * inv, s[2 * ks + 1][3] * inv); pf[ks] = __builtin_bit_cast(bf16x8, w); }
    for (int dc = 0; dc < 4; ++dc) {
        __syncthreads();
#pragma unroll
        for (int it = 0; it < 4; ++it) { const int ci = tid + 512 * it, d = ci >> 5, c = ci & 31; *(LAS u32x4*)(KV + d * PV + c * 8) = tmp[it]; }
        if (dc < 3) XLOADV(dc + 1)
        __syncthreads();
        f32x4 o[4];
#pragma unroll
        for (int n = 0; n < 4; ++n) o[n] = (f32x4){0.f, 0.f, 0.f, 0.f};
#pragma unroll
        for (int ks = 0; ks < 8; ++ks) {
#pragma unroll
            for (int n = 0; n < 4; ++n) {
                const LAS bf16_t* vp = KV + (16 * n + fr) * PV + 32 * ks + 4 * fq;
                const u32x2 a0 = *(const LAS u32x2*)vp, a1 = *(const LAS u32x2*)(vp + 16);
                const u32x4 av = (u32x4){a0.x, a0.y, a1.x, a1.y};
                o[n] = __builtin_amdgcn_mfma_f32_16x16x32_bf16(__builtin_bit_cast(bf16x8, av), pf[ks], o[n], 0, 0, 0);
            }
            __builtin_amdgcn_sched_barrier(0);
        }
        bf16_t* op = (bf16_t*)(P->ws + WS_OX) + (size_t)row * 1024 + h * 256 + dc * 64 + 4 * fq;
#pragma unroll
        for (int n = 0; n < 4; ++n) { u32x2 w2; w2.x = pk2(o[n][0], o[n][1]); w2.y = pk2(o[n][2], o[n][3]); *(u32x2*)(op + 16 * n) = w2; }
    }
#undef XLOADK
#undef XLOADV
    __syncthreads();
}

__device__ __forceinline__ void xattn_prompt2(CP P, LAS unsigned char* lds, int unit, int tid, int wave, int lane) {
    const int b = unit >> 5, h = (unit >> 3) & 3, qb = unit & 7;
    const int fr = lane & 15, fq = lane >> 4;
    LAS bf16_t* KV = (LAS bf16_t*)lds;
    const bf16_t* q2 = (const bf16_t*)(P->ws + WS_Q2); const bf16_t* mk = (const bf16_t*)(P->ws + WS_MK); const bf16_t* mvt = (const bf16_t*)(P->ws + WS_MVT);
    const int row = b * SEQ + qb * 256 + 32 * wave + fr;
    f32x4 s[2][16];
#pragma unroll
    for (int mt = 0; mt < 2; ++mt)
#pragma unroll
        for (int n = 0; n < 16; ++n) s[mt][n] = (f32x4){0.f, 0.f, 0.f, 0.f};
    u32x4 tmp[4];
#define XLOADK(dcv) { _Pragma("unroll") for (int it = 0; it < 4; ++it) { const int ci = tid + 512 * it, m = ci >> 3, c8 = ci & 7; tmp[it] = *(const u32x4*)(mk + (size_t)(b * 256 + m) * 1024 + h * 256 + (dcv) * 64 + c8 * 8); } }
#define XLOADV(dcv) { _Pragma("unroll") for (int it = 0; it < 4; ++it) { const int ci = tid + 512 * it, d = ci >> 5, c = ci & 31; tmp[it] = *(const u32x4*)(mvt + (size_t)(h * 256 + (dcv) * 64 + d) * 2048 + b * 256 + c * 8); } }
    XLOADK(0)
    for (int dc = 0; dc < 4; ++dc) {
        bf16x8 qf[2][2];
#pragma unroll
        for (int mt = 0; mt < 2; ++mt)
#pragma unroll
            for (int ks = 0; ks < 2; ++ks) qf[mt][ks] = __builtin_nontemporal_load((const bf16x8*)(q2 + (size_t)(row + 16 * mt) * 1024 + h * 256 + dc * 64 + ks * 32 + 8 * fq));
        __syncthreads();
#pragma unroll
        for (int it = 0; it < 4; ++it) { const int ci = tid + 512 * it, m = ci >> 3, c8 = ci & 7; *(LAS u32x4*)(KV + m * PK + c8 * 8) = tmp[it]; }
        if (dc < 3) XLOADK(dc + 1)
        __syncthreads();
#pragma unroll
        for (int ks = 0; ks < 2; ++ks) {
#pragma unroll
            for (int n = 0; n < 16; ++n) {
                const bf16x8 bfr = *(const LAS bf16x8*)(KV + (16 * n + fr) * PK + ks * 32 + 8 * fq);
                s[0][n] = __builtin_amdgcn_mfma_f32_16x16x32_bf16(bfr, qf[0][ks], s[0][n], 0, 0, 0);
                s[1][n] = __builtin_amdgcn_mfma_f32_16x16x32_bf16(bfr, qf[1][ks], s[1][n], 0, 0, 0);
                if ((n & 3) == 3) __builtin_amdgcn_sched_barrier(0);
            }
        }
    }
    bf16x8 pf[2][8];
#pragma unroll
    for (int mt = 0; mt < 2; ++mt) {
        float mx = -INFINITY;
#pragma unroll
        for (int n = 0; n < 16; ++n)
#pragma unroll
            for (int e = 0; e < 4; ++e) { s[mt][n][e] *= 0.0625f; mx = fmaxf(mx, s[mt][n][e]); }
        mx = fmaxf(mx, __shfl_xor(mx, 16)); mx = fmaxf(mx, __shfl_xor(mx, 32));
        float sum = 0.f;
#pragma unroll
        for (int n = 0; n < 16; ++n)
#pragma unroll
            for (int e = 0; e < 4; ++e) { const float ev = __expf(s[mt][n][e] - mx); s[mt][n][e] = ev; sum += ev; }
        sum += __shfl_xor(sum, 16); sum += __shfl_xor(sum, 32);
        const float inv = 1.f / sum;
#pragma unroll
        for (int ks = 0; ks < 8; ++ks) { u32x4 w; w.x = pk2(s[mt][2 * ks][0] * inv, s[mt][2 * ks][1] * inv); w.y = pk2(s[mt][2 * ks][2] * inv, s[mt][2 * ks][3] * inv);
            w.z = pk2(s[mt][2 * ks + 1][0] * inv, s[mt][2 * ks + 1][1] * inv); w.w = pk2(s[mt][2 * ks + 1][2] * inv, s[mt][2 * ks + 1][3] * inv); pf[mt][ks] = __builtin_bit_cast(bf16x8, w); }
    }
    XLOADV(0)
    for (int dc = 0; dc < 4; ++dc) {
        __syncthreads();
#pragma unroll
        for (int it = 0; it < 4; ++it) { const int ci = tid + 512 * it, d = ci >> 5, c = ci & 31; *(LAS u32x4*)(KV + d * PV + c * 8) = tmp[it]; }
        if (dc < 3) XLOADV(dc + 1)
        __syncthreads();
        f32x4 o[2][4];
#pragma unroll
        for (int mt = 0; mt < 2; ++mt)
#pragma unroll
            for (int n = 0; n < 4; ++n) o[mt][n] = (f32x4){0.f, 0.f, 0.f, 0.f};
#pragma unroll
        for (int ks = 0; ks < 8; ++ks) {
#pragma unroll
            for (int n = 0; n < 4; ++n) {
                const LAS bf16_t* vp = KV + (16 * n + fr) * PV + 32 * ks + 4 * fq;
                const u32x2 a0 = *(const LAS u32x2*)vp, a1 = *(const LAS u32x2*)(vp + 16);
                const bf16x8 av = __builtin_bit_cast(bf16x8, (u32x4){a0.x, a0.y, a1.x, a1.y});
                o[0][n] = __builtin_amdgcn_mfma_f32_16x16x32_bf16(av, pf[0][ks], o[0][n], 0, 0, 0);
                o[1][n] = __builtin_amdgcn_mfma_f32_16x16x32_bf16(av, pf[1][ks], o[1][n], 0, 0, 0);
            }
            __builtin_amdgcn_sched_barrier(0);
        }
        asm volatile("s_nop 7\n\ts_nop 7\n\ts_nop 7" ::: "memory");
#pragma unroll
        for (int mt = 0; mt < 2; ++mt) {
            bf16_t* op = (bf16_t*)(P->ws + WS_OX) + (size_t)(row + 16 * mt) * 1024 + h * 256 + dc * 64 + 4 * fq;
#pragma unroll
            for (int n = 0; n < 4; ++n) { u32x2 w2; w2.x = pk2(o[mt][n][0], o[mt][n][1]); w2.y = pk2(o[mt][n][2], o[mt][n][3]); *(u32x2*)(op + 16 * n) = w2; }
        }
    }
#undef XLOADK
#undef XLOADV
    __syncthreads();
}

__device__ __forceinline__ void xattn_sample(CP P, LAS unsigned char* lds, int unit, int tid, int wave, int lane) {
    const int b = unit >> 2, h = unit & 3, row0 = TP + b * 4;
    LAS float* sc = (LAS float*)lds;
    LAS float* red = sc + 1024;
    const bf16_t* q2 = (const bf16_t*)(P->ws + WS_Q2);
    const float* kb = P->in[6] + ((size_t)(b * 256) * 4 + h) * 256;
    const float* vb = P->in[7] + ((size_t)(b * 256) * 4 + h) * 256 + 4 * lane;
    {
        const int fr = lane & 15, fq = lane >> 4;
        bf16x8 qf[8];
#pragma unroll
        for (int ks = 0; ks < 8; ++ks) { u32x4 z = (u32x4){0u, 0u, 0u, 0u}; if (fr < 4) z = *(const u32x4*)(q2 + (size_t)(row0 + fr) * 1024 + h * 256 + ks * 32 + 8 * fq); qf[ks] = __builtin_bit_cast(bf16x8, z); }
#pragma unroll
        for (int mt = 0; mt < 2; ++mt) {
            const int m0 = 32 * wave + 16 * mt; const float* kr = kb + (size_t)(m0 + fr) * 1024 + 8 * fq;
            f32x4 kv[16];
#pragma unroll
            for (int ks = 0; ks < 8; ++ks) { kv[2 * ks] = __builtin_nontemporal_load((const f32x4*)(kr + ks * 32)); kv[2 * ks + 1] = __builtin_nontemporal_load((const f32x4*)(kr + ks * 32 + 4)); }
            f32x4 acc = (f32x4){0.f, 0.f, 0.f, 0.f};
#pragma unroll
            for (int ks = 0; ks < 8; ++ks) { u32x4 a; a.x = pk2(kv[2 * ks][0], kv[2 * ks][1]); a.y = pk2(kv[2 * ks][2], kv[2 * ks][3]); a.z = pk2(kv[2 * ks + 1][0], kv[2 * ks + 1][1]); a.w = pk2(kv[2 * ks + 1][2], kv[2 * ks + 1][3]);
                acc = __builtin_amdgcn_mfma_f32_16x16x32_bf16(__builtin_bit_cast(bf16x8, a), qf[ks], acc, 0, 0, 0); }
            if (fr < 4) *(LAS f32x4*)(sc + fr * 256 + m0 + 4 * fq) = acc * 0.0625f;
        }
    }
    __syncthreads();
    if (wave < 4) {
        float v[4]; float mx = -INFINITY;
#pragma unroll
        for (int j = 0; j < 4; ++j) { v[j] = sc[wave * 256 + lane + 64 * j]; mx = fmaxf(mx, v[j]); }
        mx = wave_max(mx); float sum = 0.f;
#pragma unroll
        for (int j = 0; j < 4; ++j) { v[j] = __expf(v[j] - mx); sum += v[j]; }
        const float inv = 1.f / wave_sum(sum);
#pragma unroll
        for (int j = 0; j < 4; ++j) sc[wave * 256 + lane + 64 * j] = v[j] * inv;
    }
    __syncthreads();
    f32x4 acc[4];
#pragma unroll
    for (int tt = 0; tt < 4; ++tt) acc[tt] = (f32x4){0.f, 0.f, 0.f, 0.f};
#pragma unroll 8
    for (int i = 0; i < 32; ++i) {
        const int m = 32 * wave + i; const f32x4 v = __builtin_nontemporal_load((const f32x4*)(vb + (size_t)m * 1024));
#pragma unroll
        for (int tt = 0; tt < 4; ++tt) acc[tt] += v * sc[tt * 256 + m];
    }
#pragma unroll
    for (int tt = 0; tt < 4; ++tt) *(LAS f32x4*)(red + (wave * 4 + tt) * 256 + 4 * lane) = acc[tt];
    __syncthreads();
    for (int kk_ = 0; kk_ < 2; ++kk_) { const int i = tid + 512 * kk_; float s = 0.f;
#pragma unroll
        for (int w = 0; w < 8; ++w) s += red[w * 1024 + i];
        const int tt = i >> 8, d = i & 255; ((bf16_t*)(P->ws + WS_OX))[(size_t)(row0 + tt) * 1024 + h * 256 + d] = f2bf(s); }
    __syncthreads();
}

__device__ __forceinline__ void skinny_gemm(const bf16_t* A, const bf16_t* Wt, bf16_t* C, int K, int bid, int G, int wave, int lane) {
    const int fr = lane & 15, fq = lane >> 4;
    for (int t = bid; t < 256; t += G) {
        const int r0 = TP + 32 * (t & 15) + 16 * (wave & 1), c0 = 64 * (t >> 4) + 16 * (wave >> 1);
        const bf16_t* ap = A + (size_t)(r0 + fr) * K + 8 * fq; const bf16_t* bp = Wt + (size_t)(c0 + fr) * K + 8 * fq;
        f32x4 acc = (f32x4){0.f, 0.f, 0.f, 0.f};
        for (int kb = 0; kb < K; kb += 512) {
            bf16x8 av[16], bv[16];
#pragma unroll
            for (int j = 0; j < 16; ++j) { av[j] = *(const bf16x8*)(ap + kb + 32 * j); bv[j] = *(const bf16x8*)(bp + kb + 32 * j); }
#pragma unroll
            for (int j = 0; j < 16; ++j) acc = __builtin_amdgcn_mfma_f32_16x16x32_bf16(bv[j], av[j], acc, 0, 0, 0);
        }
        __builtin_amdgcn_sched_barrier(0);
        asm volatile("s_nop 7\n\ts_nop 7\n\ts_nop 7" ::: "memory");
        u32x2 w; w.x = pk2(acc[0], acc[1]); w.y = pk2(acc[2], acc[3]);
        *(u32x2*)(C + (size_t)(r0 + fr) * 1024 + c0 + 4 * fq) = w;
    }
}

__device__ __forceinline__ void copy_caches(CP P, int part, int t0_, int NT_) {
    unsigned char* ws = P->ws; const bf16_t* proj = (const bf16_t*)(ws + WS_PROJ);
    if (part == 0) {
        for (int base_ = 0; base_ < 2048 * 1024 / 4; base_ += 4 * NT_) {
            u32x2 a[4], c[4];
#pragma unroll
            for (int k = 0; k < 4; ++k) { const int i = base_ + k * NT_ + t0_; a[k] = (u32x2){0u, 0u}; c[k] = a[k]; if (i < 2048 * 1024 / 4) { a[k] = ((const u32x2*)(ws + WS_MK))[i]; c[k] = ((const u32x2*)(ws + WS_MV))[i]; } }
#pragma unroll
            for (int k = 0; k < 4; ++k) { const int i = base_ + k * NT_ + t0_; if (i < 2048 * 1024 / 4) {
                ((f32x4*)(P->out + O_PMK))[i] = (f32x4){__uint_as_float(a[k].x << 16), __uint_as_float(a[k].x & 0xffff0000u), __uint_as_float(a[k].y << 16), __uint_as_float(a[k].y & 0xffff0000u)};
                ((f32x4*)(P->out + O_PMV))[i] = (f32x4){__uint_as_float(c[k].x << 16), __uint_as_float(c[k].x & 0xffff0000u), __uint_as_float(c[k].y << 16), __uint_as_float(c[k].y & 0xffff0000u)}; } }
        }
        for (int base_ = 0; base_ < 8 * 128 * 128; base_ += NT_) { const int i = base_ + t0_; if (i >= 8 * 128 * 128) continue; const int b = i >> 14, r = (i >> 7) & 127, cidx = i & 127;
            const bf16_t* pr = proj + (size_t)(b * SEQ + 1920 + r) * NPROJ + cidx; P->out[O_PWK + i] = bf2f(pr[2048]); P->out[O_PWV + i] = bf2f(pr[2176]); }
        for (int base_ = 0; base_ < 128 * 4 * 128; base_ += NT_) { const int j = base_ + t0_; if (j >= 128 * 4 * 128) continue; const int b = j >> 9, t = (j >> 7) & 3, cidx = j & 127;
            const bf16_t* pr = proj + (size_t)(TP + b * 4 + t) * NPROJ + cidx; const size_t o = (size_t)(b * 128 + 124 + t) * 128 + cidx; P->out[O_SWK + o] = bf2f(pr[2048]); P->out[O_SWV + o] = bf2f(pr[2176]); }
    } else {
        for (int base_ = 0; base_ < 128 * 124 * 32; base_ += 4 * NT_) {
            f32x4 kv[4], vv[4];
#pragma unroll
            for (int k = 0; k < 4; ++k) { const int j = base_ + k * NT_ + t0_; kv[k] = (f32x4){0.f, 0.f, 0.f, 0.f}; vv[k] = kv[k];
                if (j < 128 * 124 * 32) { const int b = j / (124 * 32), rem = j - b * (124 * 32); const size_t i = (size_t)b * 16384 + 4 * rem; kv[k] = __builtin_nontemporal_load((const f32x4*)(P->in[4] + i + 512)); vv[k] = __builtin_nontemporal_load((const f32x4*)(P->in[5] + i + 512)); } }
#pragma unroll
            for (int k = 0; k < 4; ++k) { const int j = base_ + k * NT_ + t0_;
                if (j < 128 * 124 * 32) { const int b = j / (124 * 32), rem = j - b * (124 * 32); const size_t i = (size_t)b * 16384 + 4 * rem; *(f32x4*)(P->out + O_SWK + i) = kv[k]; *(f32x4*)(P->out + O_SWV + i) = vv[k]; } }
        }
    }
}

#define XB_TMO      128
#define XB_XCNT(j)  (256  + 64 * (j))
#define XB_XSUB(j)  (1280 + 64 * (j))
#define XB_XGEN(j)  (2304 + 64 * (j))
#define XB_TOP      3328
#define XB_TOPGEN   3392
#define XCD_BAR_WORDS 3456
#define XB_SPIN_CAP (1u << 18)

__device__ __forceinline__ unsigned xb_ld(unsigned* p)              { return __hip_atomic_load(p, __ATOMIC_RELAXED, __HIP_MEMORY_SCOPE_AGENT); }
__device__ __forceinline__ unsigned xb_add(unsigned* p, unsigned v) { return __hip_atomic_fetch_add(p, v, __ATOMIC_RELAXED, __HIP_MEMORY_SCOPE_AGENT); }
__device__ __forceinline__ unsigned xb_xcc_id() { return (unsigned)__builtin_amdgcn_s_getreg((3 << 11) | 20) & 0xFu; }
#define XB_SPIN(cond, bar) do { unsigned _sp = 0; while (cond) { __builtin_amdgcn_s_sleep(1); \
    if ((++_sp & 255u) == 0u) { if (xb_ld(&(bar)[XB_TMO])) break; if (_sp > XB_SPIN_CAP) { atomicAdd(&(bar)[XB_TMO], 1u); break; } } } } while (0)

struct XcdBarrier {
    unsigned* bar; unsigned x;
    volatile LAS unsigned* st;
};

__device__ __forceinline__ XcdBarrier xcd_barrier_post(unsigned* bar, volatile LAS unsigned* st) {
    XcdBarrier b; b.bar = bar; b.x = xb_xcc_id(); b.st = st;
    if (threadIdx.x == 0) (void)xb_add(&bar[XB_XCNT(b.x)], 1u);
    return b;
}
__device__ __forceinline__ void xcd_barrier_complete(unsigned* bar, unsigned x, unsigned& nloc, unsigned& nx) {
    const unsigned G = gridDim.x * gridDim.y * gridDim.z;
    unsigned sum, cnt, mine, sp = 0u;
    for (;;) {
        sum = 0u; cnt = 0u; mine = 0u;
#pragma unroll
        for (unsigned j = 0; j < 16; ++j) { const unsigned c = xb_ld(&bar[XB_XCNT(j)]); sum += c; cnt += (c > 0u) ? 1u : 0u; mine = (j == x) ? c : mine; }
        if (sum == G) break;
        __builtin_amdgcn_s_sleep(1);
        if ((++sp & 255u) == 0u) { if (xb_ld(&bar[XB_TMO])) break; if (sp > XB_SPIN_CAP) { atomicAdd(&bar[XB_TMO], 1u); break; } }
    }
    nloc = mine > 0u ? mine : 1u; nx = cnt > 0u ? cnt : 1u;
}

__device__ __forceinline__ void xcd_barrier(const XcdBarrier& b) {
    asm volatile("s_waitcnt vmcnt(0)" ::: "memory");
    __syncthreads();
    if (threadIdx.x == 0) {
        unsigned* bar = b.bar;
        __builtin_amdgcn_s_waitcnt(0);
        unsigned nloc = b.st[0], nx = b.st[1];
        if (nloc == 0u) { xcd_barrier_complete(bar, b.x, nloc, nx); b.st[0] = nloc; b.st[1] = nx; }
        const unsigned old = xb_add(&bar[XB_XSUB(b.x)], 1u);
        const unsigned gen = old / nloc;
        if (old + 1u == (gen + 1u) * nloc) {
            __builtin_amdgcn_fence(__ATOMIC_RELEASE, "agent");
            asm volatile("s_waitcnt vmcnt(0)" ::: "memory");
            const unsigned og = xb_add(&bar[XB_TOP], 1u);
            const unsigned tg = og / nx;
            if (og + 1u == (tg + 1u) * nx) xb_add(&bar[XB_TOPGEN], 1u);
            else XB_SPIN(xb_ld(&bar[XB_TOPGEN]) == tg, bar);
            __builtin_amdgcn_fence(__ATOMIC_ACQUIRE, "agent");
            xb_add(&bar[XB_XGEN(b.x)], 1u);
            asm volatile("s_waitcnt vmcnt(0)" ::: "memory");
        } else {
            XB_SPIN(xb_ld(&bar[XB_XGEN(b.x)]) == gen, bar);
            __builtin_amdgcn_fence(__ATOMIC_ACQUIRE, "agent");
            asm volatile("s_waitcnt vmcnt(0)" ::: "memory");
        }
    }
    __syncthreads();
}

constexpr int NPHASE = 13;
#ifndef SKN
#define SKN 2
#endif
#ifndef MK_MULTI
#define MK_MULTI 0
#endif
#ifndef TSW
#define TSW 0
#endif
__global__ void __launch_bounds__(512, 2) mk_fwd(Params P_) {
    CP P = (CP)__builtin_amdgcn_kernarg_segment_ptr(); asm volatile("" : "+s"(P));
    extern __shared__ __attribute__((aligned(16))) unsigned char lds_raw[];
    LAS unsigned char* lds = (LAS unsigned char*)lds_raw;
    const int G = gridDim.x, bid = blockIdx.x;
    volatile LAS unsigned* bar_st = (volatile LAS unsigned*)(lds + LDS_BYTES - 16);
    if (threadIdx.x < 4) bar_st[threadIdx.x] = 0u;
    __syncthreads();
    XcdBarrier xbar = xcd_barrier_post((unsigned*)P_.ws, bar_st);
#define TLW CP P = (CP)__builtin_amdgcn_kernarg_segment_ptr(); asm volatile("" : "+s"(P)); unsigned char* ws = P->ws; (void)ws; int tid = threadIdx.x; asm volatile("" : "+v"(tid)); const int lane = tid & 63, wave = __builtin_amdgcn_readfirstlane(tid >> 6); const int gw = bid * 8 + wave, NGW = G * 8; (void)gw; (void)NGW; (void)lane;
    unsigned char* ws = P->ws;
    const int lo = P->ph_lo, hi = P->ph_hi;
#ifndef PHMASK
#define PHMASK 0xffff
#endif
#define IN(k) (((PHMASK >> (k)) & 1) && lo <= (k) && (k) < hi)
#ifndef REP_PHASE
#define REP_PHASE -1
#endif
#define NREP(k) ((k) == REP_PHASE ? 2 : 1)
#define SEAM(k) do { if (IN(k) && IN((k) + 1)) xcd_barrier(xbar); } while (0)
    bf16_t* R = (bf16_t*)(ws + WS_R);
#ifdef DUMP_BUF
    if (lo == 100) { TLW const bf16_t* src = (const bf16_t*)(ws + DUMP_BUF);
        for (size_t i = (size_t)bid * 512 + tid; i < (size_t)TT * 1024; i += (size_t)G * 512) { float v = bf2f(src[i]); if (!(fabsf(v) < 1e30f)) v = 12345.f; P->out[i] = v; } }
#endif

    if (IN(0)) for (int rep = 0; rep < NREP(0); ++rep) { TLW phase_prologue(P, lds, gw, NGW, wave, lane); }
    SEAM(0);
    if (IN(1)) {
        pg8::Gemm g{R, R, 0, 0, 1024}; Order S{754, G, bid, 0, 0};
        EpiP1 E{(bf16_t*)(ws + WS_PROJ), (bf16_t*)(ws + WS_MK), (bf16_t*)(ws + WS_MV), (bf16_t*)(ws + WS_MVT), (bf16_t*)(ws + WS_KVT)};
        pg8::gemm_phase<EpiP1, Order, true, true>(lds, g, S, E);
    }
    SEAM(1);
    if (IN(2)) for (int rep = 0; rep < NREP(2); ++rep) {
        TLW
        if (!(TSW & 4)) for (int u = bid; u < 256; u += G) ssd_pass_a(P, lds, u, tid, wave, lane);
        if (!(TSW & 8)) for (int u = bid; u < 256; u += G) swa_prompt(P, lds, u, tid, wave, lane);
        if (!(TSW & 16)) for (int u = bid; u < 256; u += G) ssd_sample(P, lds, u, tid, wave, lane);
        if (!(TSW & 32)) for (int u = bid; u < 256; u += G) swa_sample(P, lds, u, tid, wave, lane);
    }
    SEAM(2);
    if (IN(3)) { { TLW ssd_state_scan(P, bid, G, tid); } xcd_barrier(xbar); }
    if (IN(3)) for (int rep = 0; rep < NREP(3); ++rep) { TLW for (int u = bid; u < 256; u += G) ssd_pass_b(P, lds, u, tid, wave, lane); }
    SEAM(3);
    if (IN(4)) for (int rep = 0; rep < NREP(4); ++rep) {
        pg8::Gemm g{(const bf16_t*)(ws + WS_MIXIN), (const bf16_t*)(ws + WS_WOUT), TT, 1024, 1024}; Order S{272, G, bid, 3, 16};
        EpiBf E{(bf16_t*)(ws + WS_CB16), 1024, 1.f, (float*)(ws + WS_SPLIT)};
        pg8::gemm_phase<EpiBf, Order, true, true>(lds, g, S, E);
        if (bid + G >= 272 && rep == 0) { TLW const int nb_ = G - (272 - G > 0 ? 272 - G : 0); tr_items(P, lds, 1, (bid - (G - nb_)) * 8 + wave, nb_ * 8, wave, lane); }
        if ((SKN >> 0) & 1) { TLW skinny_gemm((const bf16_t*)(ws + WS_MIXIN), (const bf16_t*)(ws + WS_WOUT), (bf16_t*)(ws + WS_CB16), 1024, bid, G, wave, lane); }
    }
    SEAM(4);
#ifdef SYNC_EXTRA
    for (int r_ = 0; r_ < SYNC_EXTRA; ++r_) cg::this_grid().sync();
#endif
    if (IN(5)) for (int rep = 0; rep < NREP(5); ++rep) { TLW phase_resid(P, 0, gw, NGW, lane); }
    SEAM(5);
    if (IN(6)) {
        pg8::Gemm g{(const bf16_t*)(ws + WS_H0), (const bf16_t*)(ws + WS_WXQ), TT, 1024, 1024}; Order S{256, G, bid, 1, 4};
        EpiBf E{(bf16_t*)(ws + WS_Q2), 1024, 1.f, nullptr};
        pg8::gemm_phase<EpiBf, Order, true, true>(lds, g, S, E);
        if ((SKN >> 1) & 1) { TLW skinny_gemm((const bf16_t*)(ws + WS_H0), (const bf16_t*)(ws + WS_WXQ), (bf16_t*)(ws + WS_Q2), 1024, bid, G, wave, lane); }
    }
    SEAM(6);
    if (IN(7)) for (int rep = 0; rep < NREP(7); ++rep) {
        TLW
        if ((bid >> 3) & 1) { for (int u = bid; u < 256; u += G) xattn_prompt2(P, lds, u, tid, wave, lane); }
        for (int u = bid; u < 512; u += G) xattn_sample(P, lds, u, tid, wave, lane);
        if (!((bid >> 3) & 1)) { for (int u = bid; u < 256; u += G) xattn_prompt2(P, lds, u, tid, wave, lane); }
    }
    SEAM(7);
    if (IN(8)) {
        pg8::Gemm g{(const bf16_t*)(ws + WS_OX), (const bf16_t*)(ws + WS_WXO), TT, 1024, 1024}; Order S{272, G, bid, 3, 16};
        EpiBf E{(bf16_t*)(ws + WS_CB16), 1024, 1.f, (float*)(ws + WS_SPLIT) + 8 * 512 * 1024};
        pg8::gemm_phase<EpiBf, Order, true, true>(lds, g, S, E);
        { TLW const int first_ = G > 16 ? 16 : 0; if (bid >= first_) copy_caches(P, 0, (bid - first_) * 512 + tid, (G - first_) * 512); }
        if ((SKN >> 2) & 1) { TLW skinny_gemm((const bf16_t*)(ws + WS_OX), (const bf16_t*)(ws + WS_WXO), (bf16_t*)(ws + WS_CB16), 1024, bid, G, wave, lane); }
    }
    SEAM(8);
    if (IN(9)) { TLW phase_resid(P, 1, gw, NGW, lane); }
    SEAM(9);
    if (IN(10)) for (int rep = 0; rep < NREP(10); ++rep) {
        pg8::Gemm g{(const bf16_t*)(ws + WS_H0), (const bf16_t*)(ws + WS_WGU), TT, 2 * DFF, 1024}; Order S{66 * 22, G, bid, 1, 22};
        EpiGU E{(bf16_t*)(ws + WS_ACT)};
        pg8::gemm_phase<EpiGU, Order, true, true>(lds, g, S, E);
    }
    SEAM(10);
    if (IN(11)) for (int rep = 0; rep < NREP(11); ++rep) {
        pg8::Gemm g{(const bf16_t*)(ws + WS_ACT), (const bf16_t*)(ws + WS_WDN), TT, 1024, DFF}; Order S{288, G, bid, 2, 44};
        EpiBf E{(bf16_t*)(ws + WS_CB16), 1024, 1.f, (float*)(ws + WS_SPLIT) + 12 * 512 * 1024};
        pg8::gemm_phase<EpiBf, Order, true, true>(lds, g, S, E);
        if (rep == 0) { TLW const int first_ = G > 32 ? 32 : 0; if (bid >= first_) copy_caches(P, 1, (bid - first_) * 512 + tid, (G - first_) * 512); }
        if ((SKN >> 3) & 1) { TLW skinny_gemm((const bf16_t*)(ws + WS_ACT), (const bf16_t*)(ws + WS_WDN), (bf16_t*)(ws + WS_CB16), DFF, bid, G, wave, lane); }
    }
    SEAM(11);
    if (IN(12)) { TLW phase_resid(P, 2, gw, NGW, lane); }
#undef IN
#undef SEAM
}

#ifndef MK_MULTI
#define MK_MULTI 0
#endif
#ifndef NPH_RUN
#define NPH_RUN 13
#endif
extern "C" void kernel_launch(void* const* d_in, const int* in_sizes, int n_in, void* d_out, int out_size, void* d_ws, size_t ws_size, hipStream_t stream) {
    static int grid = 0;
    if (grid == 0) {
        if (n_in != 32 || ws_size < WS_END) { fprintf(stderr, "kernel_launch: n_in %d ws %zu (need %zu)\n", n_in, ws_size, (size_t)WS_END); grid = -1; return; }
        int dev = 0, cus = 0, per_cu = 0;
        hipGetDevice(&dev); hipDeviceGetAttribute(&cus, hipDeviceAttributeMultiprocessorCount, dev);
        hipFuncSetAttribute((const void*)mk_fwd, hipFuncAttributeMaxDynamicSharedMemorySize, LDS_BYTES);
        hipOccupancyMaxActiveBlocksPerMultiprocessor(&per_cu, (const void*)mk_fwd, 512, LDS_BYTES);
        if (per_cu < 1) { fprintf(stderr, "kernel_launch: occupancy query says %d blocks per CU\n", per_cu); per_cu = 1; }
        grid = cus;
        (void)hipGetLastError();
    }
    if (grid < 0) return;
    (void)hipMemsetAsync(d_ws, 0, 16384, stream);
    Params p{};
    for (int i = 0; i < 32; ++i) p.in[i] = (const float*)d_in[i];
    p.out = (float*)d_out; p.ws = (unsigned char*)d_ws;
#if MK_MULTI
    for (int ph = 0; ph < NPH_RUN; ++ph) { p.ph_lo = ph; p.ph_hi = ph + 1; hipLaunchKernelGGL(mk_fwd, dim3(grid), dim3(512), LDS_BYTES, stream, p); }
#ifdef DUMP_BUF
    p.ph_lo = 100; p.ph_hi = 100; hipLaunchKernelGGL(mk_fwd, dim3(grid), dim3(512), LDS_BYTES, stream, p);
#endif
#else
    p.ph_lo = 0; p.ph_hi = NPHASE;
    void* args[] = {&p};
    hipError_t e = hipLaunchCooperativeKernel((const void*)mk_fwd, dim3(grid), dim3(512), args, LDS_BYTES, stream);
    if (e != hipSuccess) fprintf(stderr, "cooperative launch failed: %s (grid %d)\n", hipGetErrorString(e), grid);
#endif
}
```

```cpp
#include <hip/hip_runtime.h>
#include <hip/hip_cooperative_groups.h>
#include <cstdio>
#include <cstdint>
namespace cg = cooperative_groups;
namespace pg8 {
#define PG8_LAS __attribute__((address_space(3)))
typedef unsigned short bf16_t;
typedef short bf16x8 __attribute__((ext_vector_type(8)));
typedef float f32x4 __attribute__((ext_vector_type(4)));
typedef unsigned u32x4 __attribute__((ext_vector_type(4)));
constexpr int BM = 256, BK = 64, HALF = 128, HTB = HALF * BK * 2  , STAGE_BYTES = 8 * HTB, NXCD = 8, WGM = 8;

__host__ __device__ __forceinline__ int lds_byte(int r, int c) { const int st = (r >> 4) * 2 + (c >> 5), rr = r & 15, cc = c & 31, ob = rr * 64 + cc * 2; return st * 1024 + (ob ^ (((ob >> 9) & 1) << 5)); }
__host__ __device__ __forceinline__ void stage_rc(int b, int& R, int& C) { const int st = b / 1024, sb = b % 1024, swz = sb ^ (((sb >> 9) & 1) << 5); R = (st >> 1) * 16 + swz / 64; C = (st & 1) * 32 + (swz % 64) / 2; }
__host__ __device__ __forceinline__ int perm32(int rho) { const int n = rho >> 4, i = rho & 15; return 8 * (i >> 2) + 4 * n + (i & 3); }

struct Unit { int pm, pn, kofs, nt, q; };
struct Gemm { const bf16_t* A; const bf16_t* Bt; int M, N, K; };

struct StaticOrder {
    int nM, nN, nwg, G, c;
    __host__ __device__ void init(int M, int N, int G_, int c_) { nM = M / BM; nN = N / BM; nwg = nM * nN; G = G_; c = c_; }
    __host__ __device__ bool next(int i, Unit& u) const {
        const long L = (long)i * G + c; if (L >= nwg) return false;
        int wgid = (int)L; { const int q = nwg / NXCD, r = nwg % NXCD, xcd = wgid % NXCD, off = wgid / NXCD; wgid = (xcd < r ? xcd * (q + 1) : r * (q + 1) + (xcd - r) * q) + off; }
        const int nig = WGM * nN, gid = wgid / nig, fm = gid * WGM, gsz = (nM - fm) < WGM ? (nM - fm) : WGM;
        u.pm = fm + ((wgid % nig) % gsz); u.pn = (wgid % nig) / gsz; return true;
    }
    __device__ __forceinline__ void a_ready(const Unit&) const {}
    __device__ __forceinline__ void done(const Unit&) const {}
};

__device__ __forceinline__ unsigned cvt_pk_bf16(float lo, float hi) { unsigned r; asm volatile("v_cvt_pk_bf16_f32 %0, %1, %2" : "=v"(r) : "v"(lo), "v"(hi)); return r; }
typedef float f32x2 __attribute__((ext_vector_type(2)));
template <class Epi, class Sched, bool ALIGN_EPI = false, bool SP2 = false>
__device__ __forceinline__ void gemm_phase(PG8_LAS unsigned char* lds, const Gemm g, const Sched& S, const Epi& E) {
    int tid_ = threadIdx.x; asm volatile("" : "+v"(tid_));
    const int tid = tid_, wid = __builtin_amdgcn_readfirstlane(tid >> 6), lane = tid & 63, wr = wid >> 2, wc = wid & 3, fr = lane & 15, fq = lane >> 4;
    const int K = g.K; int nt = K / BK;
    unsigned voffA[2], voffB[2];
#pragma unroll
    for (int i = 0; i < 2; ++i) { int R, C; stage_rc(tid * 16 + i * 8192, R, C); const int Rb = Epi::PERM ? ((R & ~31) + perm32(R & 31)) : R;
        voffA[i] = (unsigned)(R * K + C) * 2u; voffB[i] = (unsigned)(Rb * K + C) * 2u; }
    const size_t kstep = (size_t)(BK * 2);
    const size_t hstep = (size_t)HALF * K * 2;
    const size_t tstep = 2 * hstep;
    const unsigned ldsw = (unsigned)wid * 1024u;
    const int aoff = lds_byte(wr * 64 + fr, fq * 8), boff = lds_byte(wc * 32 + fr, fq * 8);
#define PG8_SA(b, h) (((b) * 2 + (h)) * HTB)
#define PG8_SB(b, h) ((4 + (b) * 2 + (h)) * HTB)
#define PG8_STAGE(bufoff, gbase, voff) do { _Pragma("unroll") for (int _i = 0; _i < 2; ++_i) \
        __builtin_amdgcn_global_load_lds((const unsigned*)((const char*)(gbase) + (voff)[_i]), (PG8_LAS unsigned*)(lds + (bufoff) + ldsw + _i * 8192), 16, 0, 0); } while (0)
#define PG8_LDA(dst, b, h) do { _Pragma("unroll") for (int m = 0; m < 4; ++m) _Pragma("unroll") for (int k = 0; k < 2; ++k) dst[m][k] = *(const PG8_LAS bf16x8*)(lds + PG8_SA(b, h) + aoff + m * 2048 + k * 1024); } while (0)
#define PG8_LDB(dst, b, h) do { _Pragma("unroll") for (int n = 0; n < 2; ++n) _Pragma("unroll") for (int k = 0; k < 2; ++k) dst[n][k] = *(const PG8_LAS bf16x8*)(lds + PG8_SB(b, h) + boff + n * 2048 + k * 1024); } while (0)
#define PG8_MMA(ai, bj, At, Bt) do { __builtin_amdgcn_s_setprio(1); _Pragma("unroll") for (int m = 0; m < 4; ++m) _Pragma("unroll") for (int n = 0; n < 2; ++n) _Pragma("unroll") for (int k = 0; k < 2; ++k) \
        acc[ai][bj][m][n] = __builtin_amdgcn_mfma_f32_16x16x32_bf16(Bt[n][k], At[m][k], acc[ai][bj][m][n], 0, 0, 0); __builtin_amdgcn_s_setprio(0); } while (0)
#define PG8_WAIT_V(n) asm volatile("s_waitcnt vmcnt(" #n ")" ::: "memory")
#define PG8_WAIT_L(n) asm volatile("s_waitcnt lgkmcnt(" #n ")" ::: "memory")
#define PG8_BAR __builtin_amdgcn_s_barrier()
#define PG8_SCHED __builtin_amdgcn_sched_barrier(0)
    Unit cur, nxt; int ui = 0;
    if (!S.next(0, cur)) return;
    f32x4 acc[2][2][4][2];
#pragma unroll
    for (int a = 0; a < 2; ++a)
#pragma unroll
        for (int b = 0; b < 2; ++b)
#pragma unroll
            for (int m = 0; m < 4; ++m)
#pragma unroll
                for (int n = 0; n < 2; ++n) acc[a][b][m][n] = (f32x4){0.f, 0.f, 0.f, 0.f};
    bf16x8 At[4][2], B0[2][2], B1[2][2];
    const char* cA = (const char*)g.A + (size_t)cur.pm * tstep + (size_t)cur.kofs * 2; const char* cB = (const char*)g.Bt + (size_t)cur.pn * tstep + (size_t)cur.kofs * 2;
    if (cur.nt) nt = cur.nt;
    S.a_ready(cur);
    if constexpr (SP2) {
        PG8_STAGE(PG8_SB(0, 0), cB, voffB); PG8_STAGE(PG8_SB(0, 1), cB + hstep, voffB); PG8_STAGE(PG8_SA(0, 0), cA, voffA); PG8_STAGE(PG8_SA(0, 1), cA + hstep, voffA);
        if (wr == 1) PG8_BAR;
        PG8_WAIT_V(2); PG8_BAR;
        PG8_STAGE(PG8_SB(1, 0), cB + kstep, voffB); PG8_STAGE(PG8_SA(1, 0), cA + kstep, voffA); PG8_STAGE(PG8_SB(1, 1), cB + hstep + kstep, voffB);
        PG8_WAIT_V(6); PG8_BAR;
    } else {
        PG8_STAGE(PG8_SB(0, 0), cB, voffB); PG8_STAGE(PG8_SA(0, 0), cA, voffA); PG8_STAGE(PG8_SB(0, 1), cB + hstep, voffB); PG8_STAGE(PG8_SA(0, 1), cA + hstep, voffA);
        if (wr == 1) PG8_BAR;
        PG8_WAIT_V(4); PG8_BAR;
        PG8_STAGE(PG8_SB(1, 0), cB + kstep, voffB); PG8_STAGE(PG8_SA(1, 0), cA + kstep, voffA); PG8_STAGE(PG8_SB(1, 1), cB + hstep + kstep, voffB);
        PG8_WAIT_V(6); PG8_BAR;
    }
    for (;;) {
        const bool has_next = S.next(ui + 1, nxt);
        const char* nA = has_next ? (const char*)g.A + (size_t)nxt.pm * tstep + (size_t)nxt.kofs * 2 : cA; const char* nB = has_next ? (const char*)g.Bt + (size_t)nxt.pn * tstep + (size_t)nxt.kofs * 2 : cB;
        for (int t = 0; t < nt; t += 2) {
            const bool last = (t == nt - 2);
            const char* a1 = cA + (size_t)(t + 1) * kstep;
            const char* a2 = last ? nA : cA + (size_t)(t + 2) * kstep; const char* b2 = last ? nB : cB + (size_t)(t + 2) * kstep;
            const char* a3 = a2 + kstep; const char* b3 = b2 + kstep;
            if (last && has_next) S.a_ready(nxt);
            if constexpr (SP2) {
            PG8_LDB(B0, 0, 0); PG8_LDB(B1, 0, 1); PG8_SCHED; PG8_LDA(At, 0, 0); PG8_STAGE(PG8_SA(1, 1), a1 + hstep, voffA);
            PG8_WAIT_V(8); PG8_WAIT_L(0); PG8_BAR; PG8_MMA(0, 0, At, B0); PG8_MMA(0, 1, At, B1); PG8_BAR; PG8_SCHED;
            PG8_LDA(At, 0, 1); PG8_STAGE(PG8_SB(0, 0), b2, voffB); PG8_STAGE(PG8_SB(0, 1), b2 + hstep, voffB); PG8_STAGE(PG8_SA(0, 0), a2, voffA);
            PG8_WAIT_V(8); PG8_WAIT_L(0); PG8_BAR; PG8_MMA(1, 0, At, B0); PG8_MMA(1, 1, At, B1); PG8_BAR; PG8_SCHED;
            PG8_LDB(B0, 1, 0); PG8_LDB(B1, 1, 1); PG8_SCHED; PG8_LDA(At, 1, 0); PG8_STAGE(PG8_SA(0, 1), a2 + hstep, voffA);
            PG8_WAIT_V(8); PG8_WAIT_L(0); PG8_BAR; PG8_MMA(0, 0, At, B0); PG8_MMA(0, 1, At, B1); PG8_BAR; PG8_SCHED;
            PG8_LDA(At, 1, 1); PG8_STAGE(PG8_SB(1, 0), b3, voffB); PG8_STAGE(PG8_SB(1, 1), b3 + hstep, voffB); PG8_STAGE(PG8_SA(1, 0), a3, voffA);
            PG8_WAIT_V(8); PG8_WAIT_L(0); PG8_BAR; PG8_MMA(1, 0, At, B0); PG8_MMA(1, 1, At, B1); PG8_BAR; PG8_SCHED;
            } else {
            PG8_LDB(B0, 0, 0); PG8_SCHED; PG8_LDA(At, 0, 0); PG8_STAGE(PG8_SA(1, 1), a1 + hstep, voffA);
            PG8_WAIT_L(8); PG8_BAR; PG8_WAIT_L(0); PG8_MMA(0, 0, At, B0); PG8_BAR; PG8_SCHED;
            PG8_LDB(B1, 0, 1); PG8_STAGE(PG8_SB(0, 0), b2, voffB);
            PG8_BAR; PG8_WAIT_L(0); PG8_MMA(0, 1, At, B1); PG8_BAR;
            PG8_LDA(At, 0, 1); PG8_STAGE(PG8_SA(0, 0), a2, voffA);
            PG8_BAR; PG8_WAIT_L(0); PG8_MMA(1, 0, At, B0); PG8_BAR; PG8_SCHED;
            PG8_STAGE(PG8_SB(0, 1), b2 + hstep, voffB);
            PG8_WAIT_V(6); PG8_BAR; PG8_MMA(1, 1, At, B1); PG8_BAR;
            PG8_LDB(B0, 1, 0); PG8_SCHED; PG8_LDA(At, 1, 0); PG8_STAGE(PG8_SA(0, 1), a2 + hstep, voffA);
            PG8_WAIT_L(8); PG8_BAR; PG8_WAIT_L(0); PG8_MMA(0, 0, At, B0); PG8_BAR; PG8_SCHED;
            PG8_LDB(B1, 1, 1); PG8_STAGE(PG8_SB(1, 0), b3, voffB);
            PG8_BAR; PG8_WAIT_L(0); PG8_MMA(0, 1, At, B1); PG8_BAR;
            PG8_LDA(At, 1, 1); PG8_STAGE(PG8_SA(1, 0), a3, voffA);
            PG8_BAR; PG8_WAIT_L(0); PG8_MMA(1, 0, At, B0); PG8_BAR; PG8_SCHED;
            PG8_STAGE(PG8_SB(1, 1), b3 + hstep, voffB);
            PG8_WAIT_V(6); PG8_BAR; PG8_MMA(1, 1, At, B1); PG8_BAR;
            }
        }
        if constexpr (ALIGN_EPI) { if (wr == 0) PG8_BAR; }
        if constexpr (!Epi::AFTER_DRAIN) { E(acc, cur, wr, wc, fr, fq); S.done(cur); }
        if (!has_next) break;
#pragma unroll
        for (int a = 0; a < 2; ++a)
#pragma unroll
            for (int b = 0; b < 2; ++b)
#pragma unroll
                for (int m = 0; m < 4; ++m)
#pragma unroll
                    for (int n = 0; n < 2; ++n) acc[a][b][m][n] = (f32x4){0.f, 0.f, 0.f, 0.f};
        cur = nxt; cA = nA; cB = nB; ++ui; nt = cur.nt ? cur.nt : K / BK;
        if constexpr (ALIGN_EPI) { if (wr == 1) PG8_BAR; }
    }
    PG8_WAIT_V(0);
    if constexpr (!ALIGN_EPI) { if (wr == 0) PG8_BAR; }
    PG8_BAR;
    if constexpr (Epi::AFTER_DRAIN) { E.fused(acc, cur, wr, wc, fr, fq, lds, wid, lane); S.done(cur); }
#undef PG8_SA
#undef PG8_SB
#undef PG8_STAGE
#undef PG8_LDA
#undef PG8_LDB
#undef PG8_MMA
#undef PG8_WAIT_V
#undef PG8_WAIT_L
#undef PG8_BAR
#undef PG8_SCHED
}
}
#define LAS __attribute__((address_space(3)))
typedef unsigned short bf16_t;
typedef float f32x4 __attribute__((ext_vector_type(4)));
typedef short bf16x8 __attribute__((ext_vector_type(8)));
typedef unsigned u32x4 __attribute__((ext_vector_type(4)));
typedef unsigned u32x2 __attribute__((ext_vector_type(2)));

constexpr int DM = 1024, TP = 16384, TS = 512, TT = TP + TS, SEQ = 2048, NB = 8, NSB = 128;
constexpr int NPROJ = 2304, INDIM = 2312, DFF = 2816;
constexpr float EPS = 1e-6f;
constexpr int RT_H0 = 0, RT_MN = 66, RT_WIN = 74, RT_WXKV = 83, RT_END = 91;
constexpr size_t WS_R = 1u << 20;
constexpr size_t WS_H0 = WS_R;
constexpr size_t WS_MN = WS_R + (size_t)RT_MN * 256 * 2048;
constexpr size_t WS_WIN = WS_R + (size_t)RT_WIN * 256 * 2048;
constexpr size_t WS_WXKV = WS_R + (size_t)RT_WXKV * 256 * 2048;
constexpr size_t WS_WOUT = WS_R + (size_t)RT_END * 256 * 2048;
constexpr size_t WS_WXQ = WS_WOUT + 2097152;
constexpr size_t WS_WXO = WS_WXQ + 2097152;
constexpr size_t WS_WGU = WS_WXO + 2097152;
constexpr size_t WS_WDN = WS_WGU + (size_t)2 * DFF * 1024 * 2;
constexpr size_t WS_DTRAW = WS_WDN + (size_t)1024 * DFF * 2;
constexpr size_t WS_SPLIT = WS_DTRAW + (size_t)TT * 8 * 4;
constexpr size_t WS_ATOT = WS_SPLIT + (size_t)16 * 512 * 1024 * 4;
constexpr size_t WS_MIXIN = WS_ATOT + 8192;
constexpr size_t WS_CB16 = WS_MIXIN + (size_t)TT * 1024 * 2;
constexpr size_t WS_Q2 = WS_CB16 + (size_t)TT * 1024 * 2;
constexpr size_t WS_OX = WS_Q2 + (size_t)TT * 1024 * 2;
constexpr size_t WS_PROJ = WS_OX + (size_t)TT * 1024 * 2;
constexpr size_t WS_KVT = WS_PROJ + (size_t)TT * NPROJ * 2;
constexpr size_t WS_MK = WS_KVT + (size_t)256 * TT * 2;
constexpr size_t WS_MVT = WS_MK + (size_t)2048 * 1024 * 2;
constexpr size_t WS_MV = WS_MVT + (size_t)2048 * 1024 * 2;
constexpr size_t WS_CS = WS_MV + (size_t)2048 * 1024 * 2;
constexpr size_t WS_X1 = WS_CS;
constexpr size_t WS_END1 = WS_X1 + (size_t)TT * 1024 * 2 > WS_CS + (size_t)8 * 16 * 8 * 8192 * 4 ? WS_X1 + (size_t)TT * 1024 * 2 : WS_CS + (size_t)8 * 16 * 8 * 8192 * 4;
constexpr size_t WS_ACT = WS_PROJ;
constexpr size_t WS_END2 = WS_ACT + (size_t)TT * DFF * 2;
constexpr size_t WS_END = WS_END1 > WS_END2 ? WS_END1 : WS_END2;
constexpr size_t O_Y = 0, O_PSSM = 17301504, O_PCONV = 17825792, O_PWK = 17850368, O_PWV = 17981440, O_PMK = 18112512, O_PMV = 20209664,
                 O_SSSM = 22306816, O_SCONV = 30695424, O_SWK = 31088640, O_SWV = 33185792;
constexpr int LDS_BYTES = 147456;

struct Params {
    const float* in[32]; float* out; unsigned char* ws; int ph_lo, ph_hi;
};
typedef const __attribute__((address_space(4))) Params* CP;

__device__ __forceinline__ float bf2f(bf16_t h) { return __uint_as_float(((unsigned)h) << 16); }
__device__ __forceinline__ unsigned pk2(float lo, float hi) { return pg8::cvt_pk_bf16(lo, hi); }
__device__ __forceinline__ bf16_t f2bf(float f) { return (bf16_t)(pk2(f, 0.f) & 0xffffu); }
__device__ __forceinline__ float wave_sum(float v) {
#pragma unroll
    for (int o = 1; o < 64; o <<= 1) v += __shfl_xor(v, o);
    return v;
}
__device__ __forceinline__ float wave_max(float v) {
#pragma unroll
    for (int o = 1; o < 64; o <<= 1) v = fmaxf(v, __shfl_xor(v, o));
    return v;
}
__device__ __forceinline__ float silu_f(float x) { return x / (1.f + __expf(-x)); }
__device__ __forceinline__ float softplus_f(float x) { return x > 20.f ? x : log1pf(__expf(x)); }
#define LDSW() asm volatile("s_waitcnt lgkmcnt(0)" ::: "memory")

template <int NT>
__device__ __forceinline__ void mma_lds(f32x4 (&acc)[NT], const LAS bf16_t* A, int lda, const LAS bf16_t* B, int ldb, int K, int lane) {
    const int fr = lane & 15, fq = lane >> 4;
    for (int k0 = 0; k0 < K; k0 += 32) {
        const bf16x8 a = *(const LAS bf16x8*)(A + fr * lda + k0 + 8 * fq);
#pragma unroll
        for (int n = 0; n < NT; ++n) {
            const bf16x8 b = *(const LAS bf16x8*)(B + (16 * n + fr) * ldb + k0 + 8 * fq);
            acc[n] = __builtin_amdgcn_mfma_f32_16x16x32_bf16(b, a, acc[n], 0, 0, 0);
        }
    }
}
template <int NT, int KS, int ks0, int nks>
__device__ __forceinline__ void mma_areg(f32x4 (&acc)[NT], const bf16x8 (&a)[KS], const LAS bf16_t* B, int ldb, int lane) {
    const int fr = lane & 15, fq = lane >> 4;
#pragma unroll
    for (int ks = 0; ks < nks; ++ks) {
#pragma unroll
        for (int n = 0; n < NT; ++n) {
            const bf16x8 b = *(const LAS bf16x8*)(B + (16 * n + fr) * ldb + ks * 32 + 8 * fq);
            acc[n] = __builtin_amdgcn_mfma_f32_16x16x32_bf16(b, a[ks0 + ks], acc[n], 0, 0, 0);
        }
        __builtin_amdgcn_sched_barrier(0);
    }
}

struct Order {
    int n, G, c, mode, nN;
    __device__ __forceinline__ bool next(int i, pg8::Unit& u) const {
        const long L0 = (long)i * G + c; if (L0 >= n) return false;
        u.kofs = 0; u.nt = 0; u.q = 0;
        if (mode == 2) { const int L = (int)L0; if (L < 256) { const int v = (L % 8) * 32 + L / 8; u.pm = v / 4; u.pn = v % 4; }
            else { const int l = L - 256, q = l & 3, hi = ((nN + 7) / 8) * 2, lo = (nN - 2 * hi) / 2; u.pm = 64 + (l >> 4); u.pn = (l >> 2) & 3; u.q = q; u.nt = q < 2 ? hi : lo; u.kofs = 64 * (q < 2 ? q * hi : 2 * hi + (q - 2) * lo); } return true; }
        if (mode == 3) { const int L = (int)L0; if (L < 256) { const int v = (L % 8) * 32 + L / 8; u.pm = v / 4; u.pn = v % 4; }
            else { const int l = L - 256, q = l & 1; u.pm = 64 + (l >> 3); u.pn = (l >> 1) & 3; u.q = q; u.nt = nN / 2; u.kofs = 64 * q * (nN / 2); } return true; }
        int L = (int)L0; { const int q = n / 8, r = n % 8, xcd = L % 8, off = L / 8; L = (xcd < r ? xcd * (q + 1) : r * (q + 1) + (xcd - r) * q) + off; }
        if (mode == 0) {
            if (L < 594) { u.pm = L / 9; u.pn = RT_WIN + L % 9; }
            else if (L < 658) { const int l = L - 594; u.pm = RT_MN + l / 8; u.pn = RT_WXKV + l % 8; }
            else if (L < 690) { const int l = L - 658; u.pm = RT_WXKV + 4 + l / 8; u.pn = RT_MN + l % 8; }
            else { u.pm = RT_WIN + 8; u.pn = L - 690; }
        } else { u.pm = L / nN; u.pn = L % nN; }
        return true;
    }
    __device__ __forceinline__ void a_ready(const pg8::Unit&) const {}
    __device__ __forceinline__ void done(const pg8::Unit&) const {}
};
struct EpiP1 {
    static constexpr bool PERM = false, AFTER_DRAIN = false;
    bf16_t* proj; bf16_t* mk; bf16_t* mv; bf16_t* mvt; bf16_t* kvt;
    __device__ __forceinline__ void operator()(const f32x4 (&acc)[2][2][4][2], const pg8::Unit& u, int wr, int wc, int fr, int fq) const {
        bf16_t* base; int ld;
        if (u.pm < RT_MN) { base = proj + (size_t)(u.pm * 256) * NPROJ + (u.pn - RT_WIN) * 256; ld = NPROJ; }
        else if (u.pm < RT_WIN) { const int ct = u.pn - RT_WXKV; base = (ct < 4 ? mk + ct * 256 : mv + (ct - 4) * 256) + (size_t)((u.pm - RT_MN) * 256) * 1024; ld = 1024; }
        else if (u.pm == RT_WIN + 8) { base = kvt + u.pn * 256; ld = TT; }
        else { base = mvt + (size_t)((u.pm - RT_WXKV - 4) * 256) * 2048 + (u.pn - RT_MN) * 256; ld = 2048; }
#pragma unroll
        for (int ai = 0; ai < 2; ++ai)
#pragma unroll
            for (int m = 0; m < 4; ++m) {
                bf16_t* rowp = base + (size_t)(128 * ai + 64 * wr + 16 * m + fr) * ld + 32 * wc + 4 * fq;
#pragma unroll
                for (int bj = 0; bj < 2; ++bj)
#pragma unroll
                    for (int n = 0; n < 2; ++n) { const f32x4 v = acc[ai][bj][m][n]; u32x2 w; w.x = pk2(v[0], v[1]); w.y = pk2(v[2], v[3]); *(u32x2*)(rowp + 128 * bj + 16 * n) = w; }
            }
    }
};
struct EpiBf {
    static constexpr bool PERM = false, AFTER_DRAIN = false;
    bf16_t* O; int ldc; float scale; float* part;
    __device__ __forceinline__ void operator()(const f32x4 (&acc)[2][2][4][2], const pg8::Unit& u, int wr, int wc, int fr, int fq) const {
        if (u.nt) {
#pragma unroll
            for (int ai = 0; ai < 2; ++ai)
#pragma unroll
                for (int m = 0; m < 4; ++m) { float* rowp = part + (size_t)u.q * 512 * 1024 + (size_t)((u.pm - 64) * 256 + 128 * ai + 64 * wr + 16 * m + fr) * 1024 + u.pn * 256 + 32 * wc + 4 * fq;
#pragma unroll
                    for (int bj = 0; bj < 2; ++bj)
#pragma unroll
                        for (int n = 0; n < 2; ++n) *(f32x4*)(rowp + 128 * bj + 16 * n) = acc[ai][bj][m][n]; }
            return;
        }
#pragma unroll
        for (int ai = 0; ai < 2; ++ai)
#pragma unroll
            for (int m = 0; m < 4; ++m) {
                bf16_t* rowp = O + (size_t)(u.pm * 256 + 128 * ai + 64 * wr + 16 * m + fr) * ldc + u.pn * 256 + 32 * wc + 4 * fq;
#pragma unroll
                for (int bj = 0; bj < 2; ++bj)
#pragma unroll
                    for (int n = 0; n < 2; ++n) { const f32x4 v = acc[ai][bj][m][n] * scale; u32x2 w; w.x = pk2(v[0], v[1]); w.y = pk2(v[2], v[3]); *(u32x2*)(rowp + 128 * bj + 16 * n) = w; }
            }
    }
};
struct EpiGU {
    static constexpr bool PERM = false, AFTER_DRAIN = false;
    bf16_t* O;
    __device__ __forceinline__ void operator()(const f32x4 (&acc)[2][2][4][2], const pg8::Unit& u, int wr, int wc, int fr, int fq) const {
#pragma unroll
        for (int ai = 0; ai < 2; ++ai)
#pragma unroll
            for (int m = 0; m < 4; ++m) {
                bf16_t* rowp = O + (size_t)(u.pm * 256 + 128 * ai + 64 * wr + 16 * m + fr) * DFF + u.pn * 128 + 16 * wc + 4 * fq;
#pragma unroll
                for (int bj = 0; bj < 2; ++bj) { const f32x4 g = acc[ai][bj][m][0], up = acc[ai][bj][m][1];
                    u32x2 w; w.x = pk2(silu_f(g[0]) * up[0], silu_f(g[1]) * up[1]); w.y = pk2(silu_f(g[2]) * up[2], silu_f(g[3]) * up[3]); *(u32x2*)(rowp + 64 * bj) = w; }
            }
    }
};

struct TrSrc { const float* lo; const float* hi; int ld; };
__device__ __forceinline__ void tr_item(const TrSrc s, int k0, bf16_t* dst, int K, LAS float* scr, int lane) {
    const float* p = (lane & 16) ? s.hi + (lane & 15) : s.lo + (lane & 15);
    float tv[32];
#pragma unroll
    for (int i = 0; i < 32; ++i) { const int kk = 2 * i + (lane >> 5); tv[i] = __builtin_nontemporal_load(p + (size_t)(k0 + kk) * s.ld); }
#pragma unroll
    for (int i = 0; i < 32; ++i) { const int kk = 2 * i + (lane >> 5); scr[kk * 33 + (lane & 31)] = tv[i]; }
    LDSW();
    const int c = lane & 7;
#pragma unroll
    for (int j = 0; j < 4; ++j) { const int n = (lane >> 3) + 8 * j; const LAS float* q = scr + (8 * c) * 33 + n;
        u32x4 o; o.x = pk2(q[0], q[33]); o.y = pk2(q[2 * 33], q[3 * 33]); o.z = pk2(q[4 * 33], q[5 * 33]); o.w = pk2(q[6 * 33], q[7 * 33]);
        *(u32x4*)(dst + (size_t)n * K + 8 * c) = o; }
    LDSW();
}
__device__ __forceinline__ void rms_apply(f32x4 (&v)[4], const float* g, int lane) {
    float ss = 0.f;
#pragma unroll
    for (int j = 0; j < 4; ++j) ss += (v[j][0] * v[j][0] + v[j][1] * v[j][1]) + (v[j][2] * v[j][2] + v[j][3] * v[j][3]);
    const float r = rsqrtf(wave_sum(ss) * (1.f / 1024.f) + EPS);
#pragma unroll
    for (int j = 0; j < 4; ++j) { const f32x4 gv = *(const f32x4*)(g + 4 * lane + 256 * j); v[j] = v[j] * r * gv; }
}
__device__ __forceinline__ void store_row_bf16(bf16_t* o, const f32x4 (&v)[4], int lane) {
#pragma unroll
    for (int j = 0; j < 4; ++j) { u32x2 w; w.x = pk2(v[j][0], v[j][1]); w.y = pk2(v[j][2], v[j][3]); *(u32x2*)(o + 4 * lane + 256 * j) = w; }
}
__device__ __forceinline__ void load_row_f32(f32x4 (&v)[4], const float* x, int lane) {
#pragma unroll
    for (int j = 0; j < 4; ++j) v[j] = __builtin_nontemporal_load((const f32x4*)(x + 4 * lane + 256 * j));
}

__device__ __forceinline__ void tr_items(CP P, LAS unsigned char* lds, int part, int gw, int NGW, int wave, int lane) {
    unsigned char* ws = P->ws;
    LAS float* scr = (LAS float*)(lds + wave * 16384);
    constexpr int I_IN = 72 * 16, I_SQ = 512, I_GU = 176 * 16, I_DN = 32 * 44;
    const int nitems = part == 0 ? I_IN + 3 * I_SQ : 2 * I_SQ + I_GU + I_DN;
    for (int it = gw; it < nitems; it += NGW) {
        int r = it; TrSrc s; bf16_t* dst; int K = 1024, k0; int which = -1;
        if (part == 0) { if (r >= I_IN) { r -= I_IN; const int w3 = r / I_SQ; r %= I_SQ; which = w3 == 0 ? 0 : w3 + 2; } }
        else { if (r < 2 * I_SQ) { which = 1 + r / I_SQ; r %= I_SQ; } else r -= 2 * I_SQ; }
        if (part == 0 && which < 0) { const int nb = r / 16, kb = r % 16, n0 = nb * 32, sc = n0 + (n0 >= 1536 ? 8 : 0);
            s.lo = P->in[10] + sc; s.hi = s.lo + 16; s.ld = INDIM; k0 = kb * 64; dst = (bf16_t*)(ws + WS_WIN) + (size_t)n0 * 1024 + k0; }
        else if (which >= 0) { const int nb = r / 16, kb = r % 16;
            const float* W = which == 0 ? P->in[18] : which == 1 ? P->in[21] : which == 2 ? P->in[25] : which == 3 ? P->in[23] : P->in[24];
            bf16_t* D = which == 0 ? (bf16_t*)(ws + WS_WOUT) : which == 1 ? (bf16_t*)(ws + WS_WXQ) : which == 2 ? (bf16_t*)(ws + WS_WXO) : which == 3 ? (bf16_t*)(ws + WS_WXKV) : (bf16_t*)(ws + WS_WXKV) + (size_t)1024 * 1024;
            s.lo = W + nb * 32; s.hi = s.lo + 16; s.ld = 1024; k0 = kb * 64; dst = D + (size_t)nb * 32 * 1024 + k0; }
        else if (r < I_GU) { const int nb = r / 16, kb = r % 16;
            s.lo = P->in[28] + nb * 16; s.hi = P->in[29] + nb * 16; s.ld = DFF; k0 = kb * 64; dst = (bf16_t*)(ws + WS_WGU) + (size_t)nb * 32 * 1024 + k0; }
        else { r -= I_GU; const int nb = r / 44, kb = r % 44; K = DFF;
            s.lo = P->in[30] + nb * 32; s.hi = s.lo + 16; s.ld = 1024; k0 = kb * 64; dst = (bf16_t*)(ws + WS_WDN) + (size_t)nb * 32 * DFF + k0; }
        tr_item(s, k0, dst, K, scr, lane);
    }
}
__device__ __forceinline__ void phase_prologue(CP P, LAS unsigned char* lds, int gw, int NGW, int wave, int lane) {
    unsigned char* ws = P->ws;
    tr_items(P, lds, 0, gw, NGW, wave, lane);
    __syncthreads();
    LAS float* wT = (LAS float*)lds;
    { const int tid = wave * 64 + lane;
#pragma unroll
      for (int it = 0; it < 4; ++it) { const int idx = tid + 512 * it, c = idx >> 1, hf = idx & 1; const f32x4 w = *(const f32x4*)(P->in[10] + (size_t)c * INDIM + 1536 + 4 * hf);
          wT[(4 * hf + 0) * 1024 + c] = w[0]; wT[(4 * hf + 1) * 1024 + c] = w[1]; wT[(4 * hf + 2) * 1024 + c] = w[2]; wT[(4 * hf + 3) * 1024 + c] = w[3]; } }
    __syncthreads();
    {
        f32x4 nx[4];
        if (gw < TT) load_row_f32(nx, gw < TP ? P->in[0] + (size_t)gw * 1024 : P->in[1] + (size_t)(gw - TP) * 1024, lane);
        for (int m = gw; m < TT; m += NGW) {
            f32x4 v[4];
#pragma unroll
            for (int j = 0; j < 4; ++j) v[j] = nx[j];
            const int m2 = m + NGW;
            if (m2 < TT) load_row_f32(nx, m2 < TP ? P->in[0] + (size_t)m2 * 1024 : P->in[1] + (size_t)(m2 - TP) * 1024, lane);
            rms_apply(v, P->in[9], lane);
            store_row_bf16((bf16_t*)(ws + WS_H0) + (size_t)m * 1024, v, lane);
            float d[8];
#pragma unroll
            for (int e = 0; e < 8; ++e) { float a = 0.f;
#pragma unroll
                for (int j = 0; j < 4; ++j) { const f32x4 w = *(const LAS f32x4*)(wT + e * 1024 + 4 * lane + 256 * j); a += (v[j][0] * w[0] + v[j][1] * w[1]) + (v[j][2] * w[2] + v[j][3] * w[3]); }
                d[e] = wave_sum(a); }
            if (lane == 0) { float* o = (float*)(ws + WS_DTRAW) + (size_t)m * 8; *(f32x4*)o = (f32x4){d[0], d[1], d[2], d[3]}; *(f32x4*)(o + 4) = (f32x4){d[4], d[5], d[6], d[7]}; }
        }
    }
    __syncthreads();
    for (int m = gw; m < 2048; m += NGW) {
        f32x4 v[4]; load_row_f32(v, P->in[8] + (size_t)m * 1024, lane); rms_apply(v, P->in[22], lane);
        store_row_bf16((bf16_t*)(ws + WS_MN) + (size_t)m * 1024, v, lane);
    }
}

__device__ __forceinline__ void phase_resid(CP P, int stage, int gw, int NGW, int lane) {
    unsigned char* ws = P->ws; const bf16_t* C = (const bf16_t*)(ws + WS_CB16); bf16_t* XB = (bf16_t*)(ws + WS_X1);
    const float* g1 = stage == 0 ? P->in[19] : stage == 1 ? P->in[26] : P->in[31];
    const float* g2 = stage == 0 ? P->in[20] : P->in[27];
    for (int m = gw; m < TT; m += NGW) {
        f32x4 c[4], x[4];
        if (m >= TP) { const float* pp_ = (const float*)(ws + WS_SPLIT) + (size_t)(stage == 0 ? 0 : stage == 1 ? 8 : 12) * 512 * 1024 + (size_t)(m - TP) * 1024; f32x4 c1[4], c2[4], c3[4];
            load_row_f32(c, pp_, lane); load_row_f32(c1, pp_ + 512 * 1024, lane);
            if (stage == 2) { load_row_f32(c2, pp_ + 2 * 512 * 1024, lane); load_row_f32(c3, pp_ + 3 * 512 * 1024, lane); }
#pragma unroll
            for (int j = 0; j < 4; ++j) c[j] = stage == 2 ? (c[j] + c1[j]) + (c2[j] + c3[j]) : c[j] + c1[j]; }
        else {
#pragma unroll
        for (int j = 0; j < 4; ++j) { const u32x2 w = __builtin_nontemporal_load((const u32x2*)(C + (size_t)m * 1024 + 4 * lane + 256 * j));
            c[j] = (f32x4){__uint_as_float(w.x << 16), __uint_as_float(w.x & 0xffff0000u), __uint_as_float(w.y << 16), __uint_as_float(w.y & 0xffff0000u)}; }
        }
        if (stage == 0) load_row_f32(x, m < TP ? P->in[0] + (size_t)m * 1024 : P->in[1] + (size_t)(m - TP) * 1024, lane);
        else {
#pragma unroll
            for (int j = 0; j < 4; ++j) { const u32x2 w = *(const u32x2*)(XB + (size_t)m * 1024 + 4 * lane + 256 * j);
                x[j] = (f32x4){__uint_as_float(w.x << 16), __uint_as_float(w.x & 0xffff0000u), __uint_as_float(w.y << 16), __uint_as_float(w.y & 0xffff0000u)}; }
        }
        rms_apply(c, g1, lane);
#pragma unroll
        for (int j = 0; j < 4; ++j) x[j] = x[j] + c[j];
        if (stage == 2) {
#pragma unroll
            for (int j = 0; j < 4; ++j) *(f32x4*)(P->out + (size_t)m * 1024 + 4 * lane + 256 * j) = x[j];
        } else {
#pragma unroll
            for (int j = 0; j < 4; ++j) { u32x2 w; w.x = pk2(x[j][0], x[j][1]); w.y = pk2(x[j][2], x[j][3]); *(u32x2*)(XB + (size_t)m * 1024 + 4 * lane + 256 * j) = w;
                x[j] = (f32x4){__uint_as_float(w.x << 16), __uint_as_float(w.x & 0xffff0000u), __uint_as_float(w.y << 16), __uint_as_float(w.y & 0xffff0000u)}; }
            rms_apply(x, g2, lane); store_row_bf16((bf16_t*)(ws + WS_H0) + (size_t)m * 1024, x, lane);
        }
    }
}

__device__ __forceinline__ void conv8(const bf16_t* col, int t0, bool zero_hist, const float (&w)[4], float bias, float (&out)[8], float (&raw)[11]) {
#pragma unroll
    for (int i = 0; i < 11; ++i) { const int r = t0 - 3 + i; raw[i] = (r < 0 && zero_hist) ? 0.f : bf2f(col[(long)r * NPROJ]); }
#pragma unroll
    for (int j = 0; j < 8; ++j) out[j] = silu_f(bias + w[0] * raw[j] + w[1] * raw[j + 1] + w[2] * raw[j + 2] + w[3] * raw[j + 3]);
}
__device__ __forceinline__ void conv8x2(const bf16_t* col, int t0, bool zero_hist, const float* cw, const float* cb, int ch, float (&o0)[8], float (&o1)[8]) {
    float r0[11], r1[11];
#pragma unroll
    for (int i = 0; i < 11; ++i) { const int r = t0 - 3 + i; unsigned w = 0u; if (!(r < 0 && zero_hist)) w = *(const unsigned*)(col + (long)r * NPROJ); r0[i] = __uint_as_float(w << 16); r1[i] = __uint_as_float(w & 0xffff0000u); }
    const float b0 = cb[ch], b1 = cb[ch + 1];
    float w0[4], w1[4];
#pragma unroll
    for (int j = 0; j < 4; ++j) { w0[j] = cw[j * 1024 + ch]; w1[j] = cw[j * 1024 + ch + 1]; }
#pragma unroll
    for (int j = 0; j < 8; ++j) { o0[j] = silu_f(b0 + w0[0] * r0[j] + w0[1] * r0[j + 1] + w0[2] * r0[j + 2] + w0[3] * r0[j + 3]);
                                  o1[j] = silu_f(b1 + w1[0] * r1[j] + w1[1] * r1[j + 1] + w1[2] * r1[j + 2] + w1[3] * r1[j + 3]); }
}
__device__ __forceinline__ void dt_acum(CP P, int row0, int g, LAS float* dtv, LAS float* acum, int wave, int lane) {
    if (wave < 4) {
        const int h = g * 4 + wave; const float* dr = (const float*)(P->ws + WS_DTRAW);
        const float bias = P->in[13][h], a = -__expf(P->in[14][h]);
        const float d0 = softplus_f(dr[(size_t)(row0 + 2 * lane) * 8 + h] + bias), d1 = softplus_f(dr[(size_t)(row0 + 2 * lane + 1) * 8 + h] + bias);
        const float a0 = a * d0, a1 = a * d1; float s = a0 + a1;
#pragma unroll
        for (int o = 1; o < 64; o <<= 1) { const float t = __shfl_up(s, o); if (lane >= o) s += t; }
        dtv[(2 * lane) * 4 + wave] = d0; dtv[(2 * lane + 1) * 4 + wave] = d1;
        acum[(2 * lane) * 4 + wave] = s - a1; acum[(2 * lane + 1) * 4 + wave] = s;
    }
}

constexpr int PT = 136;
__device__ __forceinline__ void ssd_pass_a(CP P, LAS unsigned char* lds, int unit, int tid, int wave, int lane) {
    const int b = unit >> 5, c = (unit >> 1) & 15, g = unit & 1, row0 = b * SEQ + c * 128;
    LAS bf16_t* BT = (LAS bf16_t*)lds;
    LAS bf16_t* XW = (LAS bf16_t*)(lds + 128 * PT * 2);
    LAS float* dtv = (LAS float*)(lds + 384 * PT * 2); LAS float* acum = dtv + 512;
    const bf16_t* proj = (const bf16_t*)(P->ws + WS_PROJ);
    dt_acum(P, row0, g, dtv, acum, wave, lane);
    __syncthreads();
#pragma unroll 3
    for (int kk_ = 0; kk_ < 6; ++kk_) {
        const int it = tid + 512 * kk_;
        const int pr = it % 192, tb = it / 192, t0 = tb * 8, chl = 2 * pr;
        const int ch = chl < 256 ? g * 256 + chl : 512 + g * 128 + (chl - 256);
        float o0[8], o1[8]; conv8x2(proj + (size_t)row0 * NPROJ + 512 + ch, t0, c == 0, P->in[11], P->in[12], ch, o0, o1);
        if (chl < 256) { const int hh = chl >> 6; const float aend = acum[127 * 4 + hh];
#pragma unroll
            for (int j = 0; j < 8; ++j) { const float wg = dtv[(t0 + j) * 4 + hh] * __expf(aend - acum[(t0 + j) * 4 + hh]); o0[j] *= wg; o1[j] *= wg; } }
        u32x4 pk0, pk1; pk0.x = pk2(o0[0], o0[1]); pk0.y = pk2(o0[2], o0[3]); pk0.z = pk2(o0[4], o0[5]); pk0.w = pk2(o0[6], o0[7]);
        pk1.x = pk2(o1[0], o1[1]); pk1.y = pk2(o1[2], o1[3]); pk1.z = pk2(o1[4], o1[5]); pk1.w = pk2(o1[6], o1[7]);
        LAS bf16_t* d = chl < 256 ? XW + chl * PT + t0 : BT + (chl - 256) * PT + t0;
        *(LAS u32x4*)d = pk0; *(LAS u32x4*)(d + PT) = pk1;
    }
    __syncthreads();
    float* cs = (float*)(P->ws + WS_CS) + (size_t)((b * 16 + c) * 8 + g * 4) * 8192;
#pragma unroll
    for (int mt = 0; mt < 2; ++mt) {
        f32x4 acc[8];
#pragma unroll
        for (int n = 0; n < 8; ++n) acc[n] = (f32x4){0.f, 0.f, 0.f, 0.f};
        const int r0 = 32 * wave + 16 * mt;
        mma_lds<8>(acc, XW + r0 * PT, PT, BT, PT, 128, lane);
        const int fr = lane & 15, fq = lane >> 4;
#pragma unroll
        for (int n = 0; n < 8; ++n) *(f32x4*)(cs + (size_t)(r0 + fr) * 128 + 16 * n + 4 * fq) = acc[n];
    }
    if (tid < 4) ((float*)(P->ws + WS_ATOT))[(b * 16 + c) * 8 + g * 4 + tid] = acum[127 * 4 + tid];
    __syncthreads();
}

__device__ __forceinline__ void ssd_state_scan(CP P, int bid, int G, int tid) {
    for (int base_ = bid * 512; base_ < 8 * 8 * 2048; base_ += G * 512) {
        const int i = base_ + tid, bh = i >> 11, e4 = i & 2047, b = bh >> 3, h = bh & 7;
        float* cs = (float*)(P->ws + WS_CS) + (size_t)(b * 16 * 8 + h) * 8192 + 4 * e4;
        const float* at = (const float*)(P->ws + WS_ATOT) + b * 16 * 8 + h;
        f32x4 v[16]; float dec[16];
#pragma unroll
        for (int c = 0; c < 16; ++c) { v[c] = *(const f32x4*)(cs + (size_t)c * 8 * 8192); dec[c] = __expf(at[c * 8]); }
        f32x4 st = (f32x4){0.f, 0.f, 0.f, 0.f};
#pragma unroll
        for (int c = 0; c < 16; ++c) { *(f32x4*)(cs + (size_t)c * 8 * 8192) = st; st = st * dec[c] + v[c]; }
        *(f32x4*)(P->out + O_PSSM + (size_t)(b * 8 + h) * 8192 + 4 * e4) = st;
    }
}

__device__ __forceinline__ void ssd_pass_b(CP P, LAS unsigned char* lds, int unit, int tid, int wave, int lane) {
    const int b = unit >> 5, c = (unit >> 1) & 15, g = unit & 1, row0 = b * SEQ + c * 128;
    const int fr = lane & 15, fq = lane >> 4;
    LAS bf16_t* Cs = (LAS bf16_t*)lds;
    LAS bf16_t* Bs = (LAS bf16_t*)(lds + 128 * PT * 2);
    LAS bf16_t* XT = (LAS bf16_t*)(lds + 256 * PT * 2);
    LAS bf16_t* SI = (LAS bf16_t*)(lds + 320 * PT * 2);
    LAS float* dtv = (LAS float*)(lds + 384 * PT * 2); LAS float* acum = dtv + 512;
    const bf16_t* proj = (const bf16_t*)(P->ws + WS_PROJ);
    dt_acum(P, row0, g, dtv, acum, wave, lane);
#pragma unroll 4
    for (int kk_ = 0; kk_ < 4; ++kk_) {
        const int it = tid + 512 * kk_;
        const int chl = 2 * (it & 127), tb = it >> 7, t0 = tb * 8;
        const int ch = chl < 128 ? 512 + g * 128 + chl : 768 + g * 128 + (chl - 128);
        float o0[8], o1[8]; conv8x2(proj + (size_t)row0 * NPROJ + 512 + ch, t0, c == 0, P->in[11], P->in[12], ch, o0, o1);
        LAS bf16_t* d = chl < 128 ? Bs + chl : Cs + (chl - 128);
#pragma unroll
        for (int j = 0; j < 8; ++j) *(LAS unsigned*)(d + (t0 + j) * PT) = pk2(o0[j], o1[j]);
    }
    if (c == 15) {
        const int ch = tid < 256 ? g * 256 + tid : (tid < 384 ? 512 + g * 128 + (tid - 256) : 768 + g * 128 + (tid - 384));
#pragma unroll
        for (int i = 0; i < 3; ++i) P->out[O_PCONV + (size_t)(b * 3 + i) * 1024 + ch] = bf2f(proj[(size_t)(row0 + 125 + i) * NPROJ + 512 + ch]);
    }
    __syncthreads();
    f32x4 cb[8];
#pragma unroll
    for (int n = 0; n < 8; ++n) cb[n] = (f32x4){0.f, 0.f, 0.f, 0.f};
    mma_lds<8>(cb, Cs + 16 * wave * PT, PT, Bs, PT, 128, lane);
    __syncthreads();
    LAS bf16_t* Ls = Bs;
    const int t = 16 * wave + fr;
    float ss = 0.f;
    const bf16_t* zr = proj + (size_t)(row0 + t) * NPROJ + g * 256;
    bf16_t* orow = (bf16_t*)(P->ws + WS_MIXIN) + (size_t)(row0 + t) * 1024 + g * 256;
#pragma unroll 1
    for (int hh = 0; hh < 4; ++hh) {
        const int h = g * 4 + hh;
        u32x2 zw4[4];
#pragma unroll
        for (int n = 0; n < 4; ++n) zw4[n] = *(const u32x2*)(zr + hh * 64 + 16 * n + 4 * fq);
        {
            const int p = 2 * (tid & 31), tb = tid >> 5, t0 = tb * 8, ch = h * 64 + p;
            float o0[8], o1[8]; conv8x2(proj + (size_t)row0 * NPROJ + 512 + ch, t0, c == 0, P->in[11], P->in[12], ch, o0, o1);
            u32x4 pk0, pk1; pk0.x = pk2(o0[0], o0[1]); pk0.y = pk2(o0[2], o0[3]); pk0.z = pk2(o0[4], o0[5]); pk0.w = pk2(o0[6], o0[7]);
            pk1.x = pk2(o1[0], o1[1]); pk1.y = pk2(o1[2], o1[3]); pk1.z = pk2(o1[4], o1[5]); pk1.w = pk2(o1[6], o1[7]);
            *(LAS u32x4*)(XT + p * PT + t0) = pk0; *(LAS u32x4*)(XT + (p + 1) * PT + t0) = pk1;
        }
        {
            const int p = tid >> 3, n0 = (tid & 7) * 16;
            const float* src = (const float*)(P->ws + WS_CS) + (size_t)((b * 16 + c) * 8 + h) * 8192 + p * 128 + n0;
#pragma unroll
            for (int q = 0; q < 4; ++q) { const f32x4 sv = *(const f32x4*)(src + 4 * q); u32x2 w2; w2.x = pk2(sv[0], sv[1]); w2.y = pk2(sv[2], sv[3]); *(LAS u32x2*)(SI + p * PT + n0 + 4 * q) = w2; }
        }
        {
            const float at_ = acum[t * 4 + hh];
#pragma unroll
            for (int n = 0; n < 8; ++n) {
                float l[4];
#pragma unroll
                for (int e = 0; e < 4; ++e) { const int s_ = 16 * n + 4 * fq + e; l[e] = (s_ <= t) ? cb[n][e] * __expf(at_ - acum[s_ * 4 + hh]) * dtv[s_ * 4 + hh] : 0.f; }
                u32x2 w2; w2.x = pk2(l[0], l[1]); w2.y = pk2(l[2], l[3]); *(LAS u32x2*)(Ls + t * PT + 16 * n + 4 * fq) = w2;
            }
        }
        __syncthreads();
        {
            f32x4 yd[4], yo[4];
#pragma unroll
            for (int n = 0; n < 4; ++n) { yd[n] = (f32x4){0.f, 0.f, 0.f, 0.f}; yo[n] = (f32x4){0.f, 0.f, 0.f, 0.f}; }
            mma_lds<4>(yd, Ls + 16 * wave * PT, PT, XT, PT, 128, lane);
            mma_lds<4>(yo, Cs + 16 * wave * PT, PT, SI, PT, 128, lane);
            const float ea = __expf(acum[t * 4 + hh]), dsk = P->in[15][h];
#pragma unroll
            for (int n = 0; n < 4; ++n) {
                const u32x2 zw = zw4[n];
                const float z[4] = {__uint_as_float(zw.x << 16), __uint_as_float(zw.x & 0xffff0000u), __uint_as_float(zw.y << 16), __uint_as_float(zw.y & 0xffff0000u)};
                float u[4];
#pragma unroll
                for (int e = 0; e < 4; ++e) { u[e] = (yd[n][e] + ea * yo[n][e] + dsk * bf2f(XT[(16 * n + 4 * fq + e) * PT + t])) * silu_f(z[e]); ss += u[e] * u[e]; }
                u32x2 w2; w2.x = pk2(u[0], u[1]); w2.y = pk2(u[2], u[3]); *(u32x2*)(orow + hh * 64 + 16 * n + 4 * fq) = w2;
            }
        }
        __syncthreads();
    }
    {
        ss += __shfl_xor(ss, 16); ss += __shfl_xor(ss, 32);
        const float r = rsqrtf(ss * (1.f / 256.f) + EPS);
#pragma unroll
        for (int hh = 0; hh < 4; ++hh)
#pragma unroll
            for (int n = 0; n < 4; ++n) { const int col = hh * 64 + 16 * n + 4 * fq; const f32x4 gv = *(const f32x4*)(P->in[16] + g * 256 + col);
                const u32x2 uw = *(const u32x2*)(orow + col);
                const float u0 = __uint_as_float(uw.x << 16) * r * gv[0], u1 = __uint_as_float(uw.x & 0xffff0000u) * r * gv[1], u2 = __uint_as_float(uw.y << 16) * r * gv[2], u3 = __uint_as_float(uw.y & 0xffff0000u) * r * gv[3];
                u32x2 w2; w2.x = pk2(u0, u1); w2.y = pk2(u2, u3); *(u32x2*)(orow + col) = w2; }
    }
    __syncthreads();
}

constexpr int PK = 72, PV = 264;
__device__ __forceinline__ void swa_prompt(CP P, LAS unsigned char* lds, int unit, int tid, int wave, int lane) {
    const int b = unit >> 5, nb = (unit >> 1) & 15, kvh = unit & 1, row0 = b * SEQ + nb * 128;
    const int fr = lane & 15, fq = lane >> 4;
    LAS bf16_t* Ks = (LAS bf16_t*)lds;
    LAS bf16_t* VT = (LAS bf16_t*)(lds + 256 * PK * 2);
    const bf16_t* proj = (const bf16_t*)(P->ws + WS_PROJ); const bf16_t* kvt = (const bf16_t*)(P->ws + WS_KVT);
#pragma unroll
    for (int kk_ = 0; kk_ < 4; ++kk_) {
        const int ci = tid + 512 * kk_;
        { const int row = ci >> 3, c8 = ci & 7; u32x4 v = (u32x4){0u, 0u, 0u, 0u};
          if (!(nb == 0 && row < 128)) v = *(const u32x4*)(proj + (size_t)(row0 - 128 + row) * NPROJ + 2048 + kvh * 64 + c8 * 8);
          *(LAS u32x4*)(Ks + row * PK + c8 * 8) = v; }
        { const int d = ci >> 5, c = ci & 31; u32x4 v = (u32x4){0u, 0u, 0u, 0u};
          if (!(nb == 0 && c < 16)) v = *(const u32x4*)(kvt + (size_t)(128 + kvh * 64 + d) * TT + row0 - 128 + c * 8);
          *(LAS u32x4*)(VT + d * PV + c * 8) = v; }
    }
    __syncthreads();
    const int r = wave >> 1, head = kvh * 4 + r; const float sink = P->in[17][head];
    bf16x8 qn[2];
#pragma unroll
    for (int ks = 0; ks < 2; ++ks) qn[ks] = *(const bf16x8*)(proj + (size_t)(row0 + (wave & 1) * 64 + fr) * NPROJ + 1536 + head * 64 + ks * 32 + 8 * fq);
    for (int st = 0; st < 4; ++st) {
        const int q0 = (wave & 1) * 64 + 16 * st, qi = q0 + fr;
        bf16x8 qf[2];
#pragma unroll
        for (int ks = 0; ks < 2; ++ks) qf[ks] = qn[ks];
        if (st < 3) {
#pragma unroll
            for (int ks = 0; ks < 2; ++ks) qn[ks] = *(const bf16x8*)(proj + (size_t)(row0 + qi + 16) * NPROJ + 1536 + head * 64 + ks * 32 + 8 * fq);
        }
        f32x4 s[16];
#pragma unroll
        for (int n = 0; n < 16; ++n) s[n] = (f32x4){0.f, 0.f, 0.f, 0.f};
        mma_areg<16, 2, 0, 2>(s, qf, Ks, PK, lane);
        float mx = sink;
#pragma unroll
        for (int n = 0; n < 16; ++n)
#pragma unroll
            for (int e = 0; e < 4; ++e) { const int kj = 16 * n + 4 * fq + e; const bool ok = (kj > qi) && (kj <= qi + 128) && (nb > 0 || kj >= 128);
                const float v = ok ? s[n][e] * 0.125f : -INFINITY; s[n][e] = v; mx = fmaxf(mx, v); }
        mx = fmaxf(mx, __shfl_xor(mx, 16)); mx = fmaxf(mx, __shfl_xor(mx, 32));
        float sum = 0.f;
#pragma unroll
        for (int n = 0; n < 16; ++n)
#pragma unroll
            for (int e = 0; e < 4; ++e) { const float ev = __expf(s[n][e] - mx); s[n][e] = ev; sum += ev; }
        sum += __shfl_xor(sum, 16); sum += __shfl_xor(sum, 32);
        const float inv = 1.f / (sum + __expf(sink - mx));
        bf16x8 pf[8];
#pragma unroll
        for (int ks = 0; ks < 8; ++ks) { u32x4 w; w.x = pk2(s[2 * ks][0] * inv, s[2 * ks][1] * inv); w.y = pk2(s[2 * ks][2] * inv, s[2 * ks][3] * inv);
            w.z = pk2(s[2 * ks + 1][0] * inv, s[2 * ks + 1][1] * inv); w.w = pk2(s[2 * ks + 1][2] * inv, s[2 * ks + 1][3] * inv); pf[ks] = __builtin_bit_cast(bf16x8, w); }
        f32x4 o[4];
#pragma unroll
        for (int n = 0; n < 4; ++n) o[n] = (f32x4){0.f, 0.f, 0.f, 0.f};
#pragma unroll
        for (int ks = 0; ks < 8; ++ks) {
#pragma unroll
            for (int n = 0; n < 4; ++n) {
                const LAS bf16_t* vp = VT + (16 * n + fr) * PV + 32 * ks + 4 * fq;
                const u32x2 a0 = *(const LAS u32x2*)vp, a1 = *(const LAS u32x2*)(vp + 16);
                o[n] = __builtin_amdgcn_mfma_f32_16x16x32_bf16(__builtin_bit_cast(bf16x8, (u32x4){a0.x, a0.y, a1.x, a1.y}), pf[ks], o[n], 0, 0, 0);
            }
            __builtin_amdgcn_sched_barrier(0);
        }
        asm volatile("s_nop 7\n\ts_nop 7\n\ts_nop 7" ::: "memory");
        bf16_t* op = (bf16_t*)(P->ws + WS_MIXIN) + (size_t)(row0 + qi) * 1024 + 512 + head * 64 + 4 * fq;
#pragma unroll
        for (int n = 0; n < 4; ++n) { u32x2 w2; w2.x = pk2(o[n][0], o[n][1]); w2.y = pk2(o[n][2], o[n][3]); *(u32x2*)(op + 16 * n) = w2; }
        LDSW();
    }
    __syncthreads();
}

__device__ __forceinline__ void ssd_sample(CP P, LAS unsigned char* lds, int unit, int tid, int wave, int lane) {
    const int b = unit >> 1, g = unit & 1, row0 = TP + b * 4;
    LAS float* xs = (LAS float*)lds;
    LAS float* Bsm = xs + 1024;
    LAS float* Csm = Bsm + 544;
    LAS float* ys = Csm + 544;
    LAS float* dts = ys + 1024;
    const bf16_t* proj = (const bf16_t*)(P->ws + WS_PROJ);
    {
        const int ch = tid < 256 ? g * 256 + tid : (tid < 384 ? 512 + g * 128 + (tid - 256) : 768 + g * 128 + (tid - 384));
        float up[7];
#pragma unroll
        for (int i = 0; i < 3; ++i) up[i] = __builtin_nontemporal_load(P->in[3] + (size_t)(b * 3 + i) * 1024 + ch);
#pragma unroll
        for (int i = 0; i < 4; ++i) up[3 + i] = bf2f(proj[(size_t)(row0 + i) * NPROJ + 512 + ch]);
        float w[4];
#pragma unroll
        for (int j = 0; j < 4; ++j) w[j] = P->in[11][j * 1024 + ch];
        const float bias = P->in[12][ch];
        LAS float* dst = tid < 256 ? xs + tid : (tid < 384 ? Bsm + (tid - 256) + ((tid - 256) >> 4) : Csm + (tid - 384) + ((tid - 384) >> 4)); const int pitch = tid < 256 ? 256 : 136;
#pragma unroll
        for (int i = 0; i < 4; ++i) dst[i * pitch] = silu_f(bias + w[0] * up[i] + w[1] * up[i + 1] + w[2] * up[i + 2] + w[3] * up[i + 3]);
#pragma unroll
        for (int i = 0; i < 3; ++i) P->out[O_SCONV + (size_t)(b * 3 + i) * 1024 + ch] = up[4 + i];
        if (tid < 16) { const int tt = tid >> 2, hh = tid & 3, h = g * 4 + hh; dts[tid] = softplus_f(((const float*)(P->ws + WS_DTRAW))[(size_t)(row0 + tt) * 8 + h] + P->in[13][h]); }
    }
    __syncthreads();
    const int p = tid >> 3, n0 = (tid & 7) * 16;
    f32x4 stv[4][4];
#pragma unroll
    for (int hh = 0; hh < 4; ++hh)
#pragma unroll
        for (int q = 0; q < 4; ++q) stv[hh][q] = __builtin_nontemporal_load((const f32x4*)(P->in[2] + (size_t)((b * 8 + g * 4 + hh) * 64 + p) * 128 + n0 + 4 * q));
#pragma unroll
    for (int hh = 0; hh < 4; ++hh) {
        const int h = g * 4 + hh; const float a = -__expf(P->in[14][h]), dsk = P->in[15][h];
        float st[16];
#pragma unroll
        for (int q = 0; q < 4; ++q) { const f32x4 v = stv[hh][q]; st[4 * q] = v[0]; st[4 * q + 1] = v[1]; st[4 * q + 2] = v[2]; st[4 * q + 3] = v[3]; }
#pragma unroll
        for (int tt = 0; tt < 4; ++tt) {
            const float dt = dts[tt * 4 + hh], dA = __expf(a * dt), xv = xs[tt * 256 + hh * 64 + p], dx = dt * xv; float yv = 0.f;
#pragma unroll
            for (int q = 0; q < 16; ++q) { st[q] = dA * st[q] + dx * Bsm[tt * 136 + n0 + (n0 >> 4) + q]; yv += st[q] * Csm[tt * 136 + n0 + (n0 >> 4) + q]; }
            yv += __shfl_xor(yv, 1); yv += __shfl_xor(yv, 2); yv += __shfl_xor(yv, 4);
            if ((tid & 7) == 0) ys[tt * 256 + hh * 64 + p] = yv + dsk * xv;
        }
        float* op = P->out + O_SSSM + (size_t)((b * 8 + h) * 64 + p) * 128 + n0;
#pragma unroll
        for (int q = 0; q < 4; ++q) *(f32x4*)(op + 4 * q) = (f32x4){st[4 * q], st[4 * q + 1], st[4 * q + 2], st[4 * q + 3]};
    }
    __syncthreads();
    if (wave < 4) {
        const int tt = wave; const bf16_t* zr = proj + (size_t)(row0 + tt) * NPROJ + g * 256 + 4 * lane;
        const u32x2 zw = *(const u32x2*)zr; const float z[4] = {__uint_as_float(zw.x << 16), __uint_as_float(zw.x & 0xffff0000u), __uint_as_float(zw.y << 16), __uint_as_float(zw.y & 0xffff0000u)};
        float u[4], ss = 0.f;
#pragma unroll
        for (int e = 0; e < 4; ++e) { u[e] = ys[tt * 256 + 4 * lane + e] * silu_f(z[e]); ss += u[e] * u[e]; }
        const float r = rsqrtf(wave_sum(ss) * (1.f / 256.f) + EPS); const f32x4 gv = *(const f32x4*)(P->in[16] + g * 256 + 4 * lane);
        u32x2 w2; w2.x = pk2(u[0] * r * gv[0], u[1] * r * gv[1]); w2.y = pk2(u[2] * r * gv[2], u[3] * r * gv[3]);
        *(u32x2*)((bf16_t*)(P->ws + WS_MIXIN) + (size_t)(row0 + tt) * 1024 + g * 256 + 4 * lane) = w2;
    }
    __syncthreads();
}

__device__ __forceinline__ void swa_sample(CP P, LAS unsigned char* lds, int unit, int tid, int wave, int lane) {
    const int b = unit >> 1, kvh = unit & 1, row0 = TP + b * 4;
    LAS float* Kf = (LAS float*)lds;
    LAS float* Vf = Kf + 132 * 65;
    LAS float* qf = Vf + 132 * 64;
    LAS float* sc = qf + 16 * 65;
    const bf16_t* proj = (const bf16_t*)(P->ws + WS_PROJ);
    {
        f32x4 kq[5], vq[5];
#pragma unroll
        for (int it = 0; it < 5; ++it) {
            const int i4 = tid + 512 * it, kk = i4 >> 4, d4 = (i4 & 15) * 4; kq[it] = (f32x4){0.f, 0.f, 0.f, 0.f}; vq[it] = kq[it];
            if (i4 < 132 * 16) {
                if (kk < 128) { const size_t o = (size_t)((b * 128 + kk) * 2 + kvh) * 64 + d4; kq[it] = __builtin_nontemporal_load((const f32x4*)(P->in[4] + o)); vq[it] = __builtin_nontemporal_load((const f32x4*)(P->in[5] + o)); }
                else { const bf16_t* pr = proj + (size_t)(row0 + kk - 128) * NPROJ + kvh * 64 + d4; const u32x2 a = *(const u32x2*)(pr + 2048), c = *(const u32x2*)(pr + 2176);
                    kq[it] = (f32x4){__uint_as_float(a.x << 16), __uint_as_float(a.x & 0xffff0000u), __uint_as_float(a.y << 16), __uint_as_float(a.y & 0xffff0000u)};
                    vq[it] = (f32x4){__uint_as_float(c.x << 16), __uint_as_float(c.x & 0xffff0000u), __uint_as_float(c.y << 16), __uint_as_float(c.y & 0xffff0000u)}; }
            }
        }
#pragma unroll
        for (int it = 0; it < 5; ++it) {
            const int i4 = tid + 512 * it, kk = i4 >> 4, d4 = (i4 & 15) * 4;
            if (i4 < 132 * 16) { Kf[kk * 65 + d4] = kq[it][0]; Kf[kk * 65 + d4 + 1] = kq[it][1]; Kf[kk * 65 + d4 + 2] = kq[it][2]; Kf[kk * 65 + d4 + 3] = kq[it][3]; *(LAS f32x4*)(Vf + kk * 64 + d4) = vq[it]; }
        }
    }
    for (int kk_ = 0; kk_ < 2; ++kk_) { const int i = tid + 512 * kk_; const int r16 = i >> 6, d = i & 63, tt = r16 >> 2, r = r16 & 3;
        qf[r16 * 65 + d] = bf2f(proj[(size_t)(row0 + tt) * NPROJ + 1536 + (kvh * 4 + r) * 64 + d]); }
    __syncthreads();
    { const int r16 = tid & 15, kg = tid >> 4, tt = r16 >> 2;
      for (int j_ = 0; j_ < 5; ++j_) {
          const int kk = kg + 32 * j_; if (kk >= 132) continue;
          float s = 0.f;
#pragma unroll 16
          for (int d = 0; d < 64; ++d) s += qf[r16 * 65 + d] * Kf[kk * 65 + d];
          const bool ok = kk < 128 ? (kk >= tt + 1) : (kk - 128 <= tt);
          sc[r16 * 136 + kk] = ok ? s * 0.125f : -INFINITY;
      } }
    __syncthreads();
#pragma unroll
    for (int rr = 0; rr < 2; ++rr) {
        const int r16 = 2 * wave + rr; const float sink = P->in[17][kvh * 4 + (r16 & 3)];
        float v[3]; float mx = sink;
#pragma unroll
        for (int j = 0; j < 3; ++j) { const int kk = lane + 64 * j; v[j] = kk < 132 ? sc[r16 * 136 + kk] : -INFINITY; mx = fmaxf(mx, v[j]); }
        mx = wave_max(mx); float sum = 0.f;
#pragma unroll
        for (int j = 0; j < 3; ++j) { v[j] = __expf(v[j] - mx); sum += v[j]; }
        const float inv = 1.f / (wave_sum(sum) + __expf(sink - mx));
#pragma unroll
        for (int j = 0; j < 3; ++j) { const int kk = lane + 64 * j; if (kk < 132) sc[r16 * 136 + kk] = v[j] * inv; }
    }
    __syncthreads();
    { const int r16 = tid >> 5, d2 = (tid & 31) * 2, tt = r16 >> 2, r = r16 & 3; float o0 = 0.f, o1 = 0.f;
      for (int kk = 0; kk < 132; ++kk) { const float p = sc[r16 * 136 + kk]; o0 += p * Vf[kk * 64 + d2]; o1 += p * Vf[kk * 64 + d2 + 1]; }
      *(unsigned*)((bf16_t*)(P->ws + WS_MIXIN) + (size_t)(row0 + tt) * 1024 + 512 + (kvh * 4 + r) * 64 + d2) = pk2(o0, o1); }
    __syncthreads();
}

__device__ __forceinline__ void xattn_prompt(CP P, LAS unsigned char* lds, int unit, int tid, int wave, int lane) {
    const int b = unit >> 6, h = (unit >> 4) & 3, qb = unit & 15;
    const int fr = lane & 15, fq = lane >> 4;
    LAS bf16_t* KV = (LAS bf16_t*)lds;
    LAS bf16_t* Ps = (LAS bf16_t*)(lds + 256 * PK * 2) + wave * 16 * PV;
    const bf16_t* q2 = (const bf16_t*)(P->ws + WS_Q2); const bf16_t* mk = (const bf16_t*)(P->ws + WS_MK); const bf16_t* mvt = (const bf16_t*)(P->ws + WS_MVT);
    const int row = b * SEQ + qb * 128 + 16 * wave + fr;
    f32x4 s[16];
#pragma unroll
    for (int n = 0; n < 16; ++n) s[n] = (f32x4){0.f, 0.f, 0.f, 0.f};
    u32x4 tmp[4];
#define XLOADK(dcv) { _Pragma("unroll") for (int it = 0; it < 4; ++it) { const int ci = tid + 512 * it, m = ci >> 3, c8 = ci & 7; tmp[it] = *(const u32x4*)(mk + (size_t)(b * 256 + m) * 1024 + h * 256 + (dcv) * 64 + c8 * 8); } }
#define XLOADV(dcv) { _Pragma("unroll") for (int it = 0; it < 4; ++it) { const int ci = tid + 512 * it, d = ci >> 5, c = ci & 31; tmp[it] = *(const u32x4*)(mvt + (size_t)(h * 256 + (dcv) * 64 + d) * 2048 + b * 256 + c * 8); } }
    XLOADK(0)
    for (int dc = 0; dc < 4; ++dc) {
        bf16x8 qf[2];
#pragma unroll
        for (int ks = 0; ks < 2; ++ks) qf[ks] = *(const bf16x8*)(q2 + (size_t)row * 1024 + h * 256 + dc * 64 + ks * 32 + 8 * fq);
        __syncthreads();
#pragma unroll
        for (int it = 0; it < 4; ++it) { const int ci = tid + 512 * it, m = ci >> 3, c8 = ci & 7; *(LAS u32x4*)(KV + m * PK + c8 * 8) = tmp[it]; }
        if (dc < 3) XLOADK(dc + 1) else XLOADV(0)
        __syncthreads();
        mma_areg<16, 2, 0, 2>(s, qf, KV, PK, lane);
    }
    float mx = -INFINITY;
#pragma unroll
    for (int n = 0; n < 16; ++n)
#pragma unroll
        for (int e = 0; e < 4; ++e) { s[n][e] *= 0.0625f; mx = fmaxf(mx, s[n][e]); }
    mx = fmaxf(mx, __shfl_xor(mx, 16)); mx = fmaxf(mx, __shfl_xor(mx, 32));
    float sum = 0.f;
#pragma unroll
    for (int n = 0; n < 16; ++n)
#pragma unroll
        for (int e = 0; e < 4; ++e) { const float ev = __expf(s[n][e] - mx); s[n][e] = ev; sum += ev; }
    sum += __shfl_xor(sum, 16); sum += __shfl_xor(sum, 32);
    const float inv = 1.f / sum;
    bf16x8 pf[8];
#pragma unroll
    for (int ks = 0; ks < 8; ++ks) { u32x4 w; w.x = pk2(s[2 * ks][0] * inv, s[2 * ks][1] * inv); w.y = pk2(s[2 * ks][2] * inv, s[2 * ks][3] * inv);
        w.z = pk2(s[2 * ks + 1][0] * inv, s[2 * ks + 1][1] * inv); w.w = pk2(s[2 * ks + 1][2] * inv, s[2 * ks + 1][3] * inv); pf[ks] = __builtin_bit_cast(bf16x8, w); }
    for (int dc = 0; dc < 4; ++dc) {
        __syncthreads();
#pragma unroll
        for (int it = 0; it < 4; ++it) { const int ci = tid + 512 * it, d = ci >> 5, c = ci & 31; *(LAS u32x4*)(KV + d * PV + c * 8) = tmp[it]; }
        if (dc < 3) XLOADV(dc + 1)
        __syncthreads();
        f32x4 o[4];
#pragma unroll
        for (int n = 0; n < 4; ++n) o[n] = (f32x4){0.f, 0.f, 0.f, 0.f};
#pragma unroll
        for (int ks = 0; ks < 8; ++ks) {
#pragma unroll
            for (int n = 0; n < 4; ++n) {
                const LAS bf16_t* vp = KV + (16 * n + fr) * PV + 32 * ks + 4 * fq;
                const u32x2 a0 = *(const LAS u32x2*)vp, a1 = *(const LAS u32x2*)(vp + 16);
                const u32x4 av = (u32x4){a0.x, a0.y, a1.x, a1.y};
                o[n] = __builtin_amdgcn_mfma_f32_16x16x32_bf16(__builtin_bit_cast(bf16x8, av), pf[ks], o[n], 0, 0, 0);
            }
            __builtin_amdgcn_sched_barrier(0);
        }
        bf16_t* op = (bf16_t*)(P->ws + WS_OX) + (size_t)row * 1024 + h * 256 + dc * 64 + 4 * fq;
#pragma unroll
        for (int n = 0; n < 4; ++n) { u32x2 w2; w2.x = pk2(o[n][0], o[n][1]); w2.y = pk2(o[n][2], o[n][3]); *(u32x2*)(op + 16 * n) = w2; }
    }
#undef XLOADK
#undef XLOADV
    __syncthreads();
}

__device__ __forceinline__ void xattn_prompt2(CP P, LAS unsigned char* lds, int unit, int tid, int wave, int lane) {
    const int b = unit >> 5, h = (unit >> 3) & 3, qb = unit & 7;
    const int fr = lane & 15, fq = lane >> 4;
    LAS bf16_t* KV = (LAS bf16_t*)lds;
    const bf16_t* q2 = (const bf16_t*)(P->ws + WS_Q2); const bf16_t* mk = (const bf16_t*)(P->ws + WS_MK); const bf16_t* mvt = (const bf16_t*)(P->ws + WS_MVT);
    const int row = b * SEQ + qb * 256 + 32 * wave + fr;
    f32x4 s[2][16];
#pragma unroll
    for (int mt = 0; mt < 2; ++mt)
#pragma unroll
        for (int n = 0; n < 16; ++n) s[mt][n] = (f32x4){0.f, 0.f, 0.f, 0.f};
    u32x4 tmp[4];
#define XLOADK(dcv) { _Pragma("unroll") for (int it = 0; it < 4; ++it) { const int ci = tid + 512 * it, m = ci >> 3, c8 = ci & 7; tmp[it] = *(const u32x4*)(mk + (size_t)(b * 256 + m) * 1024 + h * 256 + (dcv) * 64 + c8 * 8); } }
#define XLOADV(dcv) { _Pragma("unroll") for (int it = 0; it < 4; ++it) { const int ci = tid + 512 * it, d = ci >> 5, c = ci & 31; tmp[it] = *(const u32x4*)(mvt + (size_t)(h * 256 + (dcv) * 64 + d) * 2048 + b * 256 + c * 8); } }
    XLOADK(0)
    for (int dc = 0; dc < 4; ++dc) {
        bf16x8 qf[2][2];
#pragma unroll
        for (int mt = 0; mt < 2; ++mt)
#pragma unroll
            for (int ks = 0; ks < 2; ++ks) qf[mt][ks] = __builtin_nontemporal_load((const bf16x8*)(q2 + (size_t)(row + 16 * mt) * 1024 + h * 256 + dc * 64 + ks * 32 + 8 * fq));
        __syncthreads();
#pragma unroll
        for (int it = 0; it < 4; ++it) { const int ci = tid + 512 * it, m = ci >> 3, c8 = ci & 7; *(LAS u32x4*)(KV + m * PK + c8 * 8) = tmp[it]; }
        if (dc < 3) XLOADK(dc + 1)
        __syncthreads();
#pragma unroll
        for (int ks = 0; ks < 2; ++ks) {
#pragma unroll
            for (int n = 0; n < 16; ++n) {
                const bf16x8 bfr = *(const LAS bf16x8*)(KV + (16 * n + fr) * PK + ks * 32 + 8 * fq);
                s[0][n] = __builtin_amdgcn_mfma_f32_16x16x32_bf16(bfr, qf[0][ks], s[0][n], 0, 0, 0);
                s[1][n] = __builtin_amdgcn_mfma_f32_16x16x32_bf16(bfr, qf[1][ks], s[1][n], 0, 0, 0);
                if ((n & 3) == 3) __builtin_amdgcn_sched_barrier(0);
            }
        }
    }
    bf16x8 pf[2][8];
#pragma unroll
    for (int mt = 0; mt < 2; ++mt) {
        float mx = -INFINITY;
#pragma unroll
        for (int n = 0; n < 16; ++n)
#pragma unroll
            for (int e = 0; e < 4; ++e) { s[mt][n][e] *= 0.0625f; mx = fmaxf(mx, s[mt][n][e]); }
        mx = fmaxf(mx, __shfl_xor(mx, 16)); mx = fmaxf(mx, __shfl_xor(mx, 32));
        float sum = 0.f;
#pragma unroll
        for (int n = 0; n < 16; ++n)
#pragma unroll
            for (int e = 0; e < 4; ++e) { const float ev = __expf(s[mt][n][e] - mx); s[mt][n][e] = ev; sum += ev; }
        sum += __shfl_xor(sum, 16); sum += __shfl_xor(sum, 32);
        const float inv = 1.f / sum;
#pragma unroll
        for (int ks = 0; ks < 8; ++ks) { u32x4 w; w.x = pk2(s[mt][2 * ks][0] * inv, s[mt][2 * ks][1] * inv); w.y = pk2(s[mt][2 * ks][2] * inv, s[mt][2 * ks][3] * inv);
            w.z = pk2(s[mt][2 * ks + 1][0] * inv, s[mt][2 * ks + 1][1] * inv); w.w = pk2(s[mt][2 * ks + 1][2] * inv, s[mt][2 * ks + 1][3] * inv); pf[mt][ks] = __builtin_bit_cast(bf16x8, w); }
    }
    XLOADV(0)
    for (int dc = 0; dc < 4; ++dc) {
        __syncthreads();
#pragma unroll
        for (int it = 0; it < 4; ++it) { const int ci = tid + 512 * it, d = ci >> 5, c = ci & 31; *(LAS u32x4*)(KV + d * PV + c * 8) = tmp[it]; }
        if (dc < 3) XLOADV(dc + 1)
        __syncthreads();
        f32x4 o[2][4];
#pragma unroll
        for (int mt = 0; mt < 2; ++mt)
#pragma unroll
            for (int n = 0; n < 4; ++n) o[mt][n] = (f32x4){0.f, 0.f, 0.f, 0.f};
#pragma unroll
        for (int ks = 0; ks < 8; ++ks) {
#pragma unroll
            for (int n = 0; n < 4; ++n) {
                const LAS bf16_t* vp = KV + (16 * n + fr) * PV + 32 * ks + 4 * fq;
                const u32x2 a0 = *(const LAS u32x2*)vp, a1 = *(const LAS u32x2*)(vp + 16);
                const bf16x8 av = __builtin_bit_cast(bf16x8, (u32x4){a0.x, a0.y, a1.x, a1.y});
                o[0][n] = __builtin_amdgcn_mfma_f32_16x16x32_bf16(av, pf[0][ks], o[0][n], 0, 0, 0);
                o[1][n] = __builtin_amdgcn_mfma_f32_16x16x32_bf16(av, pf[1][ks], o[1][n], 0, 0, 0);
            }
            __builtin_amdgcn_sched_barrier(0);
        }
        asm volatile("s_nop 7\n\ts_nop 7\n\ts_nop 7" ::: "memory");
#pragma unroll
        for (int mt = 0; mt < 2; ++mt) {
            bf16_t* op = (bf16_t*)(P->ws + WS_OX) + (size_t)(row + 16 * mt) * 1024 + h * 256 + dc * 64 + 4 * fq;
#pragma unroll
            for (int n = 0; n < 4; ++n) { u32x2 w2; w2.x = pk2(o[mt][n][0], o[mt][n][1]); w2.y = pk2(o[mt][n][2], o[mt][n][3]); *(u32x2*)(op + 16 * n) = w2; }
        }
    }
#undef XLOADK
#undef XLOADV
    __syncthreads();
}

__device__ __forceinline__ void xattn_sample(CP P, LAS unsigned char* lds, int unit, int tid, int wave, int lane) {
    const int b = unit >> 2, h = unit & 3, row0 = TP + b * 4;
    LAS float* sc = (LAS float*)lds;
    LAS float* red = sc + 1024;
    const bf16_t* q2 = (const bf16_t*)(P->ws + WS_Q2);
    const float* kb = P->in[6] + ((size_t)(b * 256) * 4 + h) * 256;
    const float* vb = P->in[7] + ((size_t)(b * 256) * 4 + h) * 256 + 4 * lane;
    {
        const int fr = lane & 15, fq = lane >> 4;
        bf16x8 qf[8];
#pragma unroll
        for (int ks = 0; ks < 8; ++ks) { u32x4 z = (u32x4){0u, 0u, 0u, 0u}; if (fr < 4) z = *(const u32x4*)(q2 + (size_t)(row0 + fr) * 1024 + h * 256 + ks * 32 + 8 * fq); qf[ks] = __builtin_bit_cast(bf16x8, z); }
#pragma unroll
        for (int mt = 0; mt < 2; ++mt) {
            const int m0 = 32 * wave + 16 * mt; const float* kr = kb + (size_t)(m0 + fr) * 1024 + 8 * fq;
            f32x4 kv[16];
#pragma unroll
            for (int ks = 0; ks < 8; ++ks) { kv[2 * ks] = __builtin_nontemporal_load((const f32x4*)(kr + ks * 32)); kv[2 * ks + 1] = __builtin_nontemporal_load((const f32x4*)(kr + ks * 32 + 4)); }
            f32x4 acc = (f32x4){0.f, 0.f, 0.f, 0.f};
#pragma unroll
            for (int ks = 0; ks < 8; ++ks) { u32x4 a; a.x = pk2(kv[2 * ks][0], kv[2 * ks][1]); a.y = pk2(kv[2 * ks][2], kv[2 * ks][3]); a.z = pk2(kv[2 * ks + 1][0], kv[2 * ks + 1][1]); a.w = pk2(kv[2 * ks + 1][2], kv[2 * ks + 1][3]);
                acc = __builtin_amdgcn_mfma_f32_16x16x32_bf16(__builtin_bit_cast(bf16x8, a), qf[ks], acc, 0, 0, 0); }
            if (fr < 4) *(LAS f32x4*)(sc + fr * 256 + m0 + 4 * fq) = acc * 0.0625f;
        }
    }
    __syncthreads();
    if (wave < 4) {
        float v[4]; float mx = -INFINITY;
#pragma unroll
        for (int j = 0; j < 4; ++j) { v[j] = sc[wave * 256 + lane + 64 * j]; mx = fmaxf(mx, v[j]); }
        mx = wave_max(mx); float sum = 0.f;
#pragma unroll
        for (int j = 0; j < 4; ++j) { v[j] = __expf(v[j] - mx); sum += v[j]; }
        const float inv = 1.f / wave_sum(sum);
#pragma unroll
        for (int j = 0; j < 4; ++j) sc[wave * 256 + lane + 64 * j] = v[j] * inv;
    }
    __syncthreads();
    f32x4 acc[4];
#pragma unroll
    for (int tt = 0; tt < 4; ++tt) acc[tt] = (f32x4){0.f, 0.f, 0.f, 0.f};
#pragma unroll 8
    for (int i = 0; i < 32; ++i) {
        const int m = 32 * wave + i; const f32x4 v = __builtin_nontemporal_load((const f32x4*)(vb + (size_t)m * 1024));
#pragma unroll
        for (int tt = 0; tt < 4; ++tt) acc[tt] += v * sc[tt * 256 + m];
    }
#pragma unroll
    for (int tt = 0; tt < 4; ++tt) *(LAS f32x4*)(red + (wave * 4 + tt) * 256 + 4 * lane) = acc[tt];
    __syncthreads();
    for (int kk_ = 0; kk_ < 2; ++kk_) { const int i = tid + 512 * kk_; float s = 0.f;
#pragma unroll
        for (int w = 0; w < 8; ++w) s += red[w * 1024 + i];
        const int tt = i >> 8, d = i & 255; ((bf16_t*)(P->ws + WS_OX))[(size_t)(row0 + tt) * 1024 + h * 256 + d] = f2bf(s); }
    __syncthreads();
}

__device__ __forceinline__ void skinny_gemm(const bf16_t* A, const bf16_t* Wt, bf16_t* C, int K, int bid, int G, int wave, int lane) {
    const int fr = lane & 15, fq = lane >> 4;
    for (int t = bid; t < 256; t += G) {
        const int r0 = TP + 32 * (t & 15) + 16 * (wave & 1), c0 = 64 * (t >> 4) + 16 * (wave >> 1);
        const bf16_t* ap = A + (size_t)(r0 + fr) * K + 8 * fq; const bf16_t* bp = Wt + (size_t)(c0 + fr) * K + 8 * fq;
        f32x4 acc = (f32x4){0.f, 0.f, 0.f, 0.f};
        for (int kb = 0; kb < K; kb += 512) {
            bf16x8 av[16], bv[16];
#pragma unroll
            for (int j = 0; j < 16; ++j) { av[j] = *(const bf16x8*)(ap + kb + 32 * j); bv[j] = *(const bf16x8*)(bp + kb + 32 * j); }
#pragma unroll
            for (int j = 0; j < 16; ++j) acc = __builtin_amdgcn_mfma_f32_16x16x32_bf16(bv[j], av[j], acc, 0, 0, 0);
        }
        __builtin_amdgcn_sched_barrier(0);
        asm volatile("s_nop 7\n\ts_nop 7\n\ts_nop 7" ::: "memory");
        u32x2 w; w.x = pk2(acc[0], acc[1]); w.y = pk2(acc[2], acc[3]);
        *(u32x2*)(C + (size_t)(r0 + fr) * 1024 + c0 + 4 * fq) = w;
    }
}

__device__ __forceinline__ void copy_caches(CP P, int part, int t0_, int NT_) {
    unsigned char* ws = P->ws; const bf16_t* proj = (const bf16_t*)(ws + WS_PROJ);
    if (part == 0) {
        for (int base_ = 0; base_ < 2048 * 1024 / 4; base_ += 4 * NT_) {
            u32x2 a[4], c[4];
#pragma unroll
            for (int k = 0; k < 4; ++k) { const int i = base_ + k * NT_ + t0_; a[k] = (u32x2){0u, 0u}; c[k] = a[k]; if (i < 2048 * 1024 / 4) { a[k] = ((const u32x2*)(ws + WS_MK))[i]; c[k] = ((const u32x2*)(ws + WS_MV))[i]; } }
#pragma unroll
            for (int k = 0; k < 4; ++k) { const int i = base_ + k * NT_ + t0_; if (i < 2048 * 1024 / 4) {
                ((f32x4*)(P->out + O_PMK))[i] = (f32x4){__uint_as_float(a[k].x << 16), __uint_as_float(a[k].x & 0xffff0000u), __uint_as_float(a[k].y << 16), __uint_as_float(a[k].y & 0xffff0000u)};
                ((f32x4*)(P->out + O_PMV))[i] = (f32x4){__uint_as_float(c[k].x << 16), __uint_as_float(c[k].x & 0xffff0000u), __uint_as_float(c[k].y << 16), __uint_as_float(c[k].y & 0xffff0000u)}; } }
        }
        for (int base_ = 0; base_ < 8 * 128 * 128; base_ += NT_) { const int i = base_ + t0_; if (i >= 8 * 128 * 128) continue; const int b = i >> 14, r = (i >> 7) & 127, cidx = i & 127;
            const bf16_t* pr = proj + (size_t)(b * SEQ + 1920 + r) * NPROJ + cidx; P->out[O_PWK + i] = bf2f(pr[2048]); P->out[O_PWV + i] = bf2f(pr[2176]); }
        for (int base_ = 0; base_ < 128 * 4 * 128; base_ += NT_) { const int j = base_ + t0_; if (j >= 128 * 4 * 128) continue; const int b = j >> 9, t = (j >> 7) & 3, cidx = j & 127;
            const bf16_t* pr = proj + (size_t)(TP + b * 4 + t) * NPROJ + cidx; const size_t o = (size_t)(b * 128 + 124 + t) * 128 + cidx; P->out[O_SWK + o] = bf2f(pr[2048]); P->out[O_SWV + o] = bf2f(pr[2176]); }
    } else {
        for (int base_ = 0; base_ < 128 * 124 * 32; base_ += 4 * NT_) {
            f32x4 kv[4], vv[4];
#pragma unroll
            for (int k = 0; k < 4; ++k) { const int j = base_ + k * NT_ + t0_; kv[k] = (f32x4){0.f, 0.f, 0.f, 0.f}; vv[k] = kv[k];
                if (j < 128 * 124 * 32) { const int b = j / (124 * 32), rem = j - b * (124 * 32); const size_t i = (size_t)b * 16384 + 4 * rem; kv[k] = __builtin_nontemporal_load((const f32x4*)(P->in[4] + i + 512)); vv[k] = __builtin_nontemporal_load((const f32x4*)(P->in[5] + i + 512)); } }
#pragma unroll
            for (int k = 0; k < 4; ++k) { const int j = base_ + k * NT_ + t0_;
                if (j < 128 * 124 * 32) { const int b = j / (124 * 32), rem = j - b * (124 * 32); const size_t i = (size_t)b * 16384 + 4 * rem; *(f32x4*)(P->out + O_SWK + i) = kv[k]; *(f32x4*)(P->out + O_SWV + i) = vv[k]; } }
        }
    }
}

#define XB_TMO      128
#define XB_XCNT(j)  (256  + 64 * (j))
#define XB_XSUB(j)  (1280 + 64 * (j))
#define XB_XGEN(j)  (2304 + 64 * (j))
#define XB_TOP      3328
#define XB_TOPGEN   3392
#define XCD_BAR_WORDS 3456
#define XB_SPIN_CAP (1u << 18)

__device__ __forceinline__ unsigned xb_ld(unsigned* p)              { return __hip_atomic_load(p, __ATOMIC_RELAXED, __HIP_MEMORY_SCOPE_AGENT); }
__device__ __forceinline__ unsigned xb_add(unsigned* p, unsigned v) { return __hip_atomic_fetch_add(p, v, __ATOMIC_RELAXED, __HIP_MEMORY_SCOPE_AGENT); }
__device__ __forceinline__ unsigned xb_xcc_id() { return (unsigned)__builtin_amdgcn_s_getreg((3 << 11) | 20) & 0xFu; }
#define XB_SPIN(cond, bar) do { unsigned _sp = 0; while (cond) { __builtin_amdgcn_s_sleep(1); \
    if ((++_sp & 255u) == 0u) { if (xb_ld(&(bar)[XB_TMO])) break; if (_sp > XB_SPIN_CAP) { atomicAdd(&(bar)[XB_TMO], 1u); break; } } } } while (0)

struct XcdBarrier {
    unsigned* bar; unsigned x;
    volatile LAS unsigned* st;
};

__device__ __forceinline__ XcdBarrier xcd_barrier_post(unsigned* bar, volatile LAS unsigned* st) {
    XcdBarrier b; b.bar = bar; b.x = xb_xcc_id(); b.st = st;
    if (threadIdx.x == 0) (void)xb_add(&bar[XB_XCNT(b.x)], 1u);
    return b;
}
__device__ __forceinline__ void xcd_barrier_complete(unsigned* bar, unsigned x, unsigned& nloc, unsigned& nx) {
    const unsigned G = gridDim.x * gridDim.y * gridDim.z;
    unsigned sum, cnt, mine, sp = 0u;
    for (;;) {
        sum = 0u; cnt = 0u; mine = 0u;
#pragma unroll
        for (unsigned j = 0; j < 16; ++j) { const unsigned c = xb_ld(&bar[XB_XCNT(j)]); sum += c; cnt += (c > 0u) ? 1u : 0u; mine = (j == x) ? c : mine; }
        if (sum == G) break;
        __builtin_amdgcn_s_sleep(1);
        if ((++sp & 255u) == 0u) { if (xb_ld(&bar[XB_TMO])) break; if (sp > XB_SPIN_CAP) { atomicAdd(&bar[XB_TMO], 1u); break; } }
    }
    nloc = mine > 0u ? mine : 1u; nx = cnt > 0u ? cnt : 1u;
}

__device__ __forceinline__ void xcd_barrier(const XcdBarrier& b) {
    asm volatile("s_waitcnt vmcnt(0)" ::: "memory");
    __syncthreads();
    if (threadIdx.x == 0) {
        unsigned* bar = b.bar;
        __builtin_amdgcn_s_waitcnt(0);
        unsigned nloc = b.st[0], nx = b.st[1];
        if (nloc == 0u) { xcd_barrier_complete(bar, b.x, nloc, nx); b.st[0] = nloc; b.st[1] = nx; }
        const unsigned old = xb_add(&bar[XB_XSUB(b.x)], 1u);
        const unsigned gen = old / nloc;
        if (old + 1u == (gen + 1u) * nloc) {
            __builtin_amdgcn_fence(__ATOMIC_RELEASE, "agent");
            asm volatile("s_waitcnt vmcnt(0)" ::: "memory");
            const unsigned og = xb_add(&bar[XB_TOP], 1u);
            const unsigned tg = og / nx;
            if (og + 1u == (tg + 1u) * nx) xb_add(&bar[XB_TOPGEN], 1u);
            else XB_SPIN(xb_ld(&bar[XB_TOPGEN]) == tg, bar);
            __builtin_amdgcn_fence(__ATOMIC_ACQUIRE, "agent");
            xb_add(&bar[XB_XGEN(b.x)], 1u);
            asm volatile("s_waitcnt vmcnt(0)" ::: "memory");
        } else {
            XB_SPIN(xb_ld(&bar[XB_XGEN(b.x)]) == gen, bar);
            __builtin_amdgcn_fence(__ATOMIC_ACQUIRE, "agent");
            asm volatile("s_waitcnt vmcnt(0)" ::: "memory");
        }
    }
    __syncthreads();
}

constexpr int NPHASE = 13;
#ifndef SKN
#define SKN 2
#endif
#ifndef MK_MULTI
#define MK_MULTI 0
#endif
#ifndef TSW
#define TSW 0
#endif
__global__ void __launch_bounds__(512, 2) mk_fwd(Params P_) {
    CP P = (CP)__builtin_amdgcn_kernarg_segment_ptr(); asm volatile("" : "+s"(P));
    extern __shared__ __attribute__((aligned(16))) unsigned char lds_raw[];
    LAS unsigned char* lds = (LAS unsigned char*)lds_raw;
    const int G = gridDim.x, bid = blockIdx.x;
    volatile LAS unsigned* bar_st = (volatile LAS unsigned*)(lds + LDS_BYTES - 16);
    if (threadIdx.x < 4) bar_st[threadIdx.x] = 0u;
    __syncthreads();
    XcdBarrier xbar = xcd_barrier_post((unsigned*)P_.ws, bar_st);
#define TLW CP P = (CP)__builtin_amdgcn_kernarg_segment_ptr(); asm volatile("" : "+s"(P)); unsigned char* ws = P->ws; (void)ws; int tid = threadIdx.x; asm volatile("" : "+v"(tid)); const int lane = tid & 63, wave = __builtin_amdgcn_readfirstlane(tid >> 6); const int gw = bid * 8 + wave, NGW = G * 8; (void)gw; (void)NGW; (void)lane;
    unsigned char* ws = P->ws;
    const int lo = P->ph_lo, hi = P->ph_hi;
#ifndef PHMASK
#define PHMASK 0xffff
#endif
#define IN(k) (((PHMASK >> (k)) & 1) && lo <= (k) && (k) < hi)
#ifndef REP_PHASE
#define REP_PHASE -1
#endif
#define NREP(k) ((k) == REP_PHASE ? 2 : 1)
#define SEAM(k) do { if (IN(k) && IN((k) + 1)) xcd_barrier(xbar); } while (0)
    bf16_t* R = (bf16_t*)(ws + WS_R);
#ifdef DUMP_BUF
    if (lo == 100) { TLW const bf16_t* src = (const bf16_t*)(ws + DUMP_BUF);
        for (size_t i = (size_t)bid * 512 + tid; i < (size_t)TT * 1024; i += (size_t)G * 512) { float v = bf2f(src[i]); if (!(fabsf(v) < 1e30f)) v = 12345.f; P->out[i] = v; } }
#endif

    if (IN(0)) for (int rep = 0; rep < NREP(0); ++rep) { TLW phase_prologue(P, lds, gw, NGW, wave, lane); }
    SEAM(0);
    if (IN(1)) {
        pg8::Gemm g{R, R, 0, 0, 1024}; Order S{754, G, bid, 0, 0};
        EpiP1 E{(bf16_t*)(ws + WS_PROJ), (bf16_t*)(ws + WS_MK), (bf16_t*)(ws + WS_MV), (bf16_t*)(ws + WS_MVT), (bf16_t*)(ws + WS_KVT)};
        pg8::gemm_phase<EpiP1, Order, true, true>(lds, g, S, E);
    }
    SEAM(1);
    if (IN(2)) for (int rep = 0; rep < NREP(2); ++rep) {
        TLW
        if (!(TSW & 4)) for (int u = bid; u < 256; u += G) ssd_pass_a(P, lds, u, tid, wave, lane);
        if (!(TSW & 8)) for (int u = bid; u < 256; u += G) swa_prompt(P, lds, u, tid, wave, lane);
        if (!(TSW & 16)) for (int u = bid; u < 256; u += G) ssd_sample(P, lds, u, tid, wave, lane);
        if (!(TSW & 32)) for (int u = bid; u < 256; u += G) swa_sample(P, lds, u, tid, wave, lane);
    }
    SEAM(2);
    if (IN(3)) { { TLW ssd_state_scan(P, bid, G, tid); } xcd_barrier(xbar); }
    if (IN(3)) for (int rep = 0; rep < NREP(3); ++rep) { TLW for (int u = bid; u < 256; u += G) ssd_pass_b(P, lds, u, tid, wave, lane); }
    SEAM(3);
    if (IN(4)) for (int rep = 0; rep < NREP(4); ++rep) {
        pg8::Gemm g{(const bf16_t*)(ws + WS_MIXIN), (const bf16_t*)(ws + WS_WOUT), TT, 1024, 1024}; Order S{272, G, bid, 3, 16};
        EpiBf E{(bf16_t*)(ws + WS_CB16), 1024, 1.f, (float*)(ws + WS_SPLIT)};
        pg8::gemm_phase<EpiBf, Order, true, true>(lds, g, S, E);
        if (bid + G >= 272 && rep == 0) { TLW const int nb_ = G - (272 - G > 0 ? 272 - G : 0); tr_items(P, lds, 1, (bid - (G - nb_)) * 8 + wave, nb_ * 8, wave, lane); }
        if ((SKN >> 0) & 1) { TLW skinny_gemm((const bf16_t*)(ws + WS_MIXIN), (const bf16_t*)(ws + WS_WOUT), (bf16_t*)(ws + WS_CB16), 1024, bid, G, wave, lane); }
    }
    SEAM(4);
#ifdef SYNC_EXTRA
    for (int r_ = 0; r_ < SYNC_EXTRA; ++r_) cg::this_grid().sync();
#endif
    if (IN(5)) for (int rep = 0; rep < NREP(5); ++rep) { TLW phase_resid(P, 0, gw, NGW, lane); }
    SEAM(5);
    if (IN(6)) {
        pg8::Gemm g{(const bf16_t*)(ws + WS_H0), (const bf16_t*)(ws + WS_WXQ), TT, 1024, 1024}; Order S{256, G, bid, 1, 4};
        EpiBf E{(bf16_t*)(ws + WS_Q2), 1024, 1.f, nullptr};
        pg8::gemm_phase<EpiBf, Order, true, true>(lds, g, S, E);
        if ((SKN >> 1) & 1) { TLW skinny_gemm((const bf16_t*)(ws + WS_H0), (const bf16_t*)(ws + WS_WXQ), (bf16_t*)(ws + WS_Q2), 1024, bid, G, wave, lane); }
    }
    SEAM(6);
    if (IN(7)) for (int rep = 0; rep < NREP(7); ++rep) {
        TLW
        if ((bid >> 3) & 1) { for (int u = bid; u < 256; u += G) xattn_prompt2(P, lds, u, tid, wave, lane); }
        for (int u = bid; u < 512; u += G) xattn_sample(P, lds, u, tid, wave, lane);
        if (!((bid >> 3) & 1)) { for (int u = bid; u < 256; u += G) xattn_prompt2(P, lds, u, tid, wave, lane); }
    }
    SEAM(7);
    if (IN(8)) {
        pg8::Gemm g{(const bf16_t*)(ws + WS_OX), (const bf16_t*)(ws + WS_WXO), TT, 1024, 1024}; Order S{272, G, bid, 3, 16};
        EpiBf E{(bf16_t*)(ws + WS_CB16), 1024, 1.f, (float*)(ws + WS_SPLIT) + 8 * 512 * 1024};
        pg8::gemm_phase<EpiBf, Order, true, true>(lds, g, S, E);
        { TLW const int first_ = G > 16 ? 16 : 0; if (bid >= first_) copy_caches(P, 0, (bid - first_) * 512 + tid, (G - first_) * 512); }
        if ((SKN >> 2) & 1) { TLW skinny_gemm((const bf16_t*)(ws + WS_OX), (const bf16_t*)(ws + WS_WXO), (bf16_t*)(ws + WS_CB16), 1024, bid, G, wave, lane); }
    }
    SEAM(8);
    if (IN(9)) { TLW phase_resid(P, 1, gw, NGW, lane); }
    SEAM(9);
    if (IN(10)) for (int rep = 0; rep < NREP(10); ++rep) {
        pg8::Gemm g{(const bf16_t*)(ws + WS_H0), (const bf16_t*)(ws + WS_WGU), TT, 2 * DFF, 1024}; Order S{66 * 22, G, bid, 1, 22};
        EpiGU E{(bf16_t*)(ws + WS_ACT)};
        pg8::gemm_phase<EpiGU, Order, true, true>(lds, g, S, E);
    }
    SEAM(10);
    if (IN(11)) for (int rep = 0; rep < NREP(11); ++rep) {
        pg8::Gemm g{(const bf16_t*)(ws + WS_ACT), (const bf16_t*)(ws + WS_WDN), TT, 1024, DFF}; Order S{288, G, bid, 2, 44};
        EpiBf E{(bf16_t*)(ws + WS_CB16), 1024, 1.f, (float*)(ws + WS_SPLIT) + 12 * 512 * 1024};
        pg8::gemm_phase<EpiBf, Order, true, true>(lds, g, S, E);
        if (rep == 0) { TLW const int first_ = G > 32 ? 32 : 0; if (bid >= first_) copy_caches(P, 1, (bid - first_) * 512 + tid, (G - first_) * 512); }
        if ((SKN >> 3) & 1) { TLW skinny_gemm((const bf16_t*)(ws + WS_ACT), (const bf16_t*)(ws + WS_WDN), (bf16_t*)(ws + WS_CB16), DFF, bid, G, wave, lane); }
    }
    SEAM(11);
    if (IN(12)) { TLW phase_resid(P, 2, gw, NGW, lane); }
#undef IN
#undef SEAM
}

#ifndef MK_MULTI
#define MK_MULTI 0
#endif
#ifndef NPH_RUN
#define NPH_RUN 13
#endif
extern "C" void kernel_launch(void* const* d_in, const int* in_sizes, int n_in, void* d_out, int out_size, void* d_ws, size_t ws_size, hipStream_t stream) {
    static int grid = 0;
    if (grid == 0) {
        if (n_in != 32 || ws_size < WS_END) { fprintf(stderr, "kernel_launch: n_in %d ws %zu (need %zu)\n", n_in, ws_size, (size_t)WS_END); grid = -1; return; }
        int dev = 0, cus = 0, per_cu = 0;
        hipGetDevice(&dev); hipDeviceGetAttribute(&cus, hipDeviceAttributeMultiprocessorCount, dev);
        hipFuncSetAttribute((const void*)mk_fwd, hipFuncAttributeMaxDynamicSharedMemorySize, LDS_BYTES);
        hipOccupancyMaxActiveBlocksPerMultiprocessor(&per_cu, (const void*)mk_fwd, 512, LDS_BYTES);
        if (per_cu < 1) { fprintf(stderr, "kernel_launch: occupancy query says %d blocks per CU\n", per_cu); per_cu = 1; }
        grid = cus;
        (void)hipGetLastError();
    }
    if (grid < 0) return;
    (void)hipMemsetAsync(d_ws, 0, 16384, stream);
    Params p{};
    for (int i = 0; i < 32; ++i) p.in[i] = (const float*)d_in[i];
    p.out = (float*)d_out; p.ws = (unsigned char*)d_ws;
#if MK_MULTI
    for (int ph = 0; ph < NPH_RUN; ++ph) { p.ph_lo = ph; p.ph_hi = ph + 1; hipLaunchKernelGGL(mk_fwd, dim3(grid), dim3(512), LDS_BYTES, stream, p); }
#ifdef DUMP_BUF
    p.ph_lo = 100; p.ph_hi = 100; hipLaunchKernelGGL(mk_fwd, dim3(grid), dim3(512), LDS_BYTES, stream, p);
#endif
#else
    p.ph_lo = 0; p.ph_hi = NPHASE;
    void* args[] = {&p};
    hipError_t e = hipLaunchCooperativeKernel((const void*)mk_fwd, dim3(grid), dim3(512), args, LDS_BYTES, stream);
    if (e != hipSuccess) fprintf(stderr, "cooperative launch failed: %s (grid %d)\n", hipGetErrorString(e), grid);
#endif
}
```
